# Optimizing an MI355X kernel written in HIP

```python
import jax, jax.numpy as jnp
from jax import lax
import numpy as np

D_MODEL = 1024
BATCH = 2
SEQ = 8192
DEPTH = 4

GRID_W = 64
CTX_LEN = 256
N_MIXERS = 2
N_ATTN_LAYERS = (DEPTH + N_MIXERS - 1) // N_MIXERS
N_FOURIER_LAYERS = DEPTH // N_MIXERS

DA_HEAD_DIM = 64
DA_HEADS = D_MODEL // (2 * DA_HEAD_DIM)
DA_V_DIM = 2 * DA_HEAD_DIM
DA_QK_WIDTH = DA_HEADS * 2 * DA_HEAD_DIM
DA_V_WIDTH = DA_HEADS * DA_V_DIM
Q_BLOCK = 128
ROPE_THETA = 10000.0
ROPE_FREQS = DA_HEAD_DIM // 4

FN_WIDTH = D_MODEL
FN_GROUPS = 8
FN_GROUP_DIM = FN_WIDTH // FN_GROUPS

N_EXPERTS = 32
TOP_K = 4
D_EXPERT = D_MODEL
SWIGLU_LIMIT = 7.0
SWIGLU_ALPHA = 1.702
MOE_BLOCK = 256

LN_EPS = 1e-5
RMS_EPS = 1e-5
DEEPNORM_ALPHA = (2 * DEPTH) ** 0.25
DEEPNORM_BETA = (8 * DEPTH) ** -0.25

kernel_name = "hybrid_diffattn_fnet_moe_dit"


def layer_norm(x, g, b):
    xf = x.astype(jnp.float32)
    mu = jnp.mean(xf, axis=-1, keepdims=True)
    var = jnp.mean(jnp.square(xf - mu), axis=-1, keepdims=True)
    return ((xf - mu) * lax.rsqrt(var + LN_EPS)).astype(x.dtype) * g + b


def rms_norm(x, g):
    xf = x.astype(jnp.float32)
    return (xf * lax.rsqrt(jnp.mean(xf * xf, axis=-1, keepdims=True) + RMS_EPS)).astype(x.dtype) * g


def axial_rope_tables(n_tokens, dtype):
    rows = n_tokens // GRID_W
    row_ids = jnp.repeat(jnp.arange(rows), GRID_W).astype(jnp.float32)
    col_ids = jnp.tile(jnp.arange(GRID_W), rows).astype(jnp.float32)
    inv_freq = ROPE_THETA ** (-jnp.arange(ROPE_FREQS, dtype=jnp.float32) / ROPE_FREQS)
    ang = jnp.stack([row_ids[:, None] * inv_freq, col_ids[:, None] * inv_freq], axis=1)
    return jnp.cos(ang).astype(dtype), jnp.sin(ang).astype(dtype)


def apply_axial_rope(x, cos, sin):
    xr = x.reshape(x.shape[:-1] + (2, 2, ROPE_FREQS))
    x1, x2 = xr[..., 0, :], xr[..., 1, :]
    c_ = cos[None, :, None, None]
    s_ = sin[None, :, None, None]
    out = jnp.stack([x1 * c_ - x2 * s_, x2 * c_ + x1 * s_], axis=-2)
    return out.reshape(x.shape)


def diff_attend(q, k, v, lam):
    s = jnp.einsum("bqhcd,bkhcd->bhcqk", q, k).astype(jnp.float32) * (DA_HEAD_DIM ** -0.5)
    p = jax.nn.softmax(s, axis=-1)
    a = p[:, :, 0] - lam * p[:, :, 1]
    return jnp.einsum("bhqk,bkhe->bqhe", a.astype(v.dtype), v)


def diff_attention(h, h_ctx, w_qkv, lam, subln_g, w_o, cos, sin, lambda_init, ctx_queries):
    B, N, _ = h.shape
    Lc = h_ctx.shape[1]
    q, k, v = jnp.split(h @ w_qkv, [DA_QK_WIDTH, 2 * DA_QK_WIDTH], axis=-1)
    q = apply_axial_rope(q.reshape(B, N, DA_HEADS, 2, DA_HEAD_DIM), cos, sin)
    k = apply_axial_rope(k.reshape(B, N, DA_HEADS, 2, DA_HEAD_DIM), cos, sin)
    v = v.reshape(B, N, DA_HEADS, DA_V_DIM)
    k_c, v_c = jnp.split(h_ctx @ w_qkv[:, DA_QK_WIDTH:], [DA_QK_WIDTH], axis=-1)
    k_c = k_c.reshape(B, Lc, DA_HEADS, 2, DA_HEAD_DIM)
    v_c = v_c.reshape(B, Lc, DA_HEADS, DA_V_DIM)

    lf = lam.astype(jnp.float32)
    lam_val = jnp.exp(jnp.sum(lf[0] * lf[1])) - jnp.exp(jnp.sum(lf[2] * lf[3])) + lambda_init

    def finish(o):
        L = o.shape[1]
        o = rms_norm(o, subln_g) * (1.0 - lambda_init)
        return o.reshape(B, L, DA_V_WIDTH) @ w_o

    k_all = jnp.concatenate([k, k_c], axis=1)
    v_all = jnp.concatenate([v, v_c], axis=1)
    nb = N // Q_BLOCK
    q_blocks = jnp.moveaxis(q.reshape(B, nb, Q_BLOCK, DA_HEADS, 2, DA_HEAD_DIM), 1, 0)
    o = lax.map(lambda qb: diff_attend(qb, k_all, v_all, lam_val), q_blocks)
    o = jnp.moveaxis(o, 0, 1).reshape(B, N, DA_HEADS, DA_V_DIM)
    y = finish(o)

    if ctx_queries:
        q_c = (h_ctx @ w_qkv[:, :DA_QK_WIDTH]).reshape(B, Lc, DA_HEADS, 2, DA_HEAD_DIM)
        y_c = finish(diff_attend(q_c, k_c, v_c, lam_val))
    else:
        y_c = None
    return y, y_c


def fourier_mix(h, w_in, norm_g, w_out):
    B, L, _ = h.shape
    u = (h @ w_in).reshape(B, L, FN_GROUPS, FN_GROUP_DIM)
    u = rms_norm(u, norm_g.reshape(FN_GROUPS, FN_GROUP_DIM))
    f = jnp.fft.fft2(u.astype(jnp.float32), axes=(1, 3), norm="ortho").real.astype(h.dtype)
    return f.reshape(B, L, FN_WIDTH) @ w_out


def moe_ffn(h, w_router, b_router, w_gu, b_gu, w_down, b_down):
    T, D = h.shape
    logits = (h @ w_router + b_router).astype(jnp.float32)
    top_logit, top_e = lax.top_k(logits, TOP_K)
    gates = jax.nn.softmax(top_logit, axis=-1).astype(h.dtype)
    n_assign = T * TOP_K
    e_flat = top_e.reshape(-1)
    order = jnp.argsort(e_flat)
    e_sorted = e_flat[order]
    tok_sorted = (order // TOP_K).astype(jnp.int32)
    gate_sorted = gates.reshape(-1)[order]
    counts = jnp.bincount(e_flat, length=N_EXPERTS)
    padded = (counts + MOE_BLOCK - 1) // MOE_BLOCK * MOE_BLOCK
    start = jnp.cumsum(counts) - counts
    pend = jnp.cumsum(padded)
    pstart = pend - padded
    dest = pstart[e_sorted] + jnp.arange(n_assign) - start[e_sorted]
    n_blocks = -(-n_assign // MOE_BLOCK) + N_EXPERTS
    cap = n_blocks * MOE_BLOCK
    tok_buf = jnp.zeros((cap,), jnp.int32).at[dest].set(tok_sorted)
    gate_buf = jnp.zeros((cap,), h.dtype).at[dest].set(gate_sorted)
    blk_e = jnp.minimum(jnp.searchsorted(pend, jnp.arange(n_blocks) * MOE_BLOCK, side="right"),
                        N_EXPERTS - 1)

    def expert_block(args):
        ids, e = args
        xb = h[ids]
        gu = xb @ w_gu[e] + b_gu[e]
        gate, up = jnp.split(gu, 2, axis=-1)
        gate = jnp.minimum(gate, SWIGLU_LIMIT)
        up = jnp.clip(up, -SWIGLU_LIMIT, SWIGLU_LIMIT)
        act = gate * jax.nn.sigmoid(gate * SWIGLU_ALPHA) * (up + 1.0)
        return act @ w_down[e] + b_down[e]

    y = lax.map(expert_block, (tok_buf.reshape(n_blocks, MOE_BLOCK), blk_e))
    y = y.reshape(cap, D) * gate_buf[:, None]
    return jax.ops.segment_sum(y, tok_buf, num_segments=T)


def setup_inputs(seed: int = 0) -> dict:
    key = jax.random.key(seed)
    ks = jax.random.split(key, 22)
    nrm = jax.random.normal
    D = D_MODEL
    F = D_EXPERT
    return {
        "x": nrm(ks[0], (BATCH, SEQ, D), jnp.float32),
        "c": nrm(ks[1], (BATCH, D), jnp.float32),
        "ctx": nrm(ks[2], (BATCH, CTX_LEN, D), jnp.float32),
        "c_ctx": nrm(ks[3], (D,), jnp.float32),
        "w_mod": nrm(ks[4], (DEPTH, D, 6 * D), jnp.float32) * (0.5 * D ** -0.5),
        "b_mod": 0.02 * nrm(ks[5], (DEPTH, 6 * D), jnp.float32),
        "ln_g": 1.0 + 0.02 * nrm(ks[6], (DEPTH, 2, D), jnp.float32),
        "ln_b": 0.02 * nrm(ks[7], (DEPTH, 2, D), jnp.float32),
        "attn_w_qkv": nrm(ks[8], (N_ATTN_LAYERS, D, 2 * DA_QK_WIDTH + DA_V_WIDTH), jnp.float32) * D ** -0.5,
        "attn_lambda": 0.1 * nrm(ks[9], (N_ATTN_LAYERS, 4, DA_HEAD_DIM), jnp.float32),
        "attn_subln_g": 1.0 + 0.02 * nrm(ks[10], (N_ATTN_LAYERS, DA_V_DIM), jnp.float32),
        "attn_w_o": nrm(ks[11], (N_ATTN_LAYERS, DA_V_WIDTH, D), jnp.float32) * (DA_V_WIDTH ** -0.5 * DEEPNORM_BETA),
        "fn_w_in": nrm(ks[12], (N_FOURIER_LAYERS, D, FN_WIDTH), jnp.float32) * D ** -0.5,
        "fn_norm_g": 1.0 + 0.02 * nrm(ks[13], (N_FOURIER_LAYERS, FN_WIDTH), jnp.float32),
        "fn_w_out": nrm(ks[14], (N_FOURIER_LAYERS, FN_WIDTH, D), jnp.float32) * (FN_WIDTH ** -0.5 * DEEPNORM_BETA),
        "moe_w_router": nrm(ks[15], (DEPTH, D, N_EXPERTS), jnp.float32) * D ** -0.5,
        "moe_b_router": 0.01 * nrm(ks[16], (DEPTH, N_EXPERTS), jnp.float32),
        "moe_w_gu": nrm(ks[17], (DEPTH, N_EXPERTS, D, 2 * F), jnp.float32) * D ** -0.5,
        "moe_b_gu": 0.02 * nrm(ks[18], (DEPTH, N_EXPERTS, 2 * F), jnp.float32),
        "moe_w_down": nrm(ks[19], (DEPTH, N_EXPERTS, F, D), jnp.float32) * (F ** -0.5 * DEEPNORM_BETA),
        "moe_b_down": 0.02 * nrm(ks[20], (DEPTH, N_EXPERTS, D), jnp.float32),
    }


def reference(x, c, ctx, c_ctx, w_mod, b_mod, ln_g, ln_b, attn_w_qkv, attn_lambda, attn_subln_g,
              attn_w_o, fn_w_in, fn_norm_g, fn_w_out, moe_w_router, moe_b_router, moe_w_gu,
              moe_b_gu, moe_w_down, moe_b_down):
    B, N, D = x.shape
    cos, sin = axial_rope_tables(N, x.dtype)
    last_ctx_layer = max(i for i in range(DEPTH) if i % N_MIXERS == 0)
    for i in range(DEPTH):
        j = i // N_MIXERS
        ctx_full = i < last_ctx_layer
        mod_x = (jax.nn.silu(c) @ w_mod[i] + b_mod[i])[:, None, :]
        sh1, sc1, g1, sh2, sc2, g2 = jnp.split(mod_x, 6, axis=-1)
        if i <= last_ctx_layer:
            mod_c = jax.nn.silu(c_ctx) @ w_mod[i] + b_mod[i]
            csh1, csc1, cg1, csh2, csc2, cg2 = jnp.split(mod_c, 6)

        hx = x * (1.0 + sc1) + sh1
        if i % N_MIXERS == 0:
            hc = ctx * (1.0 + csc1) + csh1
            lambda_init = 0.8 - 0.6 * float(np.exp(-0.3 * i))
            y, y_c = diff_attention(hx, hc, attn_w_qkv[j], attn_lambda[j], attn_subln_g[j],
                                    attn_w_o[j], cos, sin, lambda_init, ctx_full)
        else:
            y = fourier_mix(hx, fn_w_in[j], fn_norm_g[j], fn_w_out[j])
            if ctx_full:
                hc = ctx * (1.0 + csc1) + csh1
                y_c = fourier_mix(hc, fn_w_in[j], fn_norm_g[j], fn_w_out[j])
        x = layer_norm(DEEPNORM_ALPHA * x + g1 * y, ln_g[i, 0], ln_b[i, 0])
        if ctx_full:
            ctx = layer_norm(DEEPNORM_ALPHA * ctx + cg1 * y_c, ln_g[i, 0], ln_b[i, 0])

        hx = x * (1.0 + sc2) + sh2
        if ctx_full:
            hc = ctx * (1.0 + csc2) + csh2
            tokens = jnp.concatenate([hx.reshape(-1, D), hc.reshape(-1, D)], axis=0)
            out = moe_ffn(tokens, moe_w_router[i], moe_b_router[i], moe_w_gu[i], moe_b_gu[i],
                          moe_w_down[i], moe_b_down[i])
            y_x = out[:B * N].reshape(B, N, D)
            y_c = out[B * N:].reshape(B, -1, D)
            ctx = layer_norm(DEEPNORM_ALPHA * ctx + cg2 * y_c, ln_g[i, 1], ln_b[i, 1])
        else:
            y_x = moe_ffn(hx.reshape(-1, D), moe_w_router[i], moe_b_router[i], moe_w_gu[i],
                          moe_b_gu[i], moe_w_down[i], moe_b_down[i]).reshape(B, N, D)
        x = layer_norm(DEEPNORM_ALPHA * x + g2 * y_x, ln_g[i, 1], ln_b[i, 1])
    return x
```

```cpp
#include <hip/hip_runtime.h>
#include <cstdio>
#include <cstdint>
namespace pg8 {
#define PG8_LAS __attribute__((address_space(3)))
typedef unsigned short bf16_t;
typedef short bf16x8 __attribute__((ext_vector_type(8)));
typedef float f32x4 __attribute__((ext_vector_type(4)));
typedef unsigned u32x4 __attribute__((ext_vector_type(4)));
constexpr int BM = 256, BK = 64, HALF = 128, HTB = HALF * BK * 2  , STAGE_BYTES = 8 * HTB, NXCD = 8, WGM = 8;

__host__ __device__ __forceinline__ int lds_byte(int r, int c) { const int st = (r >> 4) * 2 + (c >> 5), rr = r & 15, cc = c & 31, ob = rr * 64 + cc * 2; return st * 1024 + (ob ^ (((ob >> 9) & 1) << 5)); }
__host__ __device__ __forceinline__ void stage_rc(int b, int& R, int& C) { const int st = b / 1024, sb = b % 1024, swz = sb ^ (((sb >> 9) & 1) << 5); R = (st >> 1) * 16 + swz / 64; C = (st & 1) * 32 + (swz % 64) / 2; }
__host__ __device__ __forceinline__ int perm32(int rho) { const int n = rho >> 4, i = rho & 15; return 8 * (i >> 2) + 4 * n + (i & 3); }

struct Unit { int pm, pn; };
struct Gemm { const bf16_t* A; const bf16_t* Bt; int M, N, K; };

struct StaticOrder {
    int nM, nN, nwg, G, c;
    __host__ __device__ void init(int M, int N, int G_, int c_) { nM = M / BM; nN = N / BM; nwg = nM * nN; G = G_; c = c_; }
    __host__ __device__ bool next(int i, Unit& u) const {
        const long L = (long)i * G + c; if (L >= nwg) return false;
        int wgid = (int)L; { const int q = nwg / NXCD, r = nwg % NXCD, xcd = wgid % NXCD, off = wgid / NXCD; wgid = (xcd < r ? xcd * (q + 1) : r * (q + 1) + (xcd - r) * q) + off; }
        const int nig = WGM * nN, gid = wgid / nig, fm = gid * WGM, gsz = (nM - fm) < WGM ? (nM - fm) : WGM;
        u.pm = fm + ((wgid % nig) % gsz); u.pn = (wgid % nig) / gsz; return true;
    }
    __device__ __forceinline__ void a_ready(const Unit&) const {}
    __device__ __forceinline__ void done(const Unit&) const {}
};

__device__ __forceinline__ unsigned cvt_pk_bf16(float lo, float hi) { unsigned r; asm volatile("v_cvt_pk_bf16_f32 %0, %1, %2" : "=v"(r) : "v"(lo), "v"(hi)); return r; }
typedef float f32x2 __attribute__((ext_vector_type(2)));
__device__ __forceinline__ f32x2 gelu_pk(f32x2 v) {
    const f32x2 av = __builtin_elementwise_abs(v), d = av * 0.2316418882f + 1.0f;
    f32x2 t; t.x = __builtin_amdgcn_rcpf(d.x); t.y = __builtin_amdgcn_rcpf(d.y);
    f32x2 q = t * 0.5307027145f + (-0.7265760135f); q = q * t + 0.7107068705f; q = q * t + (-0.142248368f); q = q * t + 0.127414796f; q = q * t;
    const f32x2 s = (v * v) * (-0.72134752044f);
    f32x2 e; e.x = __builtin_amdgcn_exp2f(s.x); e.y = __builtin_amdgcn_exp2f(s.y);
    const f32x2 m = v * (q * e), r = v - m;
    f32x2 o; o.x = v.x < 0.f ? m.x : r.x; o.y = v.y < 0.f ? m.y : r.y; return o;
}

template <int ACT  > struct EpiBf16 {
    static constexpr bool PERM = true, AFTER_DRAIN = false; static_assert(ACT == 0 || ACT == 1, "EpiBf16: ACT is 0 (none) or 1 (gelu_pk)");
    bf16_t* O; int ldc; const float* bias; int split_cols; size_t split_stride; float scale0;
    __device__ __forceinline__ void operator()(const f32x4 (&acc)[2][2][4][2], const Unit& u, int wr, int wc, int fr, int fq) const {
        const int row0 = u.pm * BM + wr * 64 + fr; int colt = u.pn * BM; bf16_t* base = O;
        float sc = 1.f; if (split_cols) { const int t = colt / split_cols; base += (size_t)t * split_stride; colt -= t * split_cols; if (t == 0) sc = scale0; }
        const int col0 = colt + wc * 32 + 8 * fq, bcol0 = u.pn * BM + wc * 32 + 8 * fq;
        f32x4 bv[2][2];
#pragma unroll
        for (int bj = 0; bj < 2; ++bj)
#pragma unroll
            for (int n = 0; n < 2; ++n) bv[bj][n] = bias ? *(const f32x4*)(bias + bcol0 + bj * HALF + 4 * n) : (f32x4){0.f, 0.f, 0.f, 0.f};
#pragma unroll
        for (int ai = 0; ai < 2; ++ai)
#pragma unroll
            for (int m = 0; m < 4; ++m) { bf16_t* rowp = base + (size_t)(row0 + ai * HALF + m * 16) * ldc + col0;
#pragma unroll
                for (int bj = 0; bj < 2; ++bj) { f32x4 v0 = acc[ai][bj][m][0] + bv[bj][0], v1 = acc[ai][bj][m][1] + bv[bj][1];
                    if (ACT == 1) { f32x2 a = gelu_pk((f32x2){v0[0], v0[1]}), b = gelu_pk((f32x2){v0[2], v0[3]}), c = gelu_pk((f32x2){v1[0], v1[1]}), d = gelu_pk((f32x2){v1[2], v1[3]});
                        v0 = (f32x4){a.x, a.y, b.x, b.y}; v1 = (f32x4){c.x, c.y, d.x, d.y}; }
                    v0 = v0 * sc; v1 = v1 * sc; u32x4 w; w.x = cvt_pk_bf16(v0[0], v0[1]); w.y = cvt_pk_bf16(v0[2], v0[3]); w.z = cvt_pk_bf16(v1[0], v1[1]); w.w = cvt_pk_bf16(v1[2], v1[3]);
                    *(u32x4*)(rowp + bj * HALF) = w; } }
    }
};

typedef unsigned u32x2 __attribute__((ext_vector_type(2)));
__device__ __forceinline__ u32x4 pack8(const f32x4 v0, const f32x4 v1) { u32x4 w; w.x = cvt_pk_bf16(v0[0], v0[1]); w.y = cvt_pk_bf16(v0[2], v0[3]); w.z = cvt_pk_bf16(v1[0], v1[1]); w.w = cvt_pk_bf16(v1[2], v1[3]); return w; }

struct LinearOrder {
    int nwg, G, c;
    __device__ __forceinline__ bool next(int i, Unit& u) const { const long L = (long)i * G + c; if (L >= nwg) return false; int z = 0; asm volatile("" : "+s"(z)); u.pm = z; u.pn = (int)L; return true; }
    __device__ __forceinline__ void a_ready(const Unit&) const {}
    __device__ __forceinline__ void done(const Unit&) const {}
};
struct MoeOrder {
    const PG8_LAS int* blk_e; int NB, NJ, G, v;
    __device__ __forceinline__ bool next(int i, Unit& u) const { const long L = (long)i * G + v; if (L >= (long)NB * NJ) return false; const int blk = (int)(L / NJ), j = (int)(L - (long)blk * NJ);
        const int e = __builtin_amdgcn_readfirstlane(blk_e[blk]); u.pm = blk; u.pn = e * NJ + j; return true; }
    __device__ __forceinline__ void a_ready(const Unit&) const {}
    __device__ __forceinline__ void done(const Unit&) const {}
};

struct EpiQKV {
    static constexpr bool PERM = false, AFTER_DRAIN = false;
    bf16_t* Q; unsigned kv_stride; const float* ropec; const float* ropes; float qscale;
    __device__ __forceinline__ void operator()(const f32x4 (&acc)[2][2][4][2], const Unit& u, int wr, int wc, int fr_, int fq_) const {
        int fr = fr_, fq = fq_; asm volatile("" : "+v"(fr), "+v"(fq));
        const int t = u.pn >> 2;
        const bool ctx = u.pm >= 64;
        bf16_t* dst = Q + (size_t)t * kv_stride;
        const float sc = t == 0 ? qscale : 1.f;
        const bool rope = (t < 2) && !ctx;
        const unsigned colofs = (unsigned)((u.pn & 3) * 256 + wc * 32 + 4 * fq);
        const unsigned tabofs = (unsigned)(4 * fq);
#pragma unroll
        for (int ai = 0; ai < 2; ++ai)
#pragma unroll
            for (int m = 0; m < 4; ++m) {
                const int r = u.pm * 256 + ai * 128 + wr * 64 + m * 16 + fr;
                unsigned drow;
                if (t == 0) drow = (unsigned)r;
                else if (!ctx) drow = (unsigned)(r + ((r >> 13) << 8));
                else { const int rc = r - 16384; drow = (unsigned)((rc >> 8) * 8448 + 8192 + (rc & 255)); }
                f32x4 c4 = {1.f, 1.f, 1.f, 1.f}, s4 = {0.f, 0.f, 0.f, 0.f};
                if (rope) { const int n = r & 8191; const unsigned pos = (unsigned)((wc & 1) ? (n & 63) : (n >> 6));
                    c4 = *(const f32x4*)((const char*)ropec + ((pos * 16u + tabofs) * 4u)); s4 = *(const f32x4*)((const char*)ropes + ((pos * 16u + tabofs) * 4u)); }
                const unsigned off = drow * 1024u + colofs;
#pragma unroll
                for (int bj = 0; bj < 2; ++bj) {
                    const f32x4 x1 = acc[ai][bj][m][0], x2 = acc[ai][bj][m][1];
                    const f32x4 o1 = (x1 * c4 - x2 * s4) * sc, o2 = (x2 * c4 + x1 * s4) * sc;
                    u32x2 w1, w2; w1.x = cvt_pk_bf16(o1[0], o1[1]); w1.y = cvt_pk_bf16(o1[2], o1[3]); w2.x = cvt_pk_bf16(o2[0], o2[1]); w2.y = cvt_pk_bf16(o2[2], o2[3]);
                    *(u32x2*)(dst + (off + bj * 128)) = w1; *(u32x2*)(dst + (off + bj * 128 + 16)) = w2;
                }
                asm volatile("" ::: "memory");
            }
    }
};

struct EpiZ1 {
    static constexpr bool PERM = true, AFTER_DRAIN = false;
    bf16_t* Z1; bf16_t* Zc;
    __device__ __forceinline__ void operator()(const f32x4 (&acc)[2][2][4][2], const Unit& u, int wr, int wc, int fr_, int fq_) const {
        int fr = fr_, fq = fq_; asm volatile("" : "+v"(fr), "+v"(fq));
        const int mm0 = wr * 64 + fr;
#pragma unroll
        for (int bj = 0; bj < 2; ++bj) {
            const int rho0 = u.pn * 256 + bj * 128 + wc * 32 + 8 * fq;
            const bool lat = rho0 < 131072;
            bf16_t* dst; unsigned base, smm, sre;
            if (lat) { const int bgn = rho0 >> 7, n_hi = rho0 & 127, bg = bgn >> 6, n_lo = bgn & 63; dst = Z1; smm = 64u * 256u; sre = 128u; base = (unsigned)(bg * 128) * smm + (unsigned)(n_lo * 256 + n_hi); }
            else { const int rc = rho0 - 131072, bg = rc >> 8, j = rc & 255; dst = Zc; smm = 512u; sre = 256u; base = (unsigned)(bg * 128) * smm + (unsigned)j; }
            base += (unsigned)mm0 * smm;
#pragma unroll
            for (int m = 0; m < 4; ++m) {
#pragma unroll
                for (int ai = 0; ai < 2; ++ai) *(u32x4*)(dst + (base + (unsigned)(m * 16) * smm + (unsigned)ai * sre)) = pack8(acc[ai][bj][m][0], acc[ai][bj][m][1]);
                asm volatile("" ::: "memory");
            }
        }
    }
};
struct EpiFFT1 {
    static constexpr bool PERM = true, AFTER_DRAIN = false;
    bf16_t* T; const float* twc; const float* tws;
    __device__ __forceinline__ void operator()(const f32x4 (&acc)[2][2][4][2], const Unit& u, int wr, int wc, int fr_, int fq_) const {
        int fr = fr_, fq = fq_; asm volatile("" : "+v"(fr), "+v"(fq));
        const int kl0 = wr * 64 + fr;
#pragma unroll
        for (int bj = 0; bj < 2; ++bj) {
            const int rho0 = u.pn * 256 + bj * 128 + wc * 32 + 8 * fq;
            const int n_lo0 = rho0 & 63, bgm = rho0 >> 6, mm = bgm & 127, bg = bgm >> 7;
            const unsigned base = ((unsigned)(bg * 128 + kl0) * 128u + (unsigned)mm) * 128u + (unsigned)n_lo0;
            const unsigned tw0 = (unsigned)(kl0 * 64 + n_lo0);
#pragma unroll
            for (int m = 0; m < 4; ++m) {
                f32x4 pr[2], pi[2];
#pragma unroll
                for (int n = 0; n < 2; ++n) {
                    const f32x4 c4 = *(const f32x4*)((const char*)twc + ((tw0 + m * 1024 + 4 * n) * 4u)), s4 = *(const f32x4*)((const char*)tws + ((tw0 + m * 1024 + 4 * n) * 4u));
                    const f32x4 tr = acc[0][bj][m][n], ti = acc[1][bj][m][n];
                    pr[n] = tr * c4 + ti * s4; pi[n] = ti * c4 - tr * s4;
                }
                *(u32x4*)((char*)T + ((base + (unsigned)m * 262144u) * 2u)) = pack8(pr[0], pr[1]); *(u32x4*)((char*)T + ((base + (unsigned)m * 262144u + 64u) * 2u)) = pack8(pi[0], pi[1]);
                asm volatile("" ::: "memory");
            }
        }
    }
};
struct EpiFFT2 {
    static constexpr bool PERM = true, AFTER_DRAIN = false;
    bf16_t* F;
    __device__ __forceinline__ void operator()(const f32x4 (&acc)[2][2][4][2], const Unit& u, int wr, int wc, int fr_, int fq_) const {
        int fr = fr_, fq = fq_; asm volatile("" : "+v"(fr), "+v"(fq));
        if (wr != 0) return;
#pragma unroll
        for (int bj = 0; bj < 2; ++bj) {
            const int rho0 = u.pn * 256 + bj * 128 + wc * 32 + 8 * fq;
            const int mm0 = rho0 & 127, bgk = rho0 >> 7, k_lo = bgk & 127, bg = bgk >> 7, b = bg >> 3, g = bg & 7;
#pragma unroll
            for (int m = 0; m < 4; ++m) {
                const int k_hi = m * 16 + fr;
                const long row = (long)b * 8192 + k_hi * 128 + k_lo;
                *(u32x4*)(F + row * 1024 + g * 128 + mm0) = pack8(acc[0][bj][m][0], acc[0][bj][m][1]);
            }
        }
    }
};
struct EpiDFT256 {
    static constexpr bool PERM = true, AFTER_DRAIN = false;
    bf16_t* F;
    __device__ __forceinline__ void operator()(const f32x4 (&acc)[2][2][4][2], const Unit& u, int wr, int wc, int fr_, int fq_) const {
        int fr = fr_, fq = fq_; asm volatile("" : "+v"(fr), "+v"(fq));
#pragma unroll
        for (int bj = 0; bj < 2; ++bj) {
            const int rho0 = u.pn * 256 + bj * 128 + wc * 32 + 8 * fq;
            const int mm0 = rho0 & 127, bg = rho0 >> 7, b = bg >> 3, g = bg & 7;
#pragma unroll
            for (int ai = 0; ai < 2; ++ai)
#pragma unroll
                for (int m = 0; m < 4; ++m) {
                    const int k = ai * 128 + wr * 64 + m * 16 + fr;
                    const long row = 16384 + (long)b * 256 + k;
                    *(u32x4*)(F + row * 1024 + g * 128 + mm0) = pack8(acc[ai][bj][m][0], acc[ai][bj][m][1]);
                }
        }
    }
};
struct EpiSwiGLU {
    static constexpr bool PERM = true, AFTER_DRAIN = false;
    bf16_t* ACT; const float* bgu;
    __device__ __forceinline__ void operator()(const f32x4 (&acc)[2][2][4][2], const Unit& u, int wr, int wc, int fr_, int fq_) const {
        int fr = fr_, fq = fq_; asm volatile("" : "+v"(fr), "+v"(fq));
        const int e = u.pn >> 3, j = u.pn & 7, col0 = j * 128 + wc * 32 + 8 * fq;
        f32x4 bg[2], bu[2];
#pragma unroll
        for (int n = 0; n < 2; ++n) { bg[n] = *(const f32x4*)(bgu + e * 2048 + col0 + 4 * n); bu[n] = *(const f32x4*)(bgu + e * 2048 + 1024 + col0 + 4 * n); }
#pragma unroll
        for (int ai = 0; ai < 2; ++ai)
#pragma unroll
            for (int m = 0; m < 4; ++m) {
                const long row = (long)u.pm * 256 + ai * 128 + wr * 64 + m * 16 + fr;
                f32x4 a[2];
#pragma unroll
                for (int n = 0; n < 2; ++n) {
                    const f32x4 gv = acc[ai][0][m][n] + bg[n], uv = acc[ai][1][m][n] + bu[n];
#pragma unroll
                    for (int i = 0; i < 4; ++i) {
                        const float g = fminf(gv[i], 7.0f), up = fminf(fmaxf(uv[i], -7.0f), 7.0f);
                        const float sg = __builtin_amdgcn_rcpf(1.0f + __builtin_amdgcn_exp2f(g * (-1.702f * 1.4426950408889634f)));
                        a[n][i] = g * sg * (up + 1.0f);
                    }
                }
                *(u32x4*)(ACT + row * 1024 + col0) = pack8(a[0], a[1]);
            }
    }
};
struct EpiMoE2 {
    static constexpr bool PERM = true, AFTER_DRAIN = false;
    bf16_t* OUT; const float* bd; const float* gate;
    __device__ __forceinline__ void operator()(const f32x4 (&acc)[2][2][4][2], const Unit& u, int wr, int wc, int fr_, int fq_) const {
        int fr = fr_, fq = fq_; asm volatile("" : "+v"(fr), "+v"(fq));
        const int e = u.pn >> 2, j = u.pn & 3;
        f32x4 bv[2][2];
#pragma unroll
        for (int bj = 0; bj < 2; ++bj)
#pragma unroll
            for (int n = 0; n < 2; ++n) bv[bj][n] = *(const f32x4*)(bd + e * 1024 + j * 256 + bj * 128 + wc * 32 + 8 * fq + 4 * n);
#pragma unroll
        for (int ai = 0; ai < 2; ++ai)
#pragma unroll
            for (int m = 0; m < 4; ++m) {
                const long row = (long)u.pm * 256 + ai * 128 + wr * 64 + m * 16 + fr;
                const float gt = gate[row];
#pragma unroll
                for (int bj = 0; bj < 2; ++bj) {
                    const f32x4 v0 = (acc[ai][bj][m][0] + bv[bj][0]) * gt, v1 = (acc[ai][bj][m][1] + bv[bj][1]) * gt;
                    *(u32x4*)(OUT + row * 1024 + j * 256 + bj * 128 + wc * 32 + 8 * fq) = pack8(v0, v1);
                }
            }
    }
};
template <class Epi, class Sched, bool ALIGN_EPI = false, bool SP2 = false>
__device__ __forceinline__ void gemm_phase(PG8_LAS unsigned char* lds, const Gemm g, const Sched& S, const Epi& E) {
    int tid_o = threadIdx.x; asm volatile("" : "+v"(tid_o));
    const int tid = tid_o, wid = __builtin_amdgcn_readfirstlane(tid >> 6), lane = tid & 63, wr = wid >> 2, wc = wid & 3, fr = lane & 15, fq = lane >> 4;
    const int K = g.K, nt = K / BK;
    unsigned voffA[2], voffB[2];
#pragma unroll
    for (int i = 0; i < 2; ++i) { int R, C; stage_rc(tid * 16 + i * 8192, R, C); const int Rb = Epi::PERM ? ((R & ~31) + perm32(R & 31)) : R;
        voffA[i] = (unsigned)(R * K + C) * 2u; voffB[i] = (unsigned)(Rb * K + C) * 2u; }
    const size_t kstep = (size_t)(BK * 2);
    const size_t hstep = (size_t)HALF * K * 2;
    const size_t tstep = 2 * hstep;
    const unsigned ldsw = (unsigned)wid * 1024u;
    const int aoff = lds_byte(wr * 64 + fr, fq * 8), boff = lds_byte(wc * 32 + fr, fq * 8);
#define PG8_SA(b, h) (((b) * 2 + (h)) * HTB)
#define PG8_SB(b, h) ((4 + (b) * 2 + (h)) * HTB)
#define PG8_STAGE(bufoff, gbase, voff) do { _Pragma("unroll") for (int _i = 0; _i < 2; ++_i) \
        __builtin_amdgcn_global_load_lds((const unsigned*)((const char*)(gbase) + (voff)[_i]), (PG8_LAS unsigned*)(lds + (bufoff) + ldsw + _i * 8192), 16, 0, 0); } while (0)
#define PG8_LDA(dst, b, h) do { _Pragma("unroll") for (int m = 0; m < 4; ++m) _Pragma("unroll") for (int k = 0; k < 2; ++k) dst[m][k] = *(const PG8_LAS bf16x8*)(lds + PG8_SA(b, h) + aoff + m * 2048 + k * 1024); } while (0)
#define PG8_LDB(dst, b, h) do { _Pragma("unroll") for (int n = 0; n < 2; ++n) _Pragma("unroll") for (int k = 0; k < 2; ++k) dst[n][k] = *(const PG8_LAS bf16x8*)(lds + PG8_SB(b, h) + boff + n * 2048 + k * 1024); } while (0)
#define PG8_MMA(ai, bj, At, Bt) do { __builtin_amdgcn_s_setprio(1); _Pragma("unroll") for (int m = 0; m < 4; ++m) _Pragma("unroll") for (int n = 0; n < 2; ++n) _Pragma("unroll") for (int k = 0; k < 2; ++k) \
        acc[ai][bj][m][n] = __builtin_amdgcn_mfma_f32_16x16x32_bf16(Bt[n][k], At[m][k], acc[ai][bj][m][n], 0, 0, 0); __builtin_amdgcn_s_setprio(0); } while (0)
#define PG8_WAIT_V(n) asm volatile("s_waitcnt vmcnt(" #n ")" ::: "memory")
#define PG8_WAIT_L(n) asm volatile("s_waitcnt lgkmcnt(" #n ")" ::: "memory")
#define PG8_BAR __builtin_amdgcn_s_barrier()
#define PG8_SCHED __builtin_amdgcn_sched_barrier(0)
    Unit cur, nxt; int ui = 0;
    if (!S.next(0, cur)) return;
    f32x4 acc[2][2][4][2];
#pragma unroll
    for (int a = 0; a < 2; ++a)
#pragma unroll
        for (int b = 0; b < 2; ++b)
#pragma unroll
            for (int m = 0; m < 4; ++m)
#pragma unroll
                for (int n = 0; n < 2; ++n) acc[a][b][m][n] = (f32x4){0.f, 0.f, 0.f, 0.f};
    bf16x8 At[4][2], B0[2][2], B1[2][2];
    const char* cA = (const char*)g.A + (size_t)cur.pm * tstep; const char* cB = (const char*)g.Bt + (size_t)cur.pn * tstep;
    S.a_ready(cur);
    if constexpr (SP2) {
        PG8_STAGE(PG8_SB(0, 0), cB, voffB); PG8_STAGE(PG8_SB(0, 1), cB + hstep, voffB); PG8_STAGE(PG8_SA(0, 0), cA, voffA); PG8_STAGE(PG8_SA(0, 1), cA + hstep, voffA);
        if (wr == 1) PG8_BAR;
        PG8_WAIT_V(2); PG8_BAR;
        PG8_STAGE(PG8_SB(1, 0), cB + kstep, voffB); PG8_STAGE(PG8_SA(1, 0), cA + kstep, voffA); PG8_STAGE(PG8_SB(1, 1), cB + hstep + kstep, voffB);
        PG8_WAIT_V(6); PG8_BAR;
    } else {
        PG8_STAGE(PG8_SB(0, 0), cB, voffB); PG8_STAGE(PG8_SA(0, 0), cA, voffA); PG8_STAGE(PG8_SB(0, 1), cB + hstep, voffB); PG8_STAGE(PG8_SA(0, 1), cA + hstep, voffA);
        if (wr == 1) PG8_BAR;
        PG8_WAIT_V(4); PG8_BAR;
        PG8_STAGE(PG8_SB(1, 0), cB + kstep, voffB); PG8_STAGE(PG8_SA(1, 0), cA + kstep, voffA); PG8_STAGE(PG8_SB(1, 1), cB + hstep + kstep, voffB);
        PG8_WAIT_V(6); PG8_BAR;
    }
    for (;;) {
        const bool has_next = S.next(ui + 1, nxt);
        const char* nA = has_next ? (const char*)g.A + (size_t)nxt.pm * tstep : cA; const char* nB = has_next ? (const char*)g.Bt + (size_t)nxt.pn * tstep : cB;
        for (int t = 0; t < nt; t += 2) {
            const bool last = (t == nt - 2);
            const char* a1 = cA + (size_t)(t + 1) * kstep;
            const char* a2 = last ? nA : cA + (size_t)(t + 2) * kstep; const char* b2 = last ? nB : cB + (size_t)(t + 2) * kstep;
            const char* a3 = a2 + kstep; const char* b3 = b2 + kstep;
            if (last && has_next) S.a_ready(nxt);
            if constexpr (SP2) {
            PG8_LDB(B0, 0, 0); PG8_LDB(B1, 0, 1); PG8_SCHED; PG8_LDA(At, 0, 0); PG8_STAGE(PG8_SA(1, 1), a1 + hstep, voffA);
            PG8_WAIT_V(8); PG8_WAIT_L(0); PG8_BAR; PG8_MMA(0, 0, At, B0); PG8_MMA(0, 1, At, B1); PG8_BAR; PG8_SCHED;
            PG8_LDA(At, 0, 1); PG8_STAGE(PG8_SB(0, 0), b2, voffB); PG8_STAGE(PG8_SB(0, 1), b2 + hstep, voffB); PG8_STAGE(PG8_SA(0, 0), a2, voffA);
            PG8_WAIT_V(8); PG8_WAIT_L(0); PG8_BAR; PG8_MMA(1, 0, At, B0); PG8_MMA(1, 1, At, B1); PG8_BAR; PG8_SCHED;
            PG8_LDB(B0, 1, 0); PG8_LDB(B1, 1, 1); PG8_SCHED; PG8_LDA(At, 1, 0); PG8_STAGE(PG8_SA(0, 1), a2 + hstep, voffA);
            PG8_WAIT_V(8); PG8_WAIT_L(0); PG8_BAR; PG8_MMA(0, 0, At, B0); PG8_MMA(0, 1, At, B1); PG8_BAR; PG8_SCHED;
            PG8_LDA(At, 1, 1); PG8_STAGE(PG8_SB(1, 0), b3, voffB); PG8_STAGE(PG8_SB(1, 1), b3 + hstep, voffB); PG8_STAGE(PG8_SA(1, 0), a3, voffA);
            PG8_WAIT_V(8); PG8_WAIT_L(0); PG8_BAR; PG8_MMA(1, 0, At, B0); PG8_MMA(1, 1, At, B1); PG8_BAR; PG8_SCHED;
            } else {
            PG8_LDB(B0, 0, 0); PG8_SCHED; PG8_LDA(At, 0, 0); PG8_STAGE(PG8_SA(1, 1), a1 + hstep, voffA);
            PG8_WAIT_L(8); PG8_BAR; PG8_WAIT_L(0); PG8_MMA(0, 0, At, B0); PG8_BAR; PG8_SCHED;
            PG8_LDB(B1, 0, 1); PG8_STAGE(PG8_SB(0, 0), b2, voffB);
            PG8_BAR; PG8_WAIT_L(0); PG8_MMA(0, 1, At, B1); PG8_BAR;
            PG8_LDA(At, 0, 1); PG8_STAGE(PG8_SA(0, 0), a2, voffA);
            PG8_BAR; PG8_WAIT_L(0); PG8_MMA(1, 0, At, B0); PG8_BAR; PG8_SCHED;
            PG8_STAGE(PG8_SB(0, 1), b2 + hstep, voffB);
            PG8_WAIT_V(6); PG8_BAR; PG8_MMA(1, 1, At, B1); PG8_BAR;
            PG8_LDB(B0, 1, 0); PG8_SCHED; PG8_LDA(At, 1, 0); PG8_STAGE(PG8_SA(0, 1), a2 + hstep, voffA);
            PG8_WAIT_L(8); PG8_BAR; PG8_WAIT_L(0); PG8_MMA(0, 0, At, B0); PG8_BAR; PG8_SCHED;
            PG8_LDB(B1, 1, 1); PG8_STAGE(PG8_SB(1, 0), b3, voffB);
            PG8_BAR; PG8_WAIT_L(0); PG8_MMA(0, 1, At, B1); PG8_BAR;
            PG8_LDA(At, 1, 1); PG8_STAGE(PG8_SA(1, 0), a3, voffA);
            PG8_BAR; PG8_WAIT_L(0); PG8_MMA(1, 0, At, B0); PG8_BAR; PG8_SCHED;
            PG8_STAGE(PG8_SB(1, 1), b3 + hstep, voffB);
            PG8_WAIT_V(6); PG8_BAR; PG8_MMA(1, 1, At, B1); PG8_BAR;
            }
        }
        if constexpr (ALIGN_EPI) { if (wr == 0) PG8_BAR; }
        if constexpr (!Epi::AFTER_DRAIN) { E(acc, cur, wr, wc, fr, fq); S.done(cur); }
        if (!has_next) break;
#pragma unroll
        for (int a = 0; a < 2; ++a)
#pragma unroll
            for (int b = 0; b < 2; ++b)
#pragma unroll
                for (int m = 0; m < 4; ++m)
#pragma unroll
                    for (int n = 0; n < 2; ++n) acc[a][b][m][n] = (f32x4){0.f, 0.f, 0.f, 0.f};
        cur = nxt; cA = nA; cB = nB; ++ui;
        if constexpr (ALIGN_EPI) { if (wr == 1) PG8_BAR; }
    }
    PG8_WAIT_V(0);
    if constexpr (!ALIGN_EPI) { if (wr == 0) PG8_BAR; }
    PG8_BAR;
    if constexpr (Epi::AFTER_DRAIN) { E.fused(acc, cur, wr, wc, fr, fq, lds, wid, lane); S.done(cur); }
#undef PG8_SA
#undef PG8_SB
#undef PG8_STAGE
#undef PG8_LDA
#undef PG8_LDB
#undef PG8_MMA
#undef PG8_WAIT_V
#undef PG8_WAIT_L
#undef PG8_BAR
#undef PG8_SCHED
}
}

#include <hip/hip_bf16.h>
#include <cmath>
namespace attn_body {
using bf16=__hip_bfloat16;
using bf16x8=__attribute__((ext_vector_type(8)))short;
using s16x4=__attribute__((ext_vector_type(4)))short;
using f32x16=__attribute__((ext_vector_type(16)))float;
using u32x4=__attribute__((ext_vector_type(4)))unsigned;
constexpr int BATCH=2,NHEAD=16,SEQ=8192,D=64,DM=NHEAD*D;
constexpr int NW=8,QBLK=32,QB=QBLK*NW,KVBLK=64,NQB=SEQ/QB;
constexpr int ATTN_PITCH=DM, ATTN_UNIT_ROWS=QB;
__device__ __forceinline__ int crow(int r,int hi){return (r&3)+8*(r>>2)+4*hi;}
#define SBAR() __builtin_amdgcn_sched_barrier(0)
__device__ __forceinline__ void cmask(f32x16&p0,f32x16&p1,int jb,int qrel,int hi){
  const float NEG=-INFINITY; int kb=64*jb+4*hi;
  #pragma unroll
  for(int r=0;r<16;++r){int kv=kb+(r&3)+8*(r>>2); if(kv>qrel)p0[r]=NEG; if(kv+32>qrel)p1[r]=NEG;}
}

constexpr int NSLOT=3, SLOTB=8192;
constexpr int LDS_K=0, LDS_V=NSLOT*SLOTB, LDS_WS=2*NSLOT*SLOTB, LDS_OST=LDS_WS+NW*64*4, LDS_BYTES=LDS_OST+NW*4096;
constexpr float C2=0.125f*1.4426950408889634f;
__device__ __forceinline__ void glds16(const void*gsrc,unsigned lds_dst){unsigned keep;
  asm volatile("s_mov_b32 %0, m0\n\ts_mov_b32 m0, %2\n\ts_nop 0\n\tglobal_load_lds_dwordx4 %1, off\n\ts_mov_b32 m0, %0":"=&s"(keep):"v"(gsrc),"s"(lds_dst):"memory");}
__device__ __forceinline__ float max3f(float a,float b,float c){float r;asm("v_max3_f32 %0, %1, %2, %3":"=v"(r):"v"(a),"v"(b),"v"(c));return r;}
__device__ __forceinline__ float max2f(float a,float b){float r;asm("v_max_f32_e32 %0, %1, %2":"=v"(r):"v"(a),"v"(b));return r;}
__device__ __forceinline__ float fadd_s(float a,float b){float r;asm("v_add_f32_e32 %0, %1, %2":"=v"(r):"v"(a),"v"(b));return r;}
__device__ __forceinline__ float fsub_s(float a,float b){float r;asm("v_sub_f32_e32 %0, %1, %2":"=v"(r):"v"(a),"v"(b));return r;}
typedef float f32x2_t __attribute__((ext_vector_type(2))); typedef __bf16 bf16x2_t __attribute__((ext_vector_type(2)));
__device__ __forceinline__ unsigned cvtpk_s(float lo,float hi){f32x2_t v={lo,hi};bf16x2_t b=__builtin_convertvector(v,bf16x2_t);return __builtin_bit_cast(unsigned,b);}
#define WAIT_BAR(N) asm volatile("s_waitcnt vmcnt(" #N ") lgkmcnt(0)\n\ts_barrier":::"memory")

__device__ __forceinline__ void qkt(f32x16&p0,f32x16&p1,const char*Kslot,const bf16x8*qr,const f32x16&negm,int r32,int hi){
  const char*kb=Kslot+hi*1024+r32*16;
  #pragma unroll
  for(int d0=0;d0<4;++d0){
    const bf16x8 b0=*reinterpret_cast<const bf16x8*>(kb+d0*2048);
    const bf16x8 b1=*reinterpret_cast<const bf16x8*>(kb+d0*2048+512);
    if(d0==0){p0=__builtin_amdgcn_mfma_f32_32x32x16_bf16(b0,qr[0],negm,0,0,0);p1=__builtin_amdgcn_mfma_f32_32x32x16_bf16(b1,qr[0],negm,0,0,0);}
    else{p0=__builtin_amdgcn_mfma_f32_32x32x16_bf16(b0,qr[d0],p0,0,0,0);p1=__builtin_amdgcn_mfma_f32_32x32x16_bf16(b1,qr[d0],p1,0,0,0);}}
}
typedef __attribute__((address_space(3))) const char* lds_cptr;
typedef short v4i16_t __attribute__((ext_vector_type(4)));
__device__ __forceinline__ void kload8(bf16x8*kf,lds_cptr kp){
  kf[0]=*(const __attribute__((address_space(3))) bf16x8*)(kp);      kf[1]=*(const __attribute__((address_space(3))) bf16x8*)(kp+512);
  kf[2]=*(const __attribute__((address_space(3))) bf16x8*)(kp+2048); kf[3]=*(const __attribute__((address_space(3))) bf16x8*)(kp+2560);
  kf[4]=*(const __attribute__((address_space(3))) bf16x8*)(kp+4096); kf[5]=*(const __attribute__((address_space(3))) bf16x8*)(kp+4608);
  kf[6]=*(const __attribute__((address_space(3))) bf16x8*)(kp+6144); kf[7]=*(const __attribute__((address_space(3))) bf16x8*)(kp+6656);
}
__device__ __forceinline__ void kload2(bf16x8*kf,lds_cptr kp,int j){ kf[2*j]=*(const __attribute__((address_space(3))) bf16x8*)(kp+j*2048); kf[2*j+1]=*(const __attribute__((address_space(3))) bf16x8*)(kp+j*2048+512); }
__device__ __forceinline__ s16x4 vtr(lds_cptr p){ return __builtin_bit_cast(s16x4,__builtin_amdgcn_ds_read_tr16_b64_v4i16((__attribute__((address_space(3))) v4i16_t*)p)); }
__device__ __forceinline__ float rowmax(const f32x16&p0,const f32x16&p1){
  float a=max3f(p0[0],p0[1],p1[0]),b=max3f(p0[2],p0[3],p1[1]);a=max3f(a,p1[2],p1[3]);
  #pragma unroll
  for(int r=4;r<16;r+=4){a=max3f(a,p0[r],p0[r+1]);b=max3f(b,p0[r+2],p0[r+3]);a=max3f(a,p1[r],p1[r+1]);b=max3f(b,p1[r+2],p1[r+3]);}
  const float m=max2f(a,b);
  auto rr=__builtin_amdgcn_permlane32_swap(__float_as_uint(m),__float_as_uint(m),false,false);
  return max2f(__uint_as_float(rr[0]),__uint_as_float(rr[1]));
}
__device__ __forceinline__ void pv(f32x16*o,int vb,bf16x8 pa0,bf16x8 pa1,bf16x8 pa2,bf16x8 pa3){
  #pragma unroll
  for(int d0=0;d0<2;++d0){s16x4 lo[4],hi[4];
    #pragma unroll
    for(int ks=0;ks<4;++ks){
      asm volatile("ds_read_b64_tr_b16 %0,%1 offset:%c2":"=&v"(lo[ks]):"v"(vb),"i"(d0*4096+ks*1024):"memory");
      asm volatile("ds_read_b64_tr_b16 %0,%1 offset:%c2":"=&v"(hi[ks]):"v"(vb),"i"(d0*4096+ks*1024+512):"memory");}
    asm volatile("s_waitcnt lgkmcnt(0)":::"memory");SBAR();
    #define PK(k) (bf16x8){lo[k][0],lo[k][1],lo[k][2],lo[k][3],hi[k][0],hi[k][1],hi[k][2],hi[k][3]}
    o[d0]=__builtin_amdgcn_mfma_f32_32x32x16_bf16(pa0,PK(0),o[d0],0,0,0);
    o[d0]=__builtin_amdgcn_mfma_f32_32x32x16_bf16(pa1,PK(1),o[d0],0,0,0);
    o[d0]=__builtin_amdgcn_mfma_f32_32x32x16_bf16(pa2,PK(2),o[d0],0,0,0);
    o[d0]=__builtin_amdgcn_mfma_f32_32x32x16_bf16(pa3,PK(3),o[d0],0,0,0);
    #undef PK
  }
}

#ifndef ATTN_STORE16
#define ATTN_STORE16(p,v) (*(u32x4*)(p)=(v))
#endif
template<int THRL> __device__ __forceinline__ void attn_unit(long qrow0,long krow0,int NT,int hq,int hv,const bf16*Q,const bf16*__restrict__ K,const bf16*__restrict__ V,bf16*O,char*shm){
  int tid_o=threadIdx.x; asm volatile("":"+v"(tid_o));
  const int tid=tid_o,lane=tid&63,r32=lane&31,hi=lane>>5; const int wid=__builtin_amdgcn_readfirstlane(tid>>6);
  const bf16*Qw=Q+(qrow0+wid*QBLK)*DM+hq*D;
  const bf16*Kh=K+krow0*DM+hq*D,*Vh=V+krow0*DM+hv*D;
  const unsigned lds0=(unsigned)(uintptr_t)shm;
  float*wsf=(float*)(shm+LDS_WS)+wid*64;
  const bf16*ksrc=Kh+(long)lane*DM+wid*8;
  const bf16*vsrc=Vh+(long)(16*(wid&3)+(lane>>2))*DM+(wid>>2)*32+(lane&3)*8;
  const unsigned kdst=lds0+LDS_K+wid*1024, vdst=lds0+LDS_V+wid*1024;
  #define DMA_K(t,slot) glds16(ksrc+(long)(t)*KVBLK*DM,(unsigned)__builtin_amdgcn_readfirstlane(kdst+(slot)))
  #define DMA_V(t,slot) glds16(vsrc+(long)(t)*KVBLK*DM,(unsigned)__builtin_amdgcn_readfirstlane(vdst+(slot)))
  const int vb0=(int)(lds0+LDS_V)+((lane>>4)&1)*32+(lane&3)*8+(4*hi+((lane&15)>>2))*64;
  const char*Kbase=shm+LDS_K; bf16x8 kf[8];
  const lds_cptr shm3=(lds_cptr)shm; const lds_cptr kp0=shm3+LDS_K+hi*1024+r32*16; const lds_cptr vp0=shm3+LDS_V+((lane>>4)&1)*32+(lane&3)*8+(4*hi+((lane&15)>>2))*64;
  DMA_K(0,0);DMA_V(0,0);DMA_K(1,SLOTB);
  bf16x8 qr[4];
  #pragma unroll
  for(int d0=0;d0<4;++d0)qr[d0]=*reinterpret_cast<const bf16x8*>(&Qw[(long)r32*DM+d0*16+hi*8]);
  float mhat=0.f,l_reg=0.f;f32x16 o[2];o[0]=f32x16{};o[1]=f32x16{};f32x16 negm=f32x16{};asm volatile("":"+v"(negm));
  #define CMASK(P0,P1,t) do{}while(0)
  bool resc=false;
  #define START(P0,P1) do{ const float rm=rowmax(P0,P1); resc=false; \
    { const float dl=rm; mhat=fadd_s(mhat,dl); \
      _Pragma("unroll") for(int r=0;r<16;++r){P0[r]=fsub_s(P0[r],dl);P1[r]=fsub_s(P1[r],dl);} \
      _Pragma("unroll") for(int r=0;r<16;++r)negm[r]=-mhat; asm volatile("":"+v"(negm)); } \
    _Pragma("unroll") for(int r=0;r<16;++r)P0[r]=__builtin_amdgcn_exp2f(P0[r]); }while(0)
  #define RESC() do{ if(resc){ asm volatile("s_waitcnt lgkmcnt(0)":::"memory"); \
      _Pragma("unroll") for(int d_=0;d_<2;++d_) _Pragma("unroll") for(int r=0;r<16;++r)o[d_][r]*=wsf[crow(r,hi)]; } }while(0)
  f32x16 pA0,pA1,pB0,pB1;
  int sl_prev=0,sl_cur=0,sl_next=SLOTB;
  #define ROT() do{sl_prev=sl_cur;sl_cur=sl_next;sl_next=(sl_next==(NSLOT-1)*SLOTB)?0:sl_next+SLOTB;}while(0)
  DMA_K(2,2*SLOTB);
  WAIT_BAR(3);
  qkt(pA0,pA1,Kbase,qr,negm,r32,hi);asm volatile("s_nop 15\n\ts_nop 7":"+v"(pA0),"+v"(pA1));CMASK(pA0,pA1,0);
  START(pA0,pA1);
  _Pragma("unroll") for(int r=0;r<16;++r)pA1[r]=__builtin_amdgcn_exp2f(pA1[r]);
  WAIT_BAR(0);
  DMA_K(3,0);DMA_V(1,SLOTB);
  ROT();
  kload8(kf,kp0+sl_cur);
  WAIT_BAR(2);
  s16x4 vlo[8],vhi[8]; u32x4 pw0,pw1,pw2,pw3;
  #define PKW(P,B) cvtpk_s(P[B],P[B+1])
  #define PAF(k) __builtin_bit_cast(bf16x8,pw##k)
  #define VFR(i) (bf16x8){vlo[i][0],vlo[i][1],vlo[i][2],vlo[i][3],vhi[i][0],vhi[i][1],vhi[i][2],vhi[i][3]}
  #define PIN(x) asm volatile("":"+v"(x))
  #define MX3(a,b,c) __builtin_fmaxf(__builtin_fmaxf((a),(b)),(c))
  #define GAPA(MF,A0,A1,A2,A3,W0,W1,PW) do{ MF; sacc+=A0; sacc+=A1; sacc+=A2; sacc+=A3; PIN(sacc); W0; W1; PIN(PW); SBAR(); }while(0)
  #define EX(v) __builtin_amdgcn_exp2f(v)
  #define GAPB(MF,X,B) do{ MF; X[B]=EX(X[B]); X[B+1]=EX(X[B+1]); X[B+2]=EX(X[B+2]); X[B+3]=EX(X[B+3]); PIN(X); SBAR(); }while(0)
  #define VRD(i) do{ vlo[i]=vtr(vp_+(((i)>>2)*4096+((i)&3)*1024)); vhi[i]=vtr(vp_+(((i)>>2)*4096+((i)&3)*1024+512)); }while(0)
  #define KRD(G,j) do{ if(G){ kload2(kf,kp0+sl_next,j); SBAR(); } }while(0)
  #define STEP(C0,C1,P0,P1,t,GK,GV,GL) do{ SBAR(); \
    const lds_cptr vp_=vp0+sl_prev; \
    VRD(0); SBAR(); float sacc=(P0[0]+P0[1]); \
    GAPA(C0=__builtin_amdgcn_mfma_f32_32x32x16_bf16(kf[0],qr[0],negm,0,0,0), P0[2],P0[3],P0[4],P0[5],     pw0[0]=PKW(P0,0), pw0[1]=PKW(P0,2), pw0); \
    VRD(4); SBAR(); GAPA(C1=__builtin_amdgcn_mfma_f32_32x32x16_bf16(kf[1],qr[0],negm,0,0,0), P0[6],P0[7],P0[8],P0[9],     pw0[2]=PKW(P0,4), pw0[3]=PKW(P0,6), pw0); \
    VRD(1); SBAR(); GAPA(C0=__builtin_amdgcn_mfma_f32_32x32x16_bf16(kf[2],qr[1],C0,0,0,0),   P0[10],P0[11],P0[12],P0[13], pw1[0]=PKW(P0,8), pw1[1]=PKW(P0,10), pw1); \
    VRD(5); SBAR(); GAPA(C1=__builtin_amdgcn_mfma_f32_32x32x16_bf16(kf[3],qr[1],C1,0,0,0),   P0[14],P0[15],P1[0],P1[1],   pw1[2]=PKW(P0,12),pw1[3]=PKW(P0,14), pw1); \
    VRD(2); SBAR(); GAPA(C0=__builtin_amdgcn_mfma_f32_32x32x16_bf16(kf[4],qr[2],C0,0,0,0),   P1[2],P1[3],P1[4],P1[5],     pw2[0]=PKW(P1,0), pw2[1]=PKW(P1,2), pw2); \
    VRD(6); SBAR(); GAPA(C1=__builtin_amdgcn_mfma_f32_32x32x16_bf16(kf[5],qr[2],C1,0,0,0),   P1[6],P1[7],P1[8],P1[9],     pw2[2]=PKW(P1,4), pw2[3]=PKW(P1,6), pw2); \
    VRD(3); SBAR(); GAPA(C0=__builtin_amdgcn_mfma_f32_32x32x16_bf16(kf[6],qr[3],C0,0,0,0),   P1[10],P1[11],P1[12],P1[13], pw3[0]=PKW(P1,8), pw3[1]=PKW(P1,10), pw3); \
    VRD(7); SBAR(); GAPA(C1=__builtin_amdgcn_mfma_f32_32x32x16_bf16(kf[7],qr[3],C1,0,0,0),   P1[14],P1[15],0.f,0.f,       pw3[2]=PKW(P1,12),pw3[3]=PKW(P1,14), pw3); \
    l_reg+=sacc; \
    if(GK){DMA_K((t)+3,sl_cur);} if(GV){DMA_V((t)+1,sl_next);} \
    CMASK(C0,C1,t); \
    { float a=MX3(C0[0],C0[1],C1[0]),b=MX3(C0[2],C0[3],C1[1]); a=MX3(a,C1[2],C1[3]); \
      _Pragma("unroll") for(int r=4;r<16;r+=4){a=MX3(a,C0[r],C0[r+1]);b=MX3(b,C0[r+2],C0[r+3]);a=MX3(a,C1[r],C1[r+1]);b=MX3(b,C1[r+2],C1[r+3]);} \
      float rm=__builtin_fmaxf(a,b); { auto rr=__builtin_amdgcn_permlane32_swap(__float_as_uint(rm),__float_as_uint(rm),false,false); rm=__builtin_fmaxf(__uint_as_float(rr[0]),__uint_as_float(rr[1])); } \
      resc=false; \
      if(__builtin_expect(__any(rm>(float)THRL),0)){ const float dl=__builtin_fmaxf(rm,0.f); mhat+=dl; \
        _Pragma("unroll") for(int r=0;r<16;++r){C0[r]-=dl;C1[r]-=dl;} \
        _Pragma("unroll") for(int r=0;r<16;++r)negm[r]=-mhat; asm volatile("":"+v"(negm)); \
        const float f=__builtin_amdgcn_exp2f(-dl); l_reg*=f; if(hi==0)wsf[r32]=f; resc=true; } } \
    SBAR(); \
    GAPB(o[0]=__builtin_amdgcn_mfma_f32_32x32x16_bf16(PAF(0),VFR(0),o[0],0,0,0), C0,0); \
    GAPB(o[1]=__builtin_amdgcn_mfma_f32_32x32x16_bf16(PAF(0),VFR(4),o[1],0,0,0), C0,4); \
    KRD(GL,0); GAPB(o[0]=__builtin_amdgcn_mfma_f32_32x32x16_bf16(PAF(1),VFR(1),o[0],0,0,0), C0,8); \
    KRD(GL,1); GAPB(o[1]=__builtin_amdgcn_mfma_f32_32x32x16_bf16(PAF(1),VFR(5),o[1],0,0,0), C0,12); \
    KRD(GL,2); GAPB(o[0]=__builtin_amdgcn_mfma_f32_32x32x16_bf16(PAF(2),VFR(2),o[0],0,0,0), C1,0); \
    KRD(GL,3); GAPB(o[1]=__builtin_amdgcn_mfma_f32_32x32x16_bf16(PAF(2),VFR(6),o[1],0,0,0), C1,4); \
    GAPB(o[0]=__builtin_amdgcn_mfma_f32_32x32x16_bf16(PAF(3),VFR(3),o[0],0,0,0), C1,8); \
    GAPB(o[1]=__builtin_amdgcn_mfma_f32_32x32x16_bf16(PAF(3),VFR(7),o[1],0,0,0), C1,12); \
    }while(0)
  int t=1;
  #undef CMASK
  #define CMASK(P0,P1,t) do{}while(0)
  for(;t+5<NT;t+=2){
    STEP(pB0,pB1,pA0,pA1,t,true,true,true);     WAIT_BAR(2); RESC(); ROT();
    STEP(pA0,pA1,pB0,pB1,t+1,true,true,true);   WAIT_BAR(2); RESC(); ROT();
  }
  #undef CMASK
  #define CMASK(P0,P1,t) do{}while(0)
  #define ENDW(tt) do{ if((tt)+3<NT){WAIT_BAR(2);} else if((tt)+2<NT){WAIT_BAR(1);} else {WAIT_BAR(0);} }while(0)
  for(;t+1<NT;t+=2){
    STEP(pB0,pB1,pA0,pA1,t,(t+3<NT),(t+1<NT),(t+1<NT));       ENDW(t);   RESC(); ROT();
    STEP(pA0,pA1,pB0,pB1,t+1,(t+4<NT),(t+2<NT),(t+2<NT));     ENDW(t+1); RESC(); ROT();
  }
  STEP(pB0,pB1,pA0,pA1,NT-1,false,false,false); RESC();
  { float sacc=pB0[0]+pB0[1]; _Pragma("unroll") for(int r=2;r<16;++r)sacc+=pB0[r]; _Pragma("unroll") for(int r=0;r<16;++r)sacc+=pB1[r]; l_reg+=sacc;
    pw0=(u32x4){PKW(pB0,0),PKW(pB0,2),PKW(pB0,4),PKW(pB0,6)};pw1=(u32x4){PKW(pB0,8),PKW(pB0,10),PKW(pB0,12),PKW(pB0,14)};pw2=(u32x4){PKW(pB1,0),PKW(pB1,2),PKW(pB1,4),PKW(pB1,6)};pw3=(u32x4){PKW(pB1,8),PKW(pB1,10),PKW(pB1,12),PKW(pB1,14)};
    SBAR(); pv(o,vb0+sl_cur,PAF(0),PAF(1),PAF(2),PAF(3)); }
  #undef PKW
  #undef PAF
  #undef VFR
  #undef PIN
  #undef MX3
  #undef GAPA
  #undef GAPB
  #undef EX
  #undef VRD
  #undef KRD
  #undef STEP
  #undef ENDW
  {auto rr=__builtin_amdgcn_permlane32_swap(__float_as_uint(l_reg),__float_as_uint(l_reg),false,false);l_reg=__uint_as_float(rr[0])+__uint_as_float(rr[1]);}
  if(hi==0)wsf[32+r32]=l_reg;asm volatile("s_waitcnt lgkmcnt(0)":::"memory");
  float rli[16];
  #pragma unroll
  for(int r=0;r<16;++r)rli[r]=__builtin_amdgcn_rcpf(wsf[32+crow(r,hi)]);
  bf16*Ow=O+(qrow0+wid*QBLK)*DM+hv*D;
  { bf16*stg=(bf16*)(shm+LDS_OST)+wid*2048;
    #pragma unroll
    for(int r=0;r<16;++r){const int orow=crow(r,hi);
      #pragma unroll
      for(int d0=0;d0<2;++d0)stg[orow*64+d0*32+r32]=__float2bfloat16(o[d0][r]*rli[r]);}
    asm volatile("s_waitcnt lgkmcnt(0)":::"memory");
    #pragma unroll
    for(int i=0;i<4;++i){const int row=i*8+(lane>>3),ch=lane&7; const u32x4 v=*(const u32x4*)(stg+row*64+ch*8); ATTN_STORE16(Ow+(long)row*DM+ch*8,v);} }
  asm volatile("s_waitcnt lgkmcnt(0)\n\ts_barrier":::"memory");
  #undef DMA_K
  #undef DMA_V
  #undef CMASK
  #undef START
  #undef RESC
  #undef ROT
}
constexpr int ATTN_LDS_BYTES=LDS_BYTES;
#undef SBAR
#undef WAIT_BAR
}

#define GAS __attribute__((address_space(1)))
#define LAS __attribute__((address_space(3)))
typedef unsigned short bf16;
typedef unsigned v4u __attribute__((ext_vector_type(4)));
typedef float f32x4 __attribute__((ext_vector_type(4)));
typedef short bf16x8 __attribute__((ext_vector_type(8)));
typedef GAS unsigned gu32;
typedef GAS unsigned long long gu64;
#define RLX_AGENT __ATOMIC_RELAXED, __HIP_MEMORY_SCOPE_AGENT
#define LDS_WAIT() asm volatile("s_waitcnt lgkmcnt(0)" ::: "memory")
#define VM_WAIT() asm volatile("s_waitcnt vmcnt(0)" ::: "memory")
__device__ __forceinline__ unsigned long long rt() { return __builtin_amdgcn_s_memrealtime(); }
__device__ __forceinline__ unsigned f2bf(float f) { unsigned u = __builtin_bit_cast(unsigned, f); return (u + 0x7fffu + ((u >> 16) & 1u)) >> 16; }
__device__ __forceinline__ unsigned pk2(float lo, float hi) { return f2bf(lo) | (f2bf(hi) << 16); }

#define XB_TMO      128
#define XB_XCNT(j)  (256  + 64 * (j))
#define XB_XSUB(j)  (1280 + 64 * (j))
#define XB_XGEN(j)  (2304 + 64 * (j))
#define XB_TOP      3328
#define XB_TOPGEN   3392
#define XCD_BAR_WORDS 3456
#define XB_SPIN_CAP (1u << 24)

__device__ __forceinline__ unsigned xb_ld(unsigned* p)              { return __hip_atomic_load(p, __ATOMIC_RELAXED, __HIP_MEMORY_SCOPE_AGENT); }
__device__ __forceinline__ unsigned xb_add(unsigned* p, unsigned v) { return __hip_atomic_fetch_add(p, v, __ATOMIC_RELAXED, __HIP_MEMORY_SCOPE_AGENT); }
__device__ __forceinline__ unsigned xb_xcc_id() { return (unsigned)__builtin_amdgcn_s_getreg((3 << 11) | 20) & 0xFu; }
#define XB_SPIN(cond, bar) do { unsigned _sp = 0; while (cond) { __builtin_amdgcn_s_sleep(1); \
    if ((++_sp & 255u) == 0u) { if (xb_ld(&(bar)[XB_TMO])) break; if (_sp > XB_SPIN_CAP) { atomicAdd(&(bar)[XB_TMO], 1u); break; } } } } while (0)

struct XcdBarrier {
    unsigned* bar; unsigned x;
    volatile LAS unsigned* st;
};

__device__ __forceinline__ XcdBarrier xcd_barrier_post(unsigned* bar, volatile LAS unsigned* st) {
    XcdBarrier b; b.bar = bar; b.x = xb_xcc_id(); b.st = st;
    if (threadIdx.x == 0) (void)xb_add(&bar[XB_XCNT(b.x)], 1u);
    return b;
}
__device__ __forceinline__ void xcd_barrier_complete(unsigned* bar, unsigned x, unsigned& nloc, unsigned& nx) {
    const unsigned G = gridDim.x * gridDim.y * gridDim.z;
    unsigned sum, cnt, mine, sp = 0u;
    for (;;) {
        sum = 0u; cnt = 0u; mine = 0u;
#pragma unroll
        for (unsigned j = 0; j < 16; ++j) { const unsigned c = xb_ld(&bar[XB_XCNT(j)]); sum += c; cnt += (c > 0u) ? 1u : 0u; mine = (j == x) ? c : mine; }
        if (sum == G) break;
        __builtin_amdgcn_s_sleep(1);
        if ((++sp & 255u) == 0u) { if (xb_ld(&bar[XB_TMO])) break; if (sp > XB_SPIN_CAP) { atomicAdd(&bar[XB_TMO], 1u); break; } }
    }
    nloc = mine > 0u ? mine : 1u; nx = cnt > 0u ? cnt : 1u;
}

__device__ __forceinline__ void xcd_barrier(const XcdBarrier& b) {
    asm volatile("s_waitcnt vmcnt(0)" ::: "memory");
    __syncthreads();
    if (threadIdx.x == 0) {
        unsigned* bar = b.bar;
        __builtin_amdgcn_s_waitcnt(0);
        unsigned nloc = b.st[0], nx = b.st[1];
        if (nloc == 0u) { xcd_barrier_complete(bar, b.x, nloc, nx); b.st[0] = nloc; b.st[1] = nx; }
        const unsigned old = xb_add(&bar[XB_XSUB(b.x)], 1u);
        const unsigned gen = old / nloc;
        if (old + 1u == (gen + 1u) * nloc) {
            __builtin_amdgcn_fence(__ATOMIC_RELEASE, "agent");
            asm volatile("s_waitcnt vmcnt(0)" ::: "memory");
            const unsigned og = xb_add(&bar[XB_TOP], 1u);
            const unsigned tg = og / nx;
            if (og + 1u == (tg + 1u) * nx) xb_add(&bar[XB_TOPGEN], 1u);
            else XB_SPIN(xb_ld(&bar[XB_TOPGEN]) == tg, bar);
            __builtin_amdgcn_fence(__ATOMIC_ACQUIRE, "agent");
            xb_add(&bar[XB_XGEN(b.x)], 1u);
            asm volatile("s_waitcnt vmcnt(0)" ::: "memory");
        } else {
            XB_SPIN(xb_ld(&bar[XB_XGEN(b.x)]) == gen, bar);
            __builtin_amdgcn_fence(__ATOMIC_ACQUIRE, "agent");
            asm volatile("s_waitcnt vmcnt(0)" ::: "memory");
        }
    }
    __syncthreads();
}

constexpr int NWAVES = 8;
constexpr int BATCH = 2, SEQ = 8192, DM = 1024, CTXL = 256, DEPTH = 4;
constexpr int RL = BATCH * SEQ, RC = BATCH * CTXL, RT = RL + RC;
constexpr int KVB = SEQ + CTXL;
constexpr int NE = 32, TOPK = 4, CAPB = 296, CAP = CAPB * 256;
constexpr float LN_EPS = 1e-5f, RMS_EPS = 1e-5f;
constexpr float DN_ALPHA = 1.6817928305074290f;
constexpr int MODK = 16;
#ifndef ONE_LAUNCH
#define ONE_LAUNCH 1
#endif
#ifndef DEBUG_CODES
#define DEBUG_CODES 0
#endif

constexpr size_t MiB = 1u << 20;
constexpr size_t WS_CTL = 0, CTL_ZERO_BYTES = 1 * MiB;
constexpr size_t WS_MODP = 1 * MiB, WS_MOD = 6 * MiB, WS_TAB = 7 * MiB;
constexpr size_t WS_WQKV = 8 * MiB, WS_WO = 20 * MiB, WS_FNIN = 24 * MiB, WS_FNOUT = 28 * MiB, WS_WGU = 32 * MiB, WS_WD = 544 * MiB;
constexpr size_t WS_X = 800 * MiB, WS_A1 = 868 * MiB, WS_A2 = 902 * MiB, WS_Q = 936 * MiB, WS_K = 970 * MiB, WS_V = 1004 * MiB, WS_O0 = 1038 * MiB, WS_O1 = 1072 * MiB;
constexpr size_t WS_MIX = 1106 * MiB, WS_Y = 1140 * MiB, WS_U = 1174 * MiB, WS_U2 = 1208 * MiB, WS_Z1 = 1242 * MiB, WS_ZC = 1306 * MiB, WS_T = 1308 * MiB;
constexpr size_t WS_AMOE = 1372 * MiB, WS_ACT = 1520 * MiB, WS_OUTM = 1668 * MiB, WS_GATE = 1816 * MiB, WS_DEST = 1817 * MiB, WS_ASGE = 1818 * MiB, WS_ASGS = 1819 * MiB, WS_ASGG = 1820 * MiB;
constexpr size_t WS_WGB = 1821 * MiB, WS_WRT = 1822 * MiB, WS_END = 1823 * MiB;
constexpr size_t TB_ROPEC = 0, TB_ROPES = 8192, TB_TWC = 16384, TB_TWS = 49152, TB_DFTC = 81920, TB_DFT1 = 147456, TB_DFT2 = 278528, TB_DFT256 = 344064;
constexpr int CW_DBG = 8, CW_BAR = 4096, CW_CNT = 16384;

constexpr int RING_OFF = 0, RING_BYTES = 131072;
constexpr int LDSCTL_OFF = RING_BYTES, MISC_OFF = LDSCTL_OFF + 320;
constexpr int TAB_OFF = LDSCTL_OFF + 1024;
constexpr int LDS_BYTES = 147456;

__device__ __forceinline__ float shx(float v, int o, int lane) { return __builtin_bit_cast(float, __builtin_amdgcn_ds_bpermute((lane ^ o) << 2, __builtin_bit_cast(int, v))); }
__device__ __forceinline__ int shxi(int v, int o, int lane) { return __builtin_amdgcn_ds_bpermute((lane ^ o) << 2, v); }
__device__ __forceinline__ int shli(int v, int src) { return __builtin_amdgcn_ds_bpermute(src << 2, v); }
__device__ __forceinline__ float wave_sum(float v, int lane) {
#pragma unroll
    for (int o = 1; o < 64; o <<= 1) v += shx(v, o, lane);
    return v;
}
__device__ __forceinline__ float wave_max(float v, int lane) {
#pragma unroll
    for (int o = 1; o < 64; o <<= 1) v = fmaxf(v, shx(v, o, lane));
    return v;
}
__device__ __forceinline__ int wave_min_i(int v, int lane) {
#pragma unroll
    for (int o = 1; o < 64; o <<= 1) { const int w = shxi(v, o, lane); v = w < v ? w : v; }
    return v;
}
__device__ __forceinline__ float bf2f(unsigned h) { return __builtin_bit_cast(float, h << 16); }

__device__ __forceinline__ void ld_f32(const float* p, int lane, float (&v)[16]) {
#pragma unroll
    for (int j = 0; j < 2; ++j) { const f32x4 a = *(const f32x4*)(p + 512 * j + 8 * lane), b = *(const f32x4*)(p + 512 * j + 8 * lane + 4);
        v[8 * j + 0] = a[0]; v[8 * j + 1] = a[1]; v[8 * j + 2] = a[2]; v[8 * j + 3] = a[3]; v[8 * j + 4] = b[0]; v[8 * j + 5] = b[1]; v[8 * j + 6] = b[2]; v[8 * j + 7] = b[3]; }
}
__device__ __forceinline__ void st_f32(float* p, int lane, const float (&v)[16]) {
#pragma unroll
    for (int j = 0; j < 2; ++j) { *(f32x4*)(p + 512 * j + 8 * lane) = (f32x4){v[8 * j], v[8 * j + 1], v[8 * j + 2], v[8 * j + 3]}; *(f32x4*)(p + 512 * j + 8 * lane + 4) = (f32x4){v[8 * j + 4], v[8 * j + 5], v[8 * j + 6], v[8 * j + 7]}; }
}
__device__ __forceinline__ void ld_bf16(const bf16* p, int lane, float (&v)[16]) {
#pragma unroll
    for (int j = 0; j < 2; ++j) { const v4u w = *(const v4u*)(p + 512 * j + 8 * lane);
        v[8 * j + 0] = bf2f(w.x & 0xffffu); v[8 * j + 1] = bf2f(w.x >> 16); v[8 * j + 2] = bf2f(w.y & 0xffffu); v[8 * j + 3] = bf2f(w.y >> 16);
        v[8 * j + 4] = bf2f(w.z & 0xffffu); v[8 * j + 5] = bf2f(w.z >> 16); v[8 * j + 6] = bf2f(w.w & 0xffffu); v[8 * j + 7] = bf2f(w.w >> 16); }
}
__device__ __forceinline__ void st_bf16(bf16* p, int lane, const float (&v)[16]) {
#pragma unroll
    for (int j = 0; j < 2; ++j) { v4u w; w.x = pk2(v[8 * j], v[8 * j + 1]); w.y = pk2(v[8 * j + 2], v[8 * j + 3]); w.z = pk2(v[8 * j + 4], v[8 * j + 5]); w.w = pk2(v[8 * j + 6], v[8 * j + 7]); *(v4u*)(p + 512 * j + 8 * lane) = w; }
}
__device__ __forceinline__ void ln_row(float (&v)[16], const float* g, const float* b, int lane) {
    float s = 0.f;
#pragma unroll
    for (int t = 0; t < 16; ++t) s += v[t];
    const float mean = wave_sum(s, lane) * (1.f / 1024.f); float q = 0.f;
#pragma unroll
    for (int t = 0; t < 16; ++t) { v[t] -= mean; q += v[t] * v[t]; }
    const float rstd = 1.f / sqrtf(wave_sum(q, lane) * (1.f / 1024.f) + LN_EPS);
    float gg[16], bb[16]; ld_f32(g, lane, gg); ld_f32(b, lane, bb);
#pragma unroll
    for (int t = 0; t < 16; ++t) v[t] = v[t] * rstd * gg[t] + bb[t];
}

__device__ __forceinline__ void transpose_item(const float* W, int K, int N, bf16* WT, LAS float* scr, int k0, int n0, int lane) {
#pragma unroll 8
    for (int i = 0; i < 32; ++i) { const int kk = 2 * i + (lane >> 5); scr[kk * 33 + (lane & 31)] = W[(size_t)(k0 + kk) * N + n0 + (lane & 31)]; }
    LDS_WAIT(); asm volatile("" ::: "memory");
    const int c = lane & 7;
#pragma unroll
    for (int j = 0; j < 4; ++j) { const int n = (lane >> 3) + 8 * j; const LAS float* s = scr + (8 * c) * 33 + n;
        v4u o; o.x = pk2(s[0 * 33], s[1 * 33]); o.y = pk2(s[2 * 33], s[3 * 33]); o.z = pk2(s[4 * 33], s[5 * 33]); o.w = pk2(s[6 * 33], s[7 * 33]);
        *(GAS v4u*)(WT + (size_t)n * K + k0 + 8 * c) = o; }
    LDS_WAIT(); asm volatile("" ::: "memory");
}
__device__ __forceinline__ float silu_f(float x) { return x / (1.f + expf(-x)); }

struct Args { const float* in[21]; float* out; unsigned char* ws; int ph_lo, ph_hi; };

typedef const float* cfptr_t;
typedef const cfptr_t __attribute__((address_space(4)))* kin_t;
#define PHASE_BASES unsigned long long wsi_ = (unsigned long long)args.ws; asm volatile("" : "+s"(wsi_)); GAS unsigned char* w_ = (GAS unsigned char*)wsi_; kin_t in_ = (kin_t)__builtin_amdgcn_kernarg_segment_ptr(); asm volatile("" : "+s"(in_)); \
    int tid_o_ = threadIdx.x; asm volatile("" : "+v"(tid_o_)); const int tid = tid_o_, lane = tid & 63; (void)tid; (void)lane; (void)in_;
#define WSP(T, off) ((T*)(GAS T*)(w_ + (off)))
#define INP(k) ((const float*)(const GAS float*)(unsigned long long)in_[k])
#define MODP(i, s, part) (WSP(float, WS_MOD) + (size_t)((((i) * 3 + (s)) * 6 + (part)) * 1024))

__global__ void __launch_bounds__(NWAVES * 64, 2) fwd_kernel(Args args) {
    extern __shared__ __attribute__((aligned(16))) unsigned char lds[];
    LAS unsigned char* const L = (LAS unsigned char*)lds;
    volatile LAS unsigned* const MISC = (volatile LAS unsigned*)(L + MISC_OFF);
    LAS int* const TAB = (LAS int*)(L + TAB_OFF);
    const int tid = threadIdx.x, lane = tid & 63, wave = __builtin_amdgcn_readfirstlane(tid >> 6);
    const int G = gridDim.x; const int bx = blockIdx.x; const int vcu = (G % 8 == 0) ? (bx % 8) * (G / 8) + bx / 8 : bx;
    const int gw = vcu * NWAVES + wave, NGW = G * NWAVES;

    for (int u = tid; u < (LDS_BYTES - LDSCTL_OFF) / 4; u += NWAVES * 64) ((LAS unsigned*)(L + LDSCTL_OFF))[u] = 0u;
    __syncthreads();
    XcdBarrier bar; bar.bar = (unsigned*)(args.ws + WS_CTL) + CW_BAR; bar.x = 0; bar.st = nullptr;
#if ONE_LAUNCH
    bar = xcd_barrier_post((unsigned*)(args.ws + WS_CTL) + CW_BAR, MISC + 8);
#define GRID_BAR() xcd_barrier(bar)
#else
#define GRID_BAR() do { } while (0)
#endif
    const int lo = args.ph_lo, hi = args.ph_hi;
#define IN(k) (lo <= (k) && (k) < hi)
#define SEAM(k) do { if (IN(k) && IN((k) + 1)) GRID_BAR(); } while (0)
#ifndef PHASE_MASK
#define PHASE_MASK 0xffffffffu
#endif
#ifndef PHASE_MASK0
#define PHASE_MASK0 7u
#endif
#define INL(t, bit) (((PHASE_MASK >> (bit)) & 1u) && IN(pb + (t)))
#define INL0(k) (((PHASE_MASK0 >> (k)) & 1u) && IN(k))

    if (INL0(0)) {
        PHASE_BASES
        LAS float* scr = (LAS float*)(L + RING_OFF + wave * 16384);
        {
            const float* W = INP(8); bf16* WT = WSP(bf16, WS_WQKV);
            for (int it = gw; it < 2 * 1536; it += NGW) { const int j = it / 1536, r = it % 1536, kb = r / 96, nb = r % 96;
                transpose_item(W + (size_t)j * 1024 * 3072, 1024, 3072, WT + (size_t)j * 3072 * 1024 + (size_t)(nb * 32) * 1024, scr, kb * 64, nb * 32, lane); }
        }
        {
            for (int it = gw; it < 6 * 512; it += NGW) { const int mat = it / 512, r = it % 512, kb = r / 32, nb = r % 32;
                const float* W = (mat < 2 ? INP(11) : (mat < 4 ? INP(12) : INP(14))) + (size_t)(mat & 1) * 1024 * 1024;
                bf16* WT = (bf16*)(GAS bf16*)(w_ + (mat < 2 ? WS_WO : (mat < 4 ? WS_FNIN : WS_FNOUT))) + (size_t)(mat & 1) * 1024 * 1024;
                transpose_item(W, 1024, 1024, WT + (size_t)(nb * 32) * 1024, scr, kb * 64, nb * 32, lane); }
        }
        {
            const float* W = INP(17); bf16* WT = WSP(bf16, WS_WGU);
            for (int it = gw; it < 128 * 1024; it += NGW) { const int mat = it >> 10, r = it & 1023, kb = r >> 6, nb = r & 63, n0 = nb * 32;
                const int drow = n0 < 1024 ? ((n0 >> 7) * 256 + (n0 & 127)) : ((((n0 - 1024) >> 7) * 256) + 128 + ((n0 - 1024) & 127));
                transpose_item(W + (size_t)mat * 1024 * 2048, 1024, 2048, WT + (size_t)mat * 2048 * 1024 + (size_t)drow * 1024, scr, kb * 64, n0, lane); }
        }
        {
            const float* W = INP(19); bf16* WT = WSP(bf16, WS_WD);
            for (int it = gw; it < 128 * 512; it += NGW) { const int mat = it >> 9, r = it & 511, kb = r >> 5, nb = r & 31;
                transpose_item(W + (size_t)mat * 1024 * 1024, 1024, 1024, WT + (size_t)mat * 1024 * 1024 + (size_t)(nb * 32) * 1024, scr, kb * 64, nb * 32, lane); }
        }
        {
            const float* wm = INP(4); const float* cv = INP(1); const float* cc = INP(3); float* MODPART = WSP(float, WS_MODP);
            for (int it = gw; it < 4 * 24 * MODK; it += NGW) { const int kc = it % MODK, rest = it / MODK, cb = rest % 24, i = rest / 24, n = cb * 256 + 4 * lane;
                f32x4 a0 = {0.f, 0.f, 0.f, 0.f}, a1 = a0, a2 = a0;
#pragma unroll 8
                for (int kk = 0; kk < 64; ++kk) { const int k = kc * 64 + kk; const f32x4 w = *(const f32x4*)(wm + ((size_t)i * 1024 + k) * 6144 + n);
                    const float s0 = silu_f(cv[k]), s1 = silu_f(cv[1024 + k]), s2 = silu_f(cc[k]); a0 += w * s0; a1 += w * s1; a2 += w * s2; }
                float* o = MODPART + (size_t)((kc * 4 + i) * 3) * 6144 + n;
                *(f32x4*)(o) = a0; *(f32x4*)(o + 6144) = a1; *(f32x4*)(o + 2 * 6144) = a2; }
        }
        {
            float* ROPEC = WSP(float, WS_TAB + TB_ROPEC); float* ROPES = WSP(float, WS_TAB + TB_ROPES); float* TWC = WSP(float, WS_TAB + TB_TWC); float* TWS = WSP(float, WS_TAB + TB_TWS);
            bf16* DFTC = WSP(bf16, WS_TAB + TB_DFTC); bf16* DFT1 = WSP(bf16, WS_TAB + TB_DFT1); bf16* DFT2 = WSP(bf16, WS_TAB + TB_DFT2); bf16* DFT256 = WSP(bf16, WS_TAB + TB_DFT256);
            const int gt = gw * 64 + lane, NT_ = NGW * 64;
            for (int idx = gt; idx < 2048; idx += NT_) { const int pos = idx >> 4, f = idx & 15; const float inv = powf(10000.f, -(float)f / 16.f); const float ang = (float)pos * inv; ROPEC[idx] = cosf(ang); ROPES[idx] = sinf(ang); }
            for (int idx = gt; idx < 8192; idx += NT_) { const int kl = idx >> 6, nl = idx & 63; float s, c; sincospif(2.f * (float)(kl * nl) / 8192.f, &s, &c); TWC[idx] = c; TWS[idx] = s; }
            for (int idx = gt; idx < 256 * 128; idx += NT_) { const int row = idx >> 7, cc2 = idx & 127, reim = row >> 7, m = row & 127; float s, c; sincospif(2.f * (float)((m * cc2) & 127) / 128.f, &s, &c);
                DFTC[idx] = (bf16)f2bf((reim ? -s : c) * 0.08838834764831845f); }
            for (int idx = gt; idx < 256 * 256; idx += NT_) { const int row = idx >> 8, col = idx & 255, ro = row >> 7, kl = row & 127, ri = col >> 7, nh = col & 127; float s, c; sincospif(2.f * (float)((nh * kl) & 127) / 128.f, &s, &c);
                const float v = (ro == ri) ? c : (ro == 0 ? s : -s); DFT1[idx] = (bf16)f2bf(v * 0.08838834764831845f); }
            for (int idx = gt; idx < 256 * 128; idx += NT_) { const int row = idx >> 7, col = idx & 127, ri = col >> 6, nl = col & 63; float s, c; sincospif(2.f * (float)((nl * row) & 63) / 64.f, &s, &c);
                DFT2[idx] = (bf16)f2bf(row < 64 ? (ri ? s : c) * 0.125f : 0.f); }
            for (int idx = gt; idx < 256 * 512; idx += NT_) { const int row = idx >> 9, col = idx & 511, ri = col >> 8, j = col & 255; float s, c; sincospif(2.f * (float)((j * row) & 255) / 256.f, &s, &c);
                DFT256[idx] = (bf16)f2bf((ri ? s : c) * 0.0625f); }
            const float* wr = INP(15); float* WRT = WSP(float, WS_WRT);
            for (int idx = gt; idx < 4 * 32768; idx += NT_) { const int ly = idx >> 15, rem = idx & 32767, k = rem >> 5, e = rem & 31;
                const int j = k >> 9, l = (k & 511) >> 3, h = (k >> 2) & 1, t = k & 3, q = 2 * j + h; WRT[(size_t)ly * 32768 + ((e * 4 + q) * 64 + l) * 4 + t] = wr[idx]; }
        }
    }
    SEAM(0);
    if (INL0(1)) {
        PHASE_BASES
        const float* bm = INP(5); const float* MODPART = WSP(float, WS_MODP); float* MOD = WSP(float, WS_MOD);
        for (int idx = gw * 64 + lane; idx < 4 * 3 * 6144; idx += NGW * 64) { const int n = idx % 6144, is = idx / 6144, i = is / 3; float a = bm[i * 6144 + n];
#pragma unroll
            for (int kc = 0; kc < MODK; ++kc) a += MODPART[(size_t)kc * (4 * 3 * 6144) + idx];
            MOD[idx] = a; }
    }
    SEAM(1);
    if (INL0(2)) {
        PHASE_BASES
        const float* xin = INP(0); const float* cin = INP(2); float* X = WSP(float, WS_X); bf16* A1 = WSP(bf16, WS_A1);
        for (int r = gw; r < RT; r += NGW) { const int s = r < RL ? (r >> 13) : 2; const float* src = r < RL ? xin + (size_t)r * 1024 : cin + (size_t)(r - RL) * 1024;
            float v[16], sc[16], sh[16]; ld_f32(src, lane, v); st_f32(X + (size_t)r * 1024, lane, v); ld_f32(MODP(0, s, 1), lane, sc); ld_f32(MODP(0, s, 0), lane, sh);
#pragma unroll
            for (int t = 0; t < 16; ++t) v[t] = v[t] * (1.f + sc[t]) + sh[t];
            st_bf16(A1 + (size_t)r * 1024, lane, v); }
    }
    SEAM(2);

    for (int ly = 0; ly < DEPTH; ++ly) {
        const int pb = 3 + ly * 12;
        const int jj = ly >> 1;
        const bool ctx_full = ly < 2;
        const int nrows = ctx_full ? RT : RL;
        const int nMt = (ly < 3) ? (RT / 256) : (RL / 256);
        if ((ly & 1) == 0) {
            if (INL(0, 0)) {
                PHASE_BASES
                pg8::Gemm g{WSP(bf16, WS_A1), WSP(bf16, WS_WQKV) + (size_t)jj * 3072 * 1024, nMt * 256, 3072, 1024}; pg8::StaticOrder S; S.init(nMt * 256, 3072, G, bx);
                pg8::EpiQKV E{WSP(bf16, WS_Q), (unsigned)((WS_K - WS_Q) / 2), WSP(float, WS_TAB + TB_ROPEC), WSP(float, WS_TAB + TB_ROPES), 0.125f * 1.4426950408889634f};
                static_assert(WS_V - WS_K == WS_K - WS_Q, "Q | K | V equally spaced");
                pg8::gemm_phase<pg8::EpiQKV, pg8::StaticOrder, true, true>(L + RING_OFF, g, S, E);
            }
            SEAM(pb + 0);
            if (INL(1, 1)) {
                PHASE_BASES
                const int NU = 2048 + (ly == 0 ? 64 : 0);
                for (int U = vcu; U < NU; U += G) {
                    long qrow0, krow0; int NTt, hq, hv, c;
                    if (U < 2048) { const int s = U & 7, grp = (U >> 3) & 31, it = U >> 8, b = grp >> 4, v = it >> 2, qb = s + 8 * (it & 3); hq = grp & 15; hv = (hq & ~1) | v; c = hq & 1;
                        qrow0 = (long)b * SEQ + qb * 256; krow0 = (long)b * KVB; NTt = KVB / 64; }
                    else { const int w = U - 2048, b = w >> 5, v = w & 1; hq = (w & 31) >> 1; hv = (hq & ~1) | v; c = hq & 1; qrow0 = RL + (long)b * CTXL; krow0 = (long)b * KVB + SEQ; NTt = CTXL / 64; }
                    attn_body::attn_unit<8>(qrow0, krow0, NTt, hq, hv, WSP(const attn_body::bf16, WS_Q), WSP(const attn_body::bf16, WS_K), WSP(const attn_body::bf16, WS_V),
                                            (attn_body::bf16*)(GAS attn_body::bf16*)(w_ + (c ? WS_O1 : WS_O0)), (char*)lds + RING_OFF);
                }
            }
            SEAM(pb + 1);
            if (INL(2, 2)) {
                PHASE_BASES
                const bf16* O0 = WSP(bf16, WS_O0); const bf16* O1 = WSP(bf16, WS_O1); bf16* MIX = WSP(bf16, WS_MIX);
                const float* lamp = INP(9) + jj * 256; const float* sg = INP(10) + jj * 128;
                const float linit = 0.8f - 0.6f * expf(-0.3f * (float)ly);
                const float d1 = wave_sum(lamp[lane] * lamp[64 + lane], lane), d2 = wave_sum(lamp[128 + lane] * lamp[192 + lane], lane);
                const float lam = expf(d1) - expf(d2) + linit;
                float gs[8];
#pragma unroll
                for (int t = 0; t < 8; ++t) gs[t] = sg[(8 * lane + t) & 127] * (1.f - linit);
                const int nr = (ly == 0) ? RT : RL;
                for (int r = gw; r < nr; r += NGW) { float a[16], b[16]; ld_bf16(O0 + (size_t)r * 1024, lane, a); ld_bf16(O1 + (size_t)r * 1024, lane, b);
#pragma unroll
                    for (int j = 0; j < 2; ++j) { float q = 0.f;
#pragma unroll
                        for (int t = 0; t < 8; ++t) { a[8 * j + t] -= lam * b[8 * j + t]; q += a[8 * j + t] * a[8 * j + t]; }
                        q += shx(q, 1, lane); q += shx(q, 2, lane); q += shx(q, 4, lane); q += shx(q, 8, lane);
                        const float rs = 1.f / sqrtf(q * (1.f / 128.f) + RMS_EPS);
#pragma unroll
                        for (int t = 0; t < 8; ++t) a[8 * j + t] = a[8 * j + t] * rs * gs[t]; }
                    st_bf16(MIX + (size_t)r * 1024, lane, a); }
            }
            SEAM(pb + 2);
        } else {
            if (INL(0, 16)) {
                PHASE_BASES
                pg8::Gemm g{WSP(bf16, WS_A1), WSP(bf16, WS_FNIN) + (size_t)jj * 1024 * 1024, nrows, 1024, 1024}; pg8::StaticOrder S; S.init(nrows, 1024, G, bx);
                pg8::EpiBf16<0> E{WSP(bf16, WS_U), 1024, nullptr, 0, 0, 1.f};
                pg8::gemm_phase<pg8::EpiBf16<0>, pg8::StaticOrder, true, true>(L + RING_OFF, g, S, E);
            }
            SEAM(pb + 0);
            if (INL(1, 17)) {
                PHASE_BASES
                const bf16* Ub = WSP(bf16, WS_U); bf16* U2 = WSP(bf16, WS_U2);
                const float* ng = INP(13) + jj * 1024; float gg[16]; ld_f32(ng, lane, gg);
                for (int r = gw; r < nrows; r += NGW) { float a[16]; ld_bf16(Ub + (size_t)r * 1024, lane, a);
#pragma unroll
                    for (int j = 0; j < 2; ++j) { float q = 0.f;
#pragma unroll
                        for (int t = 0; t < 8; ++t) q += a[8 * j + t] * a[8 * j + t];
                        q += shx(q, 1, lane); q += shx(q, 2, lane); q += shx(q, 4, lane); q += shx(q, 8, lane);
                        const float rs = 1.f / sqrtf(q * (1.f / 128.f) + RMS_EPS);
                        v4u w; w.x = pk2(a[8 * j] * rs * gg[8 * j], a[8 * j + 1] * rs * gg[8 * j + 1]); w.y = pk2(a[8 * j + 2] * rs * gg[8 * j + 2], a[8 * j + 3] * rs * gg[8 * j + 3]);
                        w.z = pk2(a[8 * j + 4] * rs * gg[8 * j + 4], a[8 * j + 5] * rs * gg[8 * j + 5]); w.w = pk2(a[8 * j + 6] * rs * gg[8 * j + 6], a[8 * j + 7] * rs * gg[8 * j + 7]);
                        const int gq = 4 * j + (lane >> 4), cc = (8 * lane) & 127;
                        size_t drow;
                        if (r < RL) { const int b = r >> 13, n = r & 8191, n_hi = n >> 6, n_lo = n & 63; drow = ((size_t)(b * 8 + gq) * 64 + n_lo) * 128 + n_hi; }
                        else { const int rc = r - RL, b = rc >> 8, jx = rc & 255; drow = 131072 + (size_t)(b * 8 + gq) * 256 + jx; }
                        *(v4u*)(U2 + drow * 128 + cc) = w; } }
            }
            SEAM(pb + 1);
            if (INL(2, 18)) {
                PHASE_BASES
                int kk_ = 128; asm volatile("" : "+s"(kk_)); pg8::Gemm g{WSP(bf16, WS_TAB + TB_DFTC), WSP(bf16, WS_U2), 256, 0, kk_}; pg8::LinearOrder S{ctx_full ? 528 : 512, G, vcu};
                pg8::EpiZ1 E{WSP(bf16, WS_Z1), WSP(bf16, WS_ZC)};
                pg8::gemm_phase<pg8::EpiZ1, pg8::LinearOrder, true, true>(L + RING_OFF, g, S, E);
            }
            SEAM(pb + 2);
            if (INL(3, 19)) {
                PHASE_BASES
                int kk_ = 256; asm volatile("" : "+s"(kk_)); pg8::Gemm g{WSP(bf16, WS_TAB + TB_DFT1), WSP(bf16, WS_Z1), 256, 0, kk_}; pg8::LinearOrder S{512, G, vcu};
                pg8::EpiFFT1 E{WSP(bf16, WS_T), WSP(float, WS_TAB + TB_TWC), WSP(float, WS_TAB + TB_TWS)};
                pg8::gemm_phase<pg8::EpiFFT1, pg8::LinearOrder, true, true>(L + RING_OFF, g, S, E);
            }
            SEAM(pb + 3);
            if (INL(4, 20)) {
                { PHASE_BASES
                  int kk_ = 128; asm volatile("" : "+s"(kk_)); pg8::Gemm g{WSP(bf16, WS_TAB + TB_DFT2), WSP(bf16, WS_T), 256, 0, kk_}; pg8::LinearOrder S{1024, G, vcu};
                  pg8::EpiFFT2 E{WSP(bf16, WS_MIX)};
                  pg8::gemm_phase<pg8::EpiFFT2, pg8::LinearOrder, true, true>(L + RING_OFF, g, S, E); }
                if (ctx_full) { __syncthreads();
                  PHASE_BASES
                  int kk_ = 512; asm volatile("" : "+s"(kk_)); pg8::Gemm g{WSP(bf16, WS_TAB + TB_DFT256), WSP(bf16, WS_ZC), 256, 0, kk_}; pg8::LinearOrder S{8, G, vcu};
                  pg8::EpiDFT256 E{WSP(bf16, WS_MIX)};
                  pg8::gemm_phase<pg8::EpiDFT256, pg8::LinearOrder, true, true>(L + RING_OFF, g, S, E); }
            }
            SEAM(pb + 4);
        }
        if (INL(5, 5)) {
            PHASE_BASES
            const bf16* Wt = (const bf16*)(const GAS bf16*)(w_ + ((ly & 1) ? WS_FNOUT : WS_WO)) + (size_t)jj * 1024 * 1024;
            pg8::Gemm g{WSP(bf16, WS_MIX), Wt, nrows, 1024, 1024}; pg8::StaticOrder S; S.init(nrows, 1024, G, bx);
            pg8::EpiBf16<0> E{WSP(bf16, WS_Y), 1024, nullptr, 0, 0, 1.f};
            pg8::gemm_phase<pg8::EpiBf16<0>, pg8::StaticOrder, true, true>(L + RING_OFF, g, S, E);
        }
        SEAM(pb + 5);
        if (INL(6, 6)) {
            PHASE_BASES
            LAS float* WR = (LAS float*)(L + RING_OFF);
            { const v4u* src = (const v4u*)(WSP(float, WS_WRT) + (size_t)ly * 32768); for (int q = tid; q < 8192; q += NWAVES * 64) ((LAS v4u*)WR)[q] = src[q]; }
            if (tid < 32) TAB[tid] = 0;
            __syncthreads();
            float* X = WSP(float, WS_X); const bf16* Y = WSP(bf16, WS_Y); bf16* A2 = WSP(bf16, WS_A2);
            const float* brt = INP(16) + ly * 32; const float* lng = INP(6) + (size_t)(ly * 2) * 1024; const float* lnb = INP(7) + (size_t)(ly * 2) * 1024;
            int* const asg_e = WSP(int, WS_ASGE); int* const asg_s = WSP(int, WS_ASGS); float* const asg_g = WSP(float, WS_ASGG);
            for (int r = gw; r < nrows; r += NGW) { const int s = r < RL ? (r >> 13) : 2;
                float v[16];
                { float y[16], g1[16]; ld_f32(X + (size_t)r * 1024, lane, v); ld_bf16(Y + (size_t)r * 1024, lane, y); ld_f32(MODP(ly, s, 2), lane, g1);
#pragma unroll
                  for (int t = 0; t < 16; ++t) v[t] = DN_ALPHA * v[t] + g1[t] * y[t]; }
                ln_row(v, lng, lnb, lane);
                st_f32(X + (size_t)r * 1024, lane, v);
                { float sc[16], sh[16]; ld_f32(MODP(ly, s, 4), lane, sc); ld_f32(MODP(ly, s, 3), lane, sh);
#pragma unroll
                  for (int t = 0; t < 16; ++t) v[t] = v[t] * (1.f + sc[t]) + sh[t]; }
                st_bf16(A2 + (size_t)r * 1024, lane, v);
                float p[32];
#pragma unroll
                for (int e = 0; e < 32; ++e) { float a = 0.f;
#pragma unroll
                    for (int q = 0; q < 4; ++q) { const f32x4 w = *(const LAS f32x4*)(WR + ((e * 4 + q) * 64 + lane) * 4);
                        a += v[4 * q] * w[0] + v[4 * q + 1] * w[1] + v[4 * q + 2] * w[2] + v[4 * q + 3] * w[3]; }
                    p[e] = a; }
#define RSTEP(half, msk) { const bool up = (lane & (msk)) != 0; _Pragma("unroll") for (int t = 0; t < (half); ++t) { const float keep = up ? p[t + (half)] : p[t], send = up ? p[t] : p[t + (half)]; p[t] = keep + shx(send, (msk), lane); } }
                RSTEP(16, 32) RSTEP(8, 16) RSTEP(4, 8) RSTEP(2, 4) RSTEP(1, 2)
#undef RSTEP
                float lg = p[0] + shx(p[0], 1, lane);
                const int myE = (lane >> 1) & 31;
                lg += brt[myE];
                float val = (lane & 1) ? -INFINITY : lg;
                float tv[4]; int te[4];
#pragma unroll
                for (int k = 0; k < 4; ++k) { const float m = wave_max(val, lane); const int idx = wave_min_i(val == m ? myE : 99, lane); tv[k] = m; te[k] = idx; if (myE == idx) val = -INFINITY; }
                const float e1 = expf(tv[1] - tv[0]), e2 = expf(tv[2] - tv[0]), e3 = expf(tv[3] - tv[0]); const float inv = 1.f / (1.f + e1 + e2 + e3);
                if (lane < 4) { const int ee = lane == 0 ? te[0] : (lane == 1 ? te[1] : (lane == 2 ? te[2] : te[3])); const float gg = (lane == 0 ? 1.f : (lane == 1 ? e1 : (lane == 2 ? e2 : e3))) * inv;
                    const int sl = __hip_atomic_fetch_add(TAB + ee, 1, __ATOMIC_RELAXED, __HIP_MEMORY_SCOPE_WORKGROUP);
                    asg_e[r * 4 + lane] = ee; asg_s[r * 4 + lane] = sl; asg_g[r * 4 + lane] = gg; }
            }
            __syncthreads();
            if (tid < 32) { int* counts = WSP(int, WS_CTL) + CW_CNT; const int h = TAB[tid]; const int base = h ? __hip_atomic_fetch_add(counts + ly * 32 + tid, h, __ATOMIC_RELAXED, __HIP_MEMORY_SCOPE_AGENT) : 0; WSP(int, WS_WGB)[vcu * 32 + tid] = base; }
        }
        SEAM(pb + 6);
        if (INL(7, 7)) {
            PHASE_BASES
            const int* counts = WSP(int, WS_CTL) + CW_CNT;
            if (tid < 32) { int acc = 0; for (int e = 0; e < tid; ++e) acc += ((counts[ly * 32 + e] + 255) >> 8) << 8; TAB[32 + tid] = acc; }
            __syncthreads();
            const int* asg_e = WSP(int, WS_ASGE); const int* asg_s = WSP(int, WS_ASGS); const float* asg_g = WSP(float, WS_ASGG); const int* wgb = WSP(int, WS_WGB);
            const bf16* A2 = WSP(bf16, WS_A2); bf16* const AM = WSP(bf16, WS_AMOE); float* const gate = WSP(float, WS_GATE); int* const dest = WSP(int, WS_DEST);
            for (int r = gw; r < nrows; r += NGW) {
                int d = 0;
                if (lane < 4) { const int e = asg_e[r * 4 + lane]; d = TAB[32 + e] + wgb[((r % NGW) >> 3) * 32 + e] + asg_s[r * 4 + lane]; gate[d] = asg_g[r * 4 + lane]; dest[r * 4 + lane] = d; }
                const v4u w0 = *(const v4u*)(A2 + (size_t)r * 1024 + 8 * lane), w1 = *(const v4u*)(A2 + (size_t)r * 1024 + 512 + 8 * lane);
#pragma unroll
                for (int k = 0; k < 4; ++k) { const int dk = shli(d, k); *(v4u*)(AM + (size_t)dk * 1024 + 8 * lane) = w0; *(v4u*)(AM + (size_t)dk * 1024 + 512 + 8 * lane) = w1; }
            }
        }
        SEAM(pb + 7);
        if (INL(8, 8) || INL(9, 9)) {
            PHASE_BASES
            const int* counts = WSP(int, WS_CTL) + CW_CNT;
            __syncthreads();
            if (tid < CAPB + 8) { int acc = 0, ef = 31; for (int e = 0; e < 32; ++e) { const int nb = (counts[ly * 32 + e] + 255) >> 8; if (tid >= acc && tid < acc + nb) ef = e; acc += nb; } TAB[128 + tid] = ef; if (tid == 0) TAB[64] = acc; }
            __syncthreads();
        }
        if (INL(8, 8)) {
            PHASE_BASES
            const int NB = TAB[64];
            pg8::Gemm g{WSP(bf16, WS_AMOE), WSP(bf16, WS_WGU) + (size_t)ly * 32 * 2048 * 1024, 0, 0, 1024}; pg8::MoeOrder S{(const LAS int*)(TAB + 128), NB, 8, G, vcu};
            pg8::EpiSwiGLU E{WSP(bf16, WS_ACT), INP(18) + (size_t)ly * 32 * 2048};
            pg8::gemm_phase<pg8::EpiSwiGLU, pg8::MoeOrder, true, true>(L + RING_OFF, g, S, E);
        }
        SEAM(pb + 8);
        if (INL(9, 9)) {
            PHASE_BASES
            const int NB = TAB[64];
            pg8::Gemm g{WSP(bf16, WS_ACT), WSP(bf16, WS_WD) + (size_t)ly * 32 * 1024 * 1024, 0, 0, 1024}; pg8::MoeOrder S{(const LAS int*)(TAB + 128), NB, 4, G, vcu};
            pg8::EpiMoE2 E{WSP(bf16, WS_OUTM), INP(20) + (size_t)ly * 32 * 1024, WSP(float, WS_GATE)};
            pg8::gemm_phase<pg8::EpiMoE2, pg8::MoeOrder, true, true>(L + RING_OFF, g, S, E);
        }
        SEAM(pb + 9);
        if (INL(10, 10)) {
            PHASE_BASES
            const int* dest = WSP(int, WS_DEST); const bf16* OM = WSP(bf16, WS_OUTM); float* X = WSP(float, WS_X); bf16* A1 = WSP(bf16, WS_A1);
            const float* lng = INP(6) + (size_t)(ly * 2 + 1) * 1024; const float* lnb = INP(7) + (size_t)(ly * 2 + 1) * 1024;
            for (int r = gw; r < nrows; r += NGW) { const int s = r < RL ? (r >> 13) : 2;
                float v[16], acc[16];
                { const int d0 = dest[r * 4 + 0], d1 = dest[r * 4 + 1], d2 = dest[r * 4 + 2], d3 = dest[r * 4 + 3]; float t0[16], t1[16];
                  ld_bf16(OM + (size_t)d0 * 1024, lane, acc); ld_bf16(OM + (size_t)d1 * 1024, lane, t0); ld_bf16(OM + (size_t)d2 * 1024, lane, t1);
#pragma unroll
                  for (int t = 0; t < 16; ++t) acc[t] = (acc[t] + t0[t]) + t1[t];
                  ld_bf16(OM + (size_t)d3 * 1024, lane, t0);
#pragma unroll
                  for (int t = 0; t < 16; ++t) acc[t] += t0[t]; }
                { float g2[16]; ld_f32(X + (size_t)r * 1024, lane, v); ld_f32(MODP(ly, s, 5), lane, g2);
#pragma unroll
                  for (int t = 0; t < 16; ++t) v[t] = DN_ALPHA * v[t] + g2[t] * acc[t]; }
                ln_row(v, lng, lnb, lane);
                if (ly == DEPTH - 1) { st_f32((float*)(GAS float*)(unsigned long long)args.out + (size_t)r * 1024, lane, v); }
                else { st_f32(X + (size_t)r * 1024, lane, v);
                    if (r < RL || ly < 2) { float sc[16], sh[16]; ld_f32(MODP(ly + 1, s, 1), lane, sc); ld_f32(MODP(ly + 1, s, 0), lane, sh);
#pragma unroll
                        for (int t = 0; t < 16; ++t) v[t] = v[t] * (1.f + sc[t]) + sh[t];
                        st_bf16(A1 + (size_t)r * 1024, lane, v); } }
            }
        }
        SEAM(pb + 10);
    }
#if DEBUG_CODES
    {
        gu32* ctl = (gu32*)(args.ws + WS_CTL);
        unsigned code = __hip_atomic_load(ctl + CW_DBG, RLX_AGENT); if (__hip_atomic_load(ctl + CW_BAR + XB_TMO, RLX_AGENT)) code = 90;
        if (code && IN(3 + (DEPTH - 1) * 12 + 10)) { __syncthreads(); const float cv = sqrtf((float)code); for (size_t idx = (size_t)gw * 64 + lane; idx < (size_t)RL * 1024; idx += (size_t)NGW * 64) args.out[idx] = cv; }
    }
#endif
#undef IN
#undef SEAM
}

constexpr int N_PHASES = 3 + DEPTH * 12;
extern "C" void kernel_launch(void* const* d_in, const int* in_sizes, int n_in, void* d_out, int out_size, void* d_ws, size_t ws_size, hipStream_t stream) {
    static int grid = 0;
    if (grid == 0) {
        if (n_in != 21 || out_size != RL * DM || ws_size < WS_END) { fprintf(stderr, "kernel_launch: unexpected problem (n_in %d, out %d, ws %zu)\n", n_in, out_size, ws_size); grid = -1; return; }
        int dev = 0, cus = 0, per_cu = 0;
        if (hipGetDevice(&dev) != hipSuccess || hipDeviceGetAttribute(&cus, hipDeviceAttributeMultiprocessorCount, dev) != hipSuccess) { grid = -1; return; }
        if (hipFuncSetAttribute((const void*)fwd_kernel, hipFuncAttributeMaxDynamicSharedMemorySize, LDS_BYTES) != hipSuccess) { fprintf(stderr, "kernel_launch: hipFuncSetAttribute failed\n"); grid = -1; return; }
        if (hipOccupancyMaxActiveBlocksPerMultiprocessor(&per_cu, (const void*)fwd_kernel, NWAVES * 64, LDS_BYTES) != hipSuccess || per_cu < 1) { fprintf(stderr, "kernel_launch: occupancy query reports %d workgroups per CU\n", per_cu); }
        (void)hipGetLastError();
        grid = cus;
    }
    if (grid < 0) return;
    (void)hipMemsetAsync((char*)d_ws + WS_CTL, 0, CTL_ZERO_BYTES, stream);
    Args a{};
    for (int i = 0; i < 21; ++i) a.in[i] = (const float*)d_in[i];
    a.out = (float*)d_out; a.ws = (unsigned char*)d_ws;
#if ONE_LAUNCH
    a.ph_lo = 0; a.ph_hi = N_PHASES;
    hipLaunchKernelGGL(fwd_kernel, dim3(grid), dim3(NWAVES * 64), LDS_BYTES, stream, a);
#else
    for (int p = 0; p < N_PHASES; ++p) {
        const int q = (p - 3) % 12, ly = (p - 3) / 12;
        if (p >= 3) { if (q == 11) continue; if ((ly & 1) == 0 && (q == 3 || q == 4)) continue; }
        a.ph_lo = p; a.ph_hi = p + 1;
        hipLaunchKernelGGL(fwd_kernel, dim3(grid), dim3(NWAVES * 64), LDS_BYTES, stream, a);
    }
#endif
}
```

```cpp
#include <hip/hip_runtime.h>
#include <cstdio>
#include <cstdint>

namespace pg8 {
#define PG8_LAS __attribute__((address_space(3)))
typedef unsigned short bf16_t;
typedef short bf16x8 __attribute__((ext_vector_type(8)));
typedef float f32x4 __attribute__((ext_vector_type(4)));
typedef unsigned u32x4 __attribute__((ext_vector_type(4)));
typedef int i32x4_t __attribute__((ext_vector_type(4)));
template <int MODE> struct AccSel { typedef f32x4 type; };
template <> struct AccSel<1> { typedef i32x4_t type; };
constexpr int BM = 256, BK = 64, HALF = 128, HTB = HALF * BK * 2  , STAGE_BYTES = 8 * HTB, NXCD = 8, WGM = 8;

__host__ __device__ __forceinline__ int lds_byte(int r, int c) { const int st = (r >> 4) * 2 + (c >> 5), rr = r & 15, cc = c & 31, ob = rr * 64 + cc * 2; return st * 1024 + (ob ^ (((ob >> 9) & 1) << 5)); }
__host__ __device__ __forceinline__ void stage_rc(int b, int& R, int& C) { const int st = b / 1024, sb = b % 1024, swz = sb ^ (((sb >> 9) & 1) << 5); R = (st >> 1) * 16 + swz / 64; C = (st & 1) * 32 + (swz % 64) / 2; }
__host__ __device__ __forceinline__ int perm32(int rho) { const int n = rho >> 4, i = rho & 15; return 8 * (i >> 2) + 4 * n + (i & 3); }

struct Unit { int pm, pn; };
struct Gemm { const bf16_t* A; const bf16_t* Bt; int M, N, K; const int* rowidx = nullptr; PG8_LAS int* idx = nullptr; unsigned idx_max = 0xffffffffu; };

struct StaticOrder {
    int nM, nN, nwg, G, c;
    __host__ __device__ void init(int M, int N, int G_, int c_) { nM = M / BM; nN = N / BM; nwg = nM * nN; G = G_; c = c_; }
    __host__ __device__ bool next(int i, Unit& u) const {
        const long L = (long)i * G + c; if (L >= nwg) return false;
        int wgid = (int)L; { const int q = nwg / NXCD, r = nwg % NXCD, xcd = wgid % NXCD, off = wgid / NXCD; wgid = (xcd < r ? xcd * (q + 1) : r * (q + 1) + (xcd - r) * q) + off; }
        const int nig = WGM * nN, gid = wgid / nig, fm = gid * WGM, gsz = (nM - fm) < WGM ? (nM - fm) : WGM;
        u.pm = fm + ((wgid % nig) % gsz); u.pn = (wgid % nig) / gsz; return true;
    }
    __device__ __forceinline__ void a_ready(const Unit&) const {}
    __device__ __forceinline__ void done(const Unit&) const {}
};

__device__ __forceinline__ unsigned cvt_pk_bf16(float lo, float hi) { unsigned r; asm volatile("v_cvt_pk_bf16_f32 %0, %1, %2" : "=v"(r) : "v"(lo), "v"(hi)); return r; }
typedef float f32x2 __attribute__((ext_vector_type(2)));
__device__ __forceinline__ f32x2 gelu_pk(f32x2 v) {
    const f32x2 av = __builtin_elementwise_abs(v), d = av * 0.2316418882f + 1.0f;
    f32x2 t; t.x = __builtin_amdgcn_rcpf(d.x); t.y = __builtin_amdgcn_rcpf(d.y);
    f32x2 q = t * 0.5307027145f + (-0.7265760135f); q = q * t + 0.7107068705f; q = q * t + (-0.142248368f); q = q * t + 0.127414796f; q = q * t;
    const f32x2 s = (v * v) * (-0.72134752044f);
    f32x2 e; e.x = __builtin_amdgcn_exp2f(s.x); e.y = __builtin_amdgcn_exp2f(s.y);
    const f32x2 m = v * (q * e), r = v - m;
    f32x2 o; o.x = v.x < 0.f ? m.x : r.x; o.y = v.y < 0.f ? m.y : r.y; return o;
}

template <int ACT  > struct EpiBf16 {
    static constexpr bool PERM = true, AFTER_DRAIN = false; static_assert(ACT == 0 || ACT == 1, "EpiBf16: ACT is 0 (none) or 1 (gelu_pk)");
    bf16_t* O; int ldc; const float* bias; int split_cols; size_t split_stride; float scale0;
    __device__ __forceinline__ void operator()(const f32x4 (&acc)[2][2][4][2], const Unit& u, int wr, int wc, int fr, int fq) const {
        const int row0 = u.pm * BM + wr * 64 + fr; int colt = u.pn * BM; bf16_t* base = O;
        float sc = 1.f; if (split_cols) { const int t = colt / split_cols; base += (size_t)t * split_stride; colt -= t * split_cols; if (t == 0) sc = scale0; }
        const int col0 = colt + wc * 32 + 8 * fq, bcol0 = u.pn * BM + wc * 32 + 8 * fq;
        f32x4 bv[2][2];
#pragma unroll
        for (int bj = 0; bj < 2; ++bj)
#pragma unroll
            for (int n = 0; n < 2; ++n) bv[bj][n] = bias ? *(const f32x4*)(bias + bcol0 + bj * HALF + 4 * n) : (f32x4){0.f, 0.f, 0.f, 0.f};
#pragma unroll
        for (int ai = 0; ai < 2; ++ai)
#pragma unroll
            for (int m = 0; m < 4; ++m) { bf16_t* rowp = base + (size_t)(row0 + ai * HALF + m * 16) * ldc + col0;
#pragma unroll
                for (int bj = 0; bj < 2; ++bj) { f32x4 v0 = acc[ai][bj][m][0] + bv[bj][0], v1 = acc[ai][bj][m][1] + bv[bj][1];
                    if (ACT == 1) { f32x2 a = gelu_pk((f32x2){v0[0], v0[1]}), b = gelu_pk((f32x2){v0[2], v0[3]}), c = gelu_pk((f32x2){v1[0], v1[1]}), d = gelu_pk((f32x2){v1[2], v1[3]});
                        v0 = (f32x4){a.x, a.y, b.x, b.y}; v1 = (f32x4){c.x, c.y, d.x, d.y}; }
                    v0 = v0 * sc; v1 = v1 * sc; u32x4 w; w.x = cvt_pk_bf16(v0[0], v0[1]); w.y = cvt_pk_bf16(v0[2], v0[3]); w.z = cvt_pk_bf16(v1[0], v1[1]); w.w = cvt_pk_bf16(v1[2], v1[3]);
                    *(u32x4*)(rowp + bj * HALF) = w; } }
    }
};

typedef unsigned u32x2 __attribute__((ext_vector_type(2)));
__device__ __forceinline__ u32x4 pack8(const f32x4 v0, const f32x4 v1) { u32x4 w; w.x = cvt_pk_bf16(v0[0], v0[1]); w.y = cvt_pk_bf16(v0[2], v0[3]); w.z = cvt_pk_bf16(v1[0], v1[1]); w.w = cvt_pk_bf16(v1[2], v1[3]); return w; }

__device__ __forceinline__ unsigned pk4_i8(float a, float b, float c, float d) {
    const int ia = (int)__builtin_rintf(fminf(fmaxf(a, -127.f), 127.f)), ib = (int)__builtin_rintf(fminf(fmaxf(b, -127.f), 127.f));
    const int ic = (int)__builtin_rintf(fminf(fmaxf(c, -127.f), 127.f)), id = (int)__builtin_rintf(fminf(fmaxf(d, -127.f), 127.f));
    return (unsigned)(ia & 0xff) | ((unsigned)(ib & 0xff) << 8) | ((unsigned)(ic & 0xff) << 16) | ((unsigned)id << 24); }
struct LinearOrder {
    int nwg, G, c;
    __device__ __forceinline__ bool next(int i, Unit& u) const { const long L = (long)i * G + c; if (L >= nwg) return false; int z = 0; asm volatile("" : "+s"(z)); u.pm = z; u.pn = (int)L; return true; }
    __device__ __forceinline__ void a_ready(const Unit&) const {}
    __device__ __forceinline__ void done(const Unit&) const {}
};
struct MoeOrder {
    const PG8_LAS int* blk_e; int NB, NJ, G, v;
    __device__ __forceinline__ bool next(int i, Unit& u) const { const long L = (long)i * G + v; if (L >= (long)NB * NJ) return false; const int blk = (int)(L / NJ), j = (int)(L - (long)blk * NJ);
        const int w = __builtin_amdgcn_readfirstlane(blk_e[blk]); const int e = w & 255; u.pm = w >> 8; u.pn = e * NJ + j; return true; }
    __device__ __forceinline__ void a_ready(const Unit&) const {}
    __device__ __forceinline__ void done(const Unit&) const {}
};

struct EpiQKV {
    static constexpr bool PERM = false, AFTER_DRAIN = false;
    bf16_t* Q; unsigned kv_stride; const float* ropec; const float* ropes; float qscale; const float* asc; float wsc_inv; int probe = 0;
    __device__ __forceinline__ void operator()(const i32x4_t (&acc)[2][2][4][2], const Unit& u, int wr, int wc, int fr_, int fq_) const {
        int fr = fr_, fq = fq_; asm volatile("" : "+v"(fr), "+v"(fq));
        if (probe == 2) { asm volatile("" :: "v"(acc[0][0][0][0]), "v"(acc[1][1][3][1])); return; }
        const int t = u.pn >> 2;
        const bool ctx = u.pm >= 64;
        bf16_t* dst = Q + (size_t)t * kv_stride;
        const float sc = t == 0 ? qscale : 1.f;
        const bool rope = (t < 2) && !ctx;
        const unsigned colofs2 = (unsigned)((u.pn & 3) * 256 + wc * 32 + ((fq & 1) ? 16 + 4 * (fq - 1) : 4 * fq));
        const unsigned tabofs = (unsigned)(4 * fq);
        const int r0 = u.pm * 256 + wr * 64 + fr;
        float rsv[8];
#pragma unroll
        for (int g = 0; g < 8; ++g) rsv[g] = *(const float*)((const char*)asc + (unsigned)(r0 + (g >> 2) * 128 + (g & 3) * 16) * 4u);
        f32x4 cN, sN; cN = sN = (f32x4){0.f, 0.f, 0.f, 0.f};
#define QKV_TAB(g, cD, sD) { if (rope) { const int n_ = (r0 + ((g) >> 2) * 128 + ((g) & 3) * 16) & 8191; const unsigned pos_ = (unsigned)((wc & 1) ? (n_ & 63) : (n_ >> 6)); \
            cD = *(const f32x4*)((const char*)ropec + ((pos_ * 16u + tabofs) * 4u)); sD = *(const f32x4*)((const char*)ropes + ((pos_ * 16u + tabofs) * 4u)); } }
        QKV_TAB(0, cN, sN)
#pragma unroll
        for (int g = 0; g < 8; ++g) {
            const int ai = g >> 2, m = g & 3;
            const int r = r0 + ai * 128 + m * 16;
            unsigned drow;
            if (t == 0) drow = (unsigned)r;
            else if (!ctx) drow = (unsigned)(r + ((r >> 13) << 8));
            else { const int rc = r - 16384; drow = (unsigned)((rc >> 8) * 8448 + 8192 + (rc & 255)); }
            const f32x4 c4 = cN, s4 = sN;
            if (g < 7) QKV_TAB(g + 1, cN, sN)
            const unsigned off2 = drow * 1024u + colofs2;
            const float rs = rsv[g] * wsc_inv;
#pragma unroll
            for (int bj = 0; bj < 2; ++bj) {
                const f32x4 x1 = __builtin_convertvector(acc[ai][bj][m][0], f32x4) * rs, x2 = __builtin_convertvector(acc[ai][bj][m][1], f32x4) * rs;
                f32x4 o1, o2;
                if (rope) { o1 = (x1 * c4 - x2 * s4) * sc; o2 = (x2 * c4 + x1 * s4) * sc; } else { o1 = x1 * sc; o2 = x2 * sc; }
                u32x2 w1, w2; w1.x = cvt_pk_bf16(o1[0], o1[1]); w1.y = cvt_pk_bf16(o1[2], o1[3]); w2.x = cvt_pk_bf16(o2[0], o2[1]); w2.y = cvt_pk_bf16(o2[2], o2[3]);
                { const auto s0_ = __builtin_amdgcn_permlane16_swap(w1.x, w2.x, false, false); const auto s1_ = __builtin_amdgcn_permlane16_swap(w1.y, w2.y, false, false);
                  const u32x4 wv_ = {s0_[0], s1_[0], s0_[1], s1_[1]};
                  *(u32x4*)(dst + (off2 + bj * 128)) = wv_; }
            }
            asm volatile("" ::: "memory");
        }
#undef QKV_TAB
    }
};

struct EpiI8Bf16 {
    static constexpr bool PERM = true, AFTER_DRAIN = false;
    bf16_t* O; const float* asc; float wsc_inv; float cscale = 1.f;
    __device__ __forceinline__ void operator()(const i32x4_t (&acc)[2][2][4][2], const Unit& u, int wr, int wc, int fr_, int fq_) const {
        int fr = fr_, fq = fq_; asm volatile("" : "+v"(fr), "+v"(fq));
        const unsigned cofs = (unsigned)(u.pn * 256 + wc * 32 + 8 * fq);
        float rsv[8];
#pragma unroll
        for (int g = 0; g < 8; ++g) rsv[g] = asc ? *(const float*)((const char*)asc + (unsigned)(u.pm * 256 + (g >> 2) * 128 + wr * 64 + (g & 3) * 16 + fr) * 4u) : cscale;
#pragma unroll
        for (int ai = 0; ai < 2; ++ai)
#pragma unroll
            for (int m = 0; m < 4; ++m) {
                const unsigned row = (unsigned)(u.pm * 256 + ai * 128 + wr * 64 + m * 16 + fr);
                const float rs = rsv[ai * 4 + m] * wsc_inv;
#pragma unroll
                for (int bj = 0; bj < 2; ++bj) *(u32x4*)((char*)O + (row * 1024u + cofs + (unsigned)(bj * 128)) * 2u) = pack8(__builtin_convertvector(acc[ai][bj][m][0], f32x4) * rs, __builtin_convertvector(acc[ai][bj][m][1], f32x4) * rs);
                asm volatile("" ::: "memory");
            }
    }
};
struct EpiPF1 {
    static constexpr bool PERM = true, AFTER_DRAIN = false;
    bf16_t* U2; const float* asc; float wsc_inv; const float* ng; PG8_LAS float* SS; float eps; int rl;
    __device__ __forceinline__ void operator()(const i32x4_t (&acc)[2][2][4][2], const Unit& u, int wr, int wc, int fr_, int fq_) const {
        int fr = fr_, fq = fq_; asm volatile("" : "+v"(fr), "+v"(fq));
        const int lane_ = fr + 16 * fq;
        float rsv[8];
#pragma unroll
        for (int g = 0; g < 8; ++g) rsv[g] = *(const float*)((const char*)asc + (unsigned)(u.pm * 256 + (g >> 2) * 128 + wr * 64 + (g & 3) * 16 + fr) * 4u) * wsc_inv;
#pragma unroll
        for (int ai = 0; ai < 2; ++ai)
#pragma unroll
            for (int m = 0; m < 4; ++m) { const float rs = rsv[ai * 4 + m];
#pragma unroll
                for (int bj = 0; bj < 2; ++bj) { const f32x4 v0 = __builtin_convertvector(acc[ai][bj][m][0], f32x4) * rs, v1 = __builtin_convertvector(acc[ai][bj][m][1], f32x4) * rs;
                    float q = (v0[0] * v0[0] + v0[1] * v0[1]) + (v0[2] * v0[2] + v0[3] * v0[3]) + (v1[0] * v1[0] + v1[1] * v1[1]) + (v1[2] * v1[2] + v1[3] * v1[3]);
                    q += __shfl_xor(q, 16); q += __shfl_xor(q, 32);
                    if (fq == 0) SS[((ai * 128 + wr * 64 + m * 16 + fr) * 2 + bj) * 4 + wc] = q; } }
        (void)lane_;
        asm volatile("s_waitcnt lgkmcnt(0)\n\ts_barrier" ::: "memory");
        f32x4 gv[2][2];
#pragma unroll
        for (int bj = 0; bj < 2; ++bj)
#pragma unroll
            for (int n = 0; n < 2; ++n) gv[bj][n] = *(const f32x4*)(ng + u.pn * 256 + bj * 128 + wc * 32 + 8 * fq + 4 * n);
#pragma unroll
        for (int ai = 0; ai < 2; ++ai)
#pragma unroll
            for (int m = 0; m < 4; ++m) { const float rs = rsv[ai * 4 + m];
                const int rloc = ai * 128 + wr * 64 + m * 16 + fr, r = u.pm * 256 + rloc;
#pragma unroll
                for (int bj = 0; bj < 2; ++bj) { const int g = 2 * u.pn + bj;
                    const f32x4 p = *(const PG8_LAS f32x4*)(SS + (rloc * 2 + bj) * 4);
                    const float rn = rs / __builtin_sqrtf(((p[0] + p[1]) + (p[2] + p[3])) * (1.f / 128.f) + eps);
                    unsigned drow;
                    if (r < rl) { const int b = r >> 13, n_ = r & 8191; drow = (unsigned)(((b * 8 + g) * 64 + (n_ & 63)) * 128 + (n_ >> 6)); }
                    else { const int rc = r - rl; drow = 131072u + (unsigned)(((rc >> 8) * 8 + g) * 256 + (rc & 255)); }
                    *(u32x4*)((char*)U2 + (drow * 128u + (unsigned)(wc * 32 + 8 * fq)) * 2u) = pack8(__builtin_convertvector(acc[ai][bj][m][0], f32x4) * rn * gv[bj][0], __builtin_convertvector(acc[ai][bj][m][1], f32x4) * rn * gv[bj][1]); }
                asm volatile("" ::: "memory"); }
    }
};
struct EpiZ1 {
    static constexpr bool PERM = true, AFTER_DRAIN = false;
    bf16_t* Z1; bf16_t* Zc;
    __device__ __forceinline__ void operator()(const f32x4 (&acc)[2][2][4][2], const Unit& u, int wr, int wc, int fr_, int fq_) const {
        int fr = fr_, fq = fq_; asm volatile("" : "+v"(fr), "+v"(fq));
        const int mm0 = wr * 64 + fr;
#pragma unroll
        for (int bj = 0; bj < 2; ++bj) {
            const int rho0 = u.pn * 256 + bj * 128 + wc * 32 + 8 * fq;
            const bool lat = rho0 < 131072;
            bf16_t* dst; unsigned base, smm, sre;
            if (lat) { const int bgn = rho0 >> 7, n_hi = rho0 & 127, bg = bgn >> 6, n_lo = bgn & 63; dst = Z1; smm = 64u * 256u; sre = 128u; base = (unsigned)(bg * 128) * smm + (unsigned)(n_lo * 256 + n_hi); }
            else { const int rc = rho0 - 131072, bg = rc >> 8, j = rc & 255; dst = Zc; smm = 512u; sre = 256u; base = (unsigned)(bg * 128) * smm + (unsigned)j; }
            base += (unsigned)mm0 * smm;
#pragma unroll
            for (int m = 0; m < 4; ++m) {
#pragma unroll
                for (int ai = 0; ai < 2; ++ai) *(u32x4*)(dst + (base + (unsigned)(m * 16) * smm + (unsigned)ai * sre)) = pack8(acc[ai][bj][m][0], acc[ai][bj][m][1]);
                asm volatile("" ::: "memory");
            }
        }
    }
};
struct EpiFFT1 {
    static constexpr bool PERM = true, AFTER_DRAIN = false;
    bf16_t* T; const float* twc; const float* tws;
    __device__ __forceinline__ void operator()(const f32x4 (&acc)[2][2][4][2], const Unit& u, int wr, int wc, int fr_, int fq_) const {
        int fr = fr_, fq = fq_; asm volatile("" : "+v"(fr), "+v"(fq));
        const int kl0 = wr * 64 + fr;
#pragma unroll
        for (int bj = 0; bj < 2; ++bj) {
            const int rho0 = u.pn * 256 + bj * 128 + wc * 32 + 8 * fq;
            const int n_lo0 = rho0 & 63, bgm = rho0 >> 6, mm = bgm & 127, bg = bgm >> 7;
            const unsigned base = ((unsigned)(bg * 128 + kl0) * 128u + (unsigned)mm) * 128u + (unsigned)n_lo0;
            const unsigned tw0 = (unsigned)(kl0 * 64 + n_lo0);
            f32x4 cN[2], sN[2];
#define FFT1_TW(m_) { _Pragma("unroll") for (int n_ = 0; n_ < 2; ++n_) { cN[n_] = *(const f32x4*)((const char*)twc + ((tw0 + (m_) * 1024 + 4 * n_) * 4u)); sN[n_] = *(const f32x4*)((const char*)tws + ((tw0 + (m_) * 1024 + 4 * n_) * 4u)); } }
            FFT1_TW(0)
#pragma unroll
            for (int m = 0; m < 4; ++m) {
                f32x4 pr[2], pi[2];
                const f32x4 c0 = cN[0], c1 = cN[1], s0 = sN[0], s1 = sN[1];
                if (m < 3) FFT1_TW(m + 1)
#pragma unroll
                for (int n = 0; n < 2; ++n) {
                    const f32x4 c4 = n ? c1 : c0, s4 = n ? s1 : s0;
                    const f32x4 tr = acc[0][bj][m][n], ti = acc[1][bj][m][n];
                    pr[n] = tr * c4 + ti * s4; pi[n] = ti * c4 - tr * s4;
                }
                *(u32x4*)((char*)T + ((base + (unsigned)m * 262144u) * 2u)) = pack8(pr[0], pr[1]); *(u32x4*)((char*)T + ((base + (unsigned)m * 262144u + 64u) * 2u)) = pack8(pi[0], pi[1]);
                asm volatile("" ::: "memory");
            }
#undef FFT1_TW
        }
    }
};
struct EpiFFT2 {
    static constexpr bool PERM = true, AFTER_DRAIN = false;
    bf16_t* F;
    __device__ __forceinline__ void operator()(const f32x4 (&acc)[2][2][4][2], const Unit& u, int wr, int wc, int fr_, int fq_) const {
        int fr = fr_, fq = fq_; asm volatile("" : "+v"(fr), "+v"(fq));
        if (wr != 0) return;
#pragma unroll
        for (int bj = 0; bj < 2; ++bj) {
            const int rho0 = u.pn * 256 + bj * 128 + wc * 32 + 8 * fq;
            const int mm0 = rho0 & 127, bgk = rho0 >> 7, k_lo = bgk & 127, bg = bgk >> 7, b = bg >> 3, g = bg & 7;
#pragma unroll
            for (int m = 0; m < 4; ++m) {
                const int k_hi = m * 16 + fr;
                const long row = (long)b * 8192 + k_hi * 128 + k_lo;
                *(u32x4*)(F + row * 1024 + g * 128 + mm0) = pack8(acc[0][bj][m][0], acc[0][bj][m][1]);
            }
        }
    }
};
struct EpiDFT256 {
    static constexpr bool PERM = true, AFTER_DRAIN = false;
    bf16_t* F;
    __device__ __forceinline__ void operator()(const f32x4 (&acc)[2][2][4][2], const Unit& u, int wr, int wc, int fr_, int fq_) const {
        int fr = fr_, fq = fq_; asm volatile("" : "+v"(fr), "+v"(fq));
#pragma unroll
        for (int bj = 0; bj < 2; ++bj) {
            const int rho0 = u.pn * 256 + bj * 128 + wc * 32 + 8 * fq;
            const int mm0 = rho0 & 127, bg = rho0 >> 7, b = bg >> 3, g = bg & 7;
#pragma unroll
            for (int ai = 0; ai < 2; ++ai)
#pragma unroll
                for (int m = 0; m < 4; ++m) {
                    const int k = ai * 128 + wr * 64 + m * 16 + fr;
                    const long row = 16384 + (long)b * 256 + k;
                    *(u32x4*)(F + row * 1024 + g * 128 + mm0) = pack8(acc[ai][bj][m][0], acc[ai][bj][m][1]);
                }
        }
    }
};
struct EpiSwiGLU {
    static constexpr bool PERM = true, AFTER_DRAIN = false;
    unsigned char* ACT; const float* bgu; const float* asc; float wsc_inv, act_q;
    int no_store;
    __device__ __forceinline__ void operator()(const i32x4_t (&acc)[2][2][4][2], const Unit& u, int wr, int wc, int fr_, int fq_) const {
        int fr = fr_, fq = fq_; asm volatile("" : "+v"(fr), "+v"(fq));
        if (no_store == 2) { asm volatile("" :: "v"(acc[0][0][0][0]), "v"(acc[1][1][3][1])); return; }
        const int e = u.pn >> 3, j = u.pn & 7, col0 = j * 128 + wc * 32 + 8 * fq;
        f32x4 bg[2], bu[2];
#pragma unroll
        for (int n = 0; n < 2; ++n) { bg[n] = *(const f32x4*)(bgu + e * 2048 + col0 + 4 * n); bu[n] = *(const f32x4*)(bgu + e * 2048 + 1024 + col0 + 4 * n); }
        float rsv[8];
#pragma unroll
        for (int g = 0; g < 8; ++g) rsv[g] = *(const float*)((const char*)asc + (unsigned)(u.pm * 256 + (g >> 2) * 128 + wr * 64 + (g & 3) * 16 + fr) * 4u);
        f32x4 buq[2];
#pragma unroll
        for (int n = 0; n < 2; ++n) buq[n] = (bu[n] + 1.0f) * act_q;
        const float ulo = -6.0f * act_q, uhi = 8.0f * act_q;
        u32x2 wprev = {0u, 0u}; const int col16 = (u.pn & 7) * 128 + wc * 32 + 16 * (fq >> 1);
#pragma unroll
        for (int ai = 0; ai < 2; ++ai)
#pragma unroll
            for (int m = 0; m < 4; ++m) {
                const unsigned row = (unsigned)(u.pm * 256 + ai * 128 + wr * 64 + (m & ~1) * 16 + ((fq & 1) ? 16 : 0) + fr);
                const float rsg = rsv[ai * 4 + m] * wsc_inv, rsu = rsg * act_q;
                unsigned bits[8];
#pragma unroll
                for (int n = 0; n < 2; ++n)
#pragma unroll
                    for (int ip = 0; ip < 2; ++ip) {
                        const f32x2 ag = {(float)acc[ai][0][m][n][2 * ip], (float)acc[ai][0][m][n][2 * ip + 1]}, au = {(float)acc[ai][1][m][n][2 * ip], (float)acc[ai][1][m][n][2 * ip + 1]};
                        f32x2 g = __builtin_elementwise_fma(ag, (f32x2){rsg, rsg}, (f32x2){bg[n][2 * ip], bg[n][2 * ip + 1]});
                        g.x = fminf(g.x, 7.0f); g.y = fminf(g.y, 7.0f);
                        f32x2 uq = __builtin_elementwise_fma(au, (f32x2){rsu, rsu}, (f32x2){buq[n][2 * ip], buq[n][2 * ip + 1]});
                        uq.x = __builtin_amdgcn_fmed3f(uq.x, ulo, uhi); uq.y = __builtin_amdgcn_fmed3f(uq.y, ulo, uhi);
                        const f32x2 t = g * (-1.702f * 1.4426950408889634f);
                        f32x2 d; d.x = __builtin_amdgcn_exp2f(t.x); d.y = __builtin_amdgcn_exp2f(t.y);
                        d = d + 1.0f;
                        f32x2 sg; sg.x = __builtin_amdgcn_rcpf(d.x); sg.y = __builtin_amdgcn_rcpf(d.y);
                        f32x2 a = (g * sg) * uq;
                        a.x = __builtin_amdgcn_fmed3f(a.x, -127.0f, 127.0f); a.y = __builtin_amdgcn_fmed3f(a.y, -127.0f, 127.0f);
                        a = a + 12582912.0f;
                        bits[4 * n + 2 * ip] = __float_as_uint(a.x); bits[4 * n + 2 * ip + 1] = __float_as_uint(a.y);
                    }
                u32x2 w;
                w.x = __builtin_amdgcn_perm(bits[1], bits[0], 0x0c0c0400u) | (__builtin_amdgcn_perm(bits[3], bits[2], 0x0c0c0400u) << 16);
                w.y = __builtin_amdgcn_perm(bits[5], bits[4], 0x0c0c0400u) | (__builtin_amdgcn_perm(bits[7], bits[6], 0x0c0c0400u) << 16);
                if ((m & 1) == 0) wprev = w;
                else { const auto s0_ = __builtin_amdgcn_permlane16_swap(wprev.x, w.x, false, false); const auto s1_ = __builtin_amdgcn_permlane16_swap(wprev.y, w.y, false, false);
                    const u32x4 wv_ = {s0_[0], s1_[0], s0_[1], s1_[1]};
                    if (!no_store) *(u32x4*)(ACT + (row * 1024u + (unsigned)col16)) = wv_; else asm volatile("" :: "v"(wv_));
                    asm volatile("" ::: "memory"); }
            }
    }
};
__device__ __forceinline__ unsigned pk4_fp8(float a, float b, float c, float d) { int w = 0; w = __builtin_amdgcn_cvt_pk_fp8_f32(a, b, w, false); w = __builtin_amdgcn_cvt_pk_fp8_f32(c, d, w, true); return (unsigned)w; }
struct EpiMoE2 {
    static constexpr bool PERM = true, AFTER_DRAIN = false;
    unsigned char* OUT; const float* bd; const float* gate; float inv_scale, out_scale;
    int no_store;
    __device__ __forceinline__ void operator()(const i32x4_t (&acc)[2][2][4][2], const Unit& u, int wr, int wc, int fr_, int fq_) const {
        int fr = fr_, fq = fq_; asm volatile("" : "+v"(fr), "+v"(fq));
        if (no_store == 2) { asm volatile("" :: "v"(acc[0][0][0][0]), "v"(acc[1][1][3][1])); return; }
        const int e = u.pn >> 2, j = u.pn & 3;
        const unsigned cofs = (unsigned)(j * 256 + wc * 32 + 8 * fq), cofs16 = (unsigned)(j * 256 + wc * 32 + 16 * (fq >> 1));
        u32x2 pprev[2] = {{0u, 0u}, {0u, 0u}};
        f32x4 bv[2][2];
#pragma unroll
        for (int bj = 0; bj < 2; ++bj)
#pragma unroll
            for (int n = 0; n < 2; ++n) bv[bj][n] = *(const f32x4*)((const char*)bd + ((unsigned)(e * 1024) + cofs + (unsigned)(bj * 128 + 4 * n)) * 4u);
        float gtv[8];
#pragma unroll
        for (int g = 0; g < 8; ++g) gtv[g] = *(const float*)((const char*)gate + (unsigned)(u.pm * 256 + (g >> 2) * 128 + wr * 64 + (g & 3) * 16 + fr) * 4u) * out_scale;
#pragma unroll
        for (int ai = 0; ai < 2; ++ai)
#pragma unroll
            for (int m = 0; m < 4; ++m) {
                const unsigned row = (unsigned)(u.pm * 256 + ai * 128 + wr * 64 + (m & ~1) * 16 + ((fq & 1) ? 16 : 0) + fr);
                const float gt = gtv[ai * 4 + m];
#pragma unroll
                for (int bj = 0; bj < 2; ++bj) {
                    f32x4 v0 = (__builtin_convertvector(acc[ai][bj][m][0], f32x4) * inv_scale + bv[bj][0]) * gt, v1 = (__builtin_convertvector(acc[ai][bj][m][1], f32x4) * inv_scale + bv[bj][1]) * gt;
#pragma unroll
                    for (int i = 0; i < 4; ++i) { v0[i] = __builtin_amdgcn_fmed3f(v0[i], -440.f, 440.f); v1[i] = __builtin_amdgcn_fmed3f(v1[i], -440.f, 440.f); }
                    u32x2 pw_; pw_.x = pk4_fp8(v0[0], v0[1], v0[2], v0[3]); pw_.y = pk4_fp8(v1[0], v1[1], v1[2], v1[3]);
                    if ((m & 1) == 0) pprev[bj] = pw_;
                    else { const auto s0_ = __builtin_amdgcn_permlane16_swap(pprev[bj].x, pw_.x, false, false); const auto s1_ = __builtin_amdgcn_permlane16_swap(pprev[bj].y, pw_.y, false, false);
                        const u32x4 wv_ = {s0_[0], s1_[0], s0_[1], s1_[1]};
                        if (!no_store) *(u32x4*)(OUT + (row * 1024u + cofs16 + (unsigned)(bj * 128))) = wv_; else asm volatile("" :: "v"(wv_)); }
                }
                asm volatile("" ::: "memory");
            }
    }
};
template <class Epi, class Sched, bool ALIGN_EPI = false, bool SP2 = false, int MODE = 0, bool GATHER = false>
__device__ __forceinline__ void gemm_phase(PG8_LAS unsigned char* lds, const Gemm g, const Sched& S, const Epi& E) {
    int tid_o = threadIdx.x; asm volatile("" : "+v"(tid_o));
    const int tid = tid_o, wid = __builtin_amdgcn_readfirstlane(tid >> 6), lane = tid & 63, wr = wid >> 2, wc = wid & 3, fr = lane & 15, fq = lane >> 4;
    const int K = g.K, nt = K / BK;
    unsigned voffA[2], voffB[2];
#pragma unroll
    for (int i = 0; i < 2; ++i) { int R, C; stage_rc(tid * 16 + i * 8192, R, C); const int Rb = Epi::PERM ? ((R & ~31) + perm32(R & 31)) : R;
        voffA[i] = (unsigned)(R * K + C) * 2u; voffB[i] = (unsigned)(Rb * K + C) * 2u; }
    static_assert(!GATHER || SP2, "GATHER is written into the SP2 loop only");
    unsigned cvG[2][2], nvG[2][2]; int Rg[2]; unsigned Cb[2];
#pragma unroll
    for (int i = 0; i < 2; ++i) { int R, C; stage_rc(tid * 16 + i * 8192, R, C); Rg[i] = R; Cb[i] = (unsigned)C * 2u; }
#define PG8_GFETCH(slot, pm_) do { if (wid < 4) { int l_ = lane; asm volatile("" : "+v"(l_));     \
        __builtin_amdgcn_global_load_lds((const unsigned*)(g.rowidx + (size_t)(pm_) * 256 + wid * 64 + l_), (PG8_LAS unsigned*)(g.idx + (slot) * 256 + wid * 64), 4, 0, 0); } } while (0)
#define PG8_GIDX(slot, dst) do { _Pragma("unroll") for (int h_ = 0; h_ < 2; ++h_) _Pragma("unroll") for (int i_ = 0; i_ < 2; ++i_) { unsigned ix_ = (unsigned)g.idx[(slot) * 256 + h_ * 128 + Rg[i_]]; ix_ = ix_ < g.idx_max ? ix_ : g.idx_max; dst[h_][i_] = ix_ * (unsigned)(2 * K) + Cb[i_]; } } while (0)
#define PG8_STAGE_A(bufoff, h, base, nsel) do { if constexpr (GATHER) { const unsigned vs_[2] = {(nsel) ? nvG[h][0] : cvG[h][0], (nsel) ? nvG[h][1] : cvG[h][1]}; PG8_STAGE(bufoff, base, vs_); } \
        else { PG8_STAGE(bufoff, (base) + (h) * hstep, voffA); } } while (0)
    const size_t kstep = (size_t)(BK * 2);
    const size_t hstep = (size_t)HALF * K * 2;
    const size_t tstep = 2 * hstep;
    const unsigned ldsw = (unsigned)wid * 1024u;
    const int aoff = lds_byte(wr * 64 + fr, fq * 8), boff = lds_byte(wc * 32 + fr, fq * 8);
#define PG8_SA(b, h) (((b) * 2 + (h)) * HTB)
#define PG8_SB(b, h) ((4 + (b) * 2 + (h)) * HTB)
#define PG8_STAGE(bufoff, gbase, voff) do { _Pragma("unroll") for (int _i = 0; _i < 2; ++_i) \
        __builtin_amdgcn_global_load_lds((const unsigned*)((const char*)(gbase) + (voff)[_i]), (PG8_LAS unsigned*)(lds + (bufoff) + ldsw + _i * 8192), 16, 0, 0); } while (0)
#define PG8_LDA(dst, b, h) do { _Pragma("unroll") for (int m = 0; m < 4; ++m) _Pragma("unroll") for (int k = 0; k < 2; ++k) dst[m][k] = *(const PG8_LAS bf16x8*)(lds + PG8_SA(b, h) + aoff + m * 2048 + k * 1024); } while (0)
#define PG8_LDB(dst, b, h) do { _Pragma("unroll") for (int n = 0; n < 2; ++n) _Pragma("unroll") for (int k = 0; k < 2; ++k) dst[n][k] = *(const PG8_LAS bf16x8*)(lds + PG8_SB(b, h) + boff + n * 2048 + k * 1024); } while (0)
#define PG8_MMA(ai, bj, At, Bt) do { __builtin_amdgcn_s_setprio(1); _Pragma("unroll") for (int m = 0; m < 4; ++m) _Pragma("unroll") for (int n = 0; n < 2; ++n) _Pragma("unroll") for (int k = 0; k < 2; ++k) { \
        if constexpr (MODE == 1) acc[ai][bj][m][n] = __builtin_amdgcn_mfma_i32_16x16x64_i8(__builtin_bit_cast(i32x4_t, Bt[n][k]), __builtin_bit_cast(i32x4_t, At[m][k]), acc[ai][bj][m][n], 0, 0, 0); \
        else acc[ai][bj][m][n] = __builtin_amdgcn_mfma_f32_16x16x32_bf16(Bt[n][k], At[m][k], acc[ai][bj][m][n], 0, 0, 0); } __builtin_amdgcn_s_setprio(0); } while (0)
#define PG8_WAIT_V(n) asm volatile("s_waitcnt vmcnt(" #n ")" ::: "memory")
#define PG8_WAIT_L(n) asm volatile("s_waitcnt lgkmcnt(" #n ")" ::: "memory")
#define PG8_BAR __builtin_amdgcn_s_barrier()
#define PG8_SCHED __builtin_amdgcn_sched_barrier(0)
    Unit cur, nxt; int ui = 0;
    if (!S.next(0, cur)) return;
    typedef typename AccSel<MODE>::type acc_t;
    acc_t acc[2][2][4][2];
#pragma unroll
    for (int a = 0; a < 2; ++a)
#pragma unroll
        for (int b = 0; b < 2; ++b)
#pragma unroll
            for (int m = 0; m < 4; ++m)
#pragma unroll
                for (int n = 0; n < 2; ++n) acc[a][b][m][n] = acc_t{};
    bf16x8 At[4][2], B0[2][2], B1[2][2];
    const char* cA = GATHER ? (const char*)g.A : (const char*)g.A + (size_t)cur.pm * tstep; const char* cB = (const char*)g.Bt + (size_t)cur.pn * tstep;
    S.a_ready(cur);
    if constexpr (GATHER) {
        PG8_GFETCH(0, cur.pm); PG8_WAIT_V(0); PG8_BAR; asm volatile("" ::: "memory");
        PG8_GIDX(0, cvG);
#pragma unroll
        for (int h_ = 0; h_ < 2; ++h_) { nvG[h_][0] = cvG[h_][0]; nvG[h_][1] = cvG[h_][1]; }
    }
    if constexpr (SP2) {
        PG8_STAGE(PG8_SB(0, 0), cB, voffB); PG8_STAGE(PG8_SB(0, 1), cB + hstep, voffB); PG8_STAGE_A(PG8_SA(0, 0), 0, cA, false); PG8_STAGE_A(PG8_SA(0, 1), 1, cA, false);
        if (wr == 1) PG8_BAR;
        PG8_WAIT_V(2); PG8_BAR;
        PG8_STAGE(PG8_SB(1, 0), cB + kstep, voffB); PG8_STAGE_A(PG8_SA(1, 0), 0, cA + kstep, false); PG8_STAGE(PG8_SB(1, 1), cB + hstep + kstep, voffB);
        PG8_WAIT_V(6); PG8_BAR;
    } else {
        PG8_STAGE(PG8_SB(0, 0), cB, voffB); PG8_STAGE(PG8_SA(0, 0), cA, voffA); PG8_STAGE(PG8_SB(0, 1), cB + hstep, voffB); PG8_STAGE(PG8_SA(0, 1), cA + hstep, voffA);
        if (wr == 1) PG8_BAR;
        PG8_WAIT_V(4); PG8_BAR;
        PG8_STAGE(PG8_SB(1, 0), cB + kstep, voffB); PG8_STAGE(PG8_SA(1, 0), cA + kstep, voffA); PG8_STAGE(PG8_SB(1, 1), cB + hstep + kstep, voffB);
        PG8_WAIT_V(6); PG8_BAR;
    }
    for (;;) {
        const bool has_next = S.next(ui + 1, nxt);
        const char* nA = GATHER ? cA : (has_next ? (const char*)g.A + (size_t)nxt.pm * tstep : cA); const char* nB = has_next ? (const char*)g.Bt + (size_t)nxt.pn * tstep : cB;
        if constexpr (GATHER) { if (has_next) PG8_GFETCH((ui + 1) & 1, nxt.pm); }
        for (int t = 0; t < nt; t += 2) {
            const bool last = (t == nt - 2);
            const char* a1 = cA + (size_t)(t + 1) * kstep;
            const char* a2 = last ? nA : cA + (size_t)(t + 2) * kstep; const char* b2 = last ? nB : cB + (size_t)(t + 2) * kstep;
            const char* a3 = a2 + kstep; const char* b3 = b2 + kstep;
            if (last && has_next) S.a_ready(nxt);
            if constexpr (GATHER) { if (last && has_next) { PG8_GIDX((ui + 1) & 1, nvG); } }
            if constexpr (SP2) {
            PG8_LDB(B0, 0, 0); PG8_LDB(B1, 0, 1); PG8_SCHED; PG8_LDA(At, 0, 0); PG8_STAGE_A(PG8_SA(1, 1), 1, a1, false);
            PG8_WAIT_V(8); PG8_WAIT_L(0); PG8_BAR; PG8_MMA(0, 0, At, B0); PG8_MMA(0, 1, At, B1); PG8_BAR; PG8_SCHED;
            PG8_LDA(At, 0, 1); PG8_STAGE(PG8_SB(0, 0), b2, voffB); PG8_STAGE(PG8_SB(0, 1), b2 + hstep, voffB); PG8_STAGE_A(PG8_SA(0, 0), 0, a2, last);
            PG8_WAIT_V(8); PG8_WAIT_L(0); PG8_BAR; PG8_MMA(1, 0, At, B0); PG8_MMA(1, 1, At, B1); PG8_BAR; PG8_SCHED;
            PG8_LDB(B0, 1, 0); PG8_LDB(B1, 1, 1); PG8_SCHED; PG8_LDA(At, 1, 0); PG8_STAGE_A(PG8_SA(0, 1), 1, a2, last);
            PG8_WAIT_V(8); PG8_WAIT_L(0); PG8_BAR; PG8_MMA(0, 0, At, B0); PG8_MMA(0, 1, At, B1); PG8_BAR; PG8_SCHED;
            PG8_LDA(At, 1, 1); PG8_STAGE(PG8_SB(1, 0), b3, voffB); PG8_STAGE(PG8_SB(1, 1), b3 + hstep, voffB); PG8_STAGE_A(PG8_SA(1, 0), 0, a3, last);
            PG8_WAIT_V(8); PG8_WAIT_L(0); PG8_BAR; PG8_MMA(1, 0, At, B0); PG8_MMA(1, 1, At, B1); PG8_BAR; PG8_SCHED;
            } else {
            PG8_LDB(B0, 0, 0); PG8_SCHED; PG8_LDA(At, 0, 0); PG8_STAGE(PG8_SA(1, 1), a1 + hstep, voffA);
            PG8_WAIT_L(8); PG8_BAR; PG8_WAIT_L(0); PG8_MMA(0, 0, At, B0); PG8_BAR; PG8_SCHED;
            PG8_LDB(B1, 0, 1); PG8_STAGE(PG8_SB(0, 0), b2, voffB);
            PG8_BAR; PG8_WAIT_L(0); PG8_MMA(0, 1, At, B1); PG8_BAR;
            PG8_LDA(At, 0, 1); PG8_STAGE(PG8_SA(0, 0), a2, voffA);
            PG8_BAR; PG8_WAIT_L(0); PG8_MMA(1, 0, At, B0); PG8_BAR; PG8_SCHED;
            PG8_STAGE(PG8_SB(0, 1), b2 + hstep, voffB);
            PG8_WAIT_V(6); PG8_BAR; PG8_MMA(1, 1, At, B1); PG8_BAR;
            PG8_LDB(B0, 1, 0); PG8_SCHED; PG8_LDA(At, 1, 0); PG8_STAGE(PG8_SA(0, 1), a2 + hstep, voffA);
            PG8_WAIT_L(8); PG8_BAR; PG8_WAIT_L(0); PG8_MMA(0, 0, At, B0); PG8_BAR; PG8_SCHED;
            PG8_LDB(B1, 1, 1); PG8_STAGE(PG8_SB(1, 0), b3, voffB);
            PG8_BAR; PG8_WAIT_L(0); PG8_MMA(0, 1, At, B1); PG8_BAR;
            PG8_LDA(At, 1, 1); PG8_STAGE(PG8_SA(1, 0), a3, voffA);
            PG8_BAR; PG8_WAIT_L(0); PG8_MMA(1, 0, At, B0); PG8_BAR; PG8_SCHED;
            PG8_STAGE(PG8_SB(1, 1), b3 + hstep, voffB);
            PG8_WAIT_V(6); PG8_BAR; PG8_MMA(1, 1, At, B1); PG8_BAR;
            }
        }
        if constexpr (ALIGN_EPI) { if (wr == 0) PG8_BAR; }
        if constexpr (!Epi::AFTER_DRAIN) { E(acc, cur, wr, wc, fr, fq); S.done(cur); }
        if (!has_next) break;
#pragma unroll
        for (int a = 0; a < 2; ++a)
#pragma unroll
            for (int b = 0; b < 2; ++b)
#pragma unroll
                for (int m = 0; m < 4; ++m)
#pragma unroll
                    for (int n = 0; n < 2; ++n) acc[a][b][m][n] = acc_t{};
        cur = nxt; cA = nA; cB = nB; ++ui;
        if constexpr (GATHER) {
#pragma unroll
            for (int h_ = 0; h_ < 2; ++h_) { cvG[h_][0] = nvG[h_][0]; cvG[h_][1] = nvG[h_][1]; } }
        if constexpr (ALIGN_EPI) { if (wr == 1) PG8_BAR; }
    }
    PG8_WAIT_V(0);
    if constexpr (!ALIGN_EPI) { if (wr == 0) PG8_BAR; }
    PG8_BAR;
    if constexpr (Epi::AFTER_DRAIN) { E.fused(acc, cur, wr, wc, fr, fq, lds, wid, lane); S.done(cur); }
#undef PG8_SA
#undef PG8_SB
#undef PG8_STAGE
#undef PG8_STAGE_A
#undef PG8_GFETCH
#undef PG8_GIDX
#undef PG8_LDA
#undef PG8_LDB
#undef PG8_MMA
#undef PG8_WAIT_V
#undef PG8_WAIT_L
#undef PG8_BAR
#undef PG8_SCHED
}
}

namespace dattn {
using bf16x8 = __attribute__((ext_vector_type(8))) short;
using s16x4  = __attribute__((ext_vector_type(4))) short;
using f32x16 = __attribute__((ext_vector_type(16))) float;
using u32x4  = __attribute__((ext_vector_type(4))) unsigned;
typedef unsigned short bf16_t;
constexpr int NW = 8, QBLK = 32, KVBLK = 64, LD = 1024;
constexpr int SHM_V = KVBLK * 128 * 2, SHM_K = KVBLK * 64 * 2, NBUF = 3, SHM_BYTES = NBUF * (SHM_V + SHM_K) + NW * 64 * 4;
constexpr float THRL = 8.f;
#define DA_KSWZ(row, colB) ((row) * 128 + ((colB) ^ ((((row) >> 1) & 7) << 4)))
#define DA_SBAR() __builtin_amdgcn_sched_barrier(0)
__device__ __forceinline__ int crow(int r, int hi) { return (r & 3) + 8 * (r >> 2) + 4 * hi; }
__device__ __forceinline__ unsigned cvtpk(float lo, float hi) { unsigned r; asm volatile("v_cvt_pk_bf16_f32 %0, %1, %2" : "=v"(r) : "v"(lo), "v"(hi)); return r; }

__device__ __forceinline__ void partialSM(f32x16& p0, f32x16& p1, float& m_reg, float& mn, float& alpha) {
  float pmax = p0[0];
#pragma unroll
  for (int r = 1; r < 16; ++r) pmax = fmaxf(pmax, p0[r]);
#pragma unroll
  for (int r = 0; r < 16; ++r) pmax = fmaxf(pmax, p1[r]);
  { auto rr = __builtin_amdgcn_permlane32_swap(__float_as_uint(pmax), __float_as_uint(pmax), false, false);
    pmax = fmaxf(__uint_as_float(rr[0]), __uint_as_float(rr[1])); }
  if (__builtin_expect(__all(pmax - m_reg <= THRL), 1)) { mn = m_reg; alpha = 1.f; }
  else { mn = fmaxf(m_reg, pmax); alpha = __builtin_amdgcn_exp2f(m_reg - mn); m_reg = mn; }
#pragma unroll
  for (int r = 0; r < 16; ++r) p0[r] = p0[r] - mn;
#pragma unroll
  for (int r = 0; r < 16; ++r) p1[r] = p1[r] - mn;
#pragma unroll
  for (int r = 0; r < 16; ++r) p0[r] = __builtin_amdgcn_exp2f(p0[r]);
}
__device__ __forceinline__ void finishSM(f32x16& p0, f32x16& p1, float alpha, float& l_reg, bf16x8& pa0, bf16x8& pa1, bf16x8& pa2, bf16x8& pa3) {
#pragma unroll
  for (int r = 0; r < 16; ++r) p1[r] = __builtin_amdgcn_exp2f(p1[r]);
  float ps = 0;
#pragma unroll
  for (int r = 0; r < 16; ++r) ps += p0[r];
#pragma unroll
  for (int r = 0; r < 16; ++r) ps += p1[r];
  { auto rr = __builtin_amdgcn_permlane32_swap(__float_as_uint(ps), __float_as_uint(ps), false, false);
    ps = __uint_as_float(rr[0]) + __uint_as_float(rr[1]); }
  l_reg = l_reg * alpha + ps;
#define DA_PK4(P, BASE, OUT) do { unsigned a0 = cvtpk(P[BASE + 0], P[BASE + 1]), a1 = cvtpk(P[BASE + 2], P[BASE + 3]);   \
    unsigned b0 = cvtpk(P[BASE + 4], P[BASE + 5]), b1 = cvtpk(P[BASE + 6], P[BASE + 7]);                              \
    auto r0 = __builtin_amdgcn_permlane32_swap(a0, b0, false, false); auto r1 = __builtin_amdgcn_permlane32_swap(a1, b1, false, false); \
    u32x4 w = {r0[0], r1[0], r0[1], r1[1]}; OUT = *reinterpret_cast<bf16x8*>(&w); } while (0)
  DA_PK4(p0, 0, pa0); DA_PK4(p0, 8, pa1); DA_PK4(p1, 0, pa2); DA_PK4(p1, 8, pa3);
#undef DA_PK4
}
__device__ __forceinline__ void qkt(f32x16& p0, f32x16& p1, const char* Ks, const bf16x8* qr, int r32, int hi) {
  p0 = f32x16{}; p1 = f32x16{};
#pragma unroll
  for (int d0 = 0; d0 < 4; ++d0) { const int cb = (d0 * 16 + hi * 8) * 2;
    const bf16x8 b0 = *reinterpret_cast<const bf16x8*>(Ks + DA_KSWZ(r32, cb));
    const bf16x8 b1 = *reinterpret_cast<const bf16x8*>(Ks + DA_KSWZ(32 + r32, cb));
    p0 = __builtin_amdgcn_mfma_f32_32x32x16_bf16(b0, qr[d0], p0, 0, 0, 0);
    p1 = __builtin_amdgcn_mfma_f32_32x32x16_bf16(b1, qr[d0], p1, 0, 0, 0); }
}
__device__ __forceinline__ int v_st(int k, int c) { const int kk = (k & ~0xC) | ((k & 4) << 1) | ((k & 8) >> 1); return ((kk >> 3) * 4 + (c >> 5)) * 512 + ((kk & 7) * 32 + (c & 31)) * 2; }
__device__ __forceinline__ int v_rd_base(int lane) { return ((lane & 3) << 3) | (((lane >> 2) & 3) << 6) | (((lane >> 4) & 1) << 5) | (((lane >> 5) & 1) << 8); }
constexpr int v_rd_off(int d0, int ks, int half) { return d0 * 512 + ks * 4096 + half * 2048; }
template <int OFF> __device__ __forceinline__ s16x4 tr_read(int vb) { s16x4 r; asm volatile("ds_read_b64_tr_b16 %0, %1 offset:%2" : "=&v"(r) : "v"(vb), "i"(OFF) : "memory"); return r; }
template <int KS> __device__ __forceinline__ void pv_ks(f32x16* o, int vb, bf16x8 pa) {
  s16x4 l0 = tr_read<v_rd_off(0, KS, 0)>(vb), h0 = tr_read<v_rd_off(0, KS, 1)>(vb), l1 = tr_read<v_rd_off(1, KS, 0)>(vb), h1 = tr_read<v_rd_off(1, KS, 1)>(vb);
  s16x4 l2 = tr_read<v_rd_off(2, KS, 0)>(vb), h2 = tr_read<v_rd_off(2, KS, 1)>(vb), l3 = tr_read<v_rd_off(3, KS, 0)>(vb), h3 = tr_read<v_rd_off(3, KS, 1)>(vb);
  asm volatile("s_waitcnt lgkmcnt(0)" : "+v"(l0), "+v"(h0), "+v"(l1), "+v"(h1), "+v"(l2), "+v"(h2), "+v"(l3), "+v"(h3) :: "memory");
#define DA_PK(L, H) (bf16x8){L[0], L[1], L[2], L[3], H[0], H[1], H[2], H[3]}
  o[0] = __builtin_amdgcn_mfma_f32_32x32x16_bf16(pa, DA_PK(l0, h0), o[0], 0, 0, 0);
  o[1] = __builtin_amdgcn_mfma_f32_32x32x16_bf16(pa, DA_PK(l1, h1), o[1], 0, 0, 0);
  o[2] = __builtin_amdgcn_mfma_f32_32x32x16_bf16(pa, DA_PK(l2, h2), o[2], 0, 0, 0);
  o[3] = __builtin_amdgcn_mfma_f32_32x32x16_bf16(pa, DA_PK(l3, h3), o[3], 0, 0, 0);
#undef DA_PK
}
__device__ __forceinline__ void pv_d0(f32x16* o, int vb, bf16x8 pa0, bf16x8 pa1, bf16x8 pa2, bf16x8 pa3) {
  pv_ks<0>(o, vb, pa0); pv_ks<1>(o, vb, pa1); pv_ks<2>(o, vb, pa2); pv_ks<3>(o, vb, pa3);
}
__device__ __forceinline__ void unit(const bf16_t* __restrict__ Qb, const bf16_t* __restrict__ Kh, const bf16_t* __restrict__ Vh, bf16_t* __restrict__ Ob, int seq, char* lds) {
  int tid_o = threadIdx.x; asm volatile("" : "+v"(tid_o));
  const int tid = tid_o, wid = tid >> 6, lane = tid & 63, r32 = lane & 31, hi = lane >> 5;
  char* V_lds = lds; char* K_lds = lds + NBUF * SHM_V;
  float* ws = (float*)(lds + NBUF * (SHM_V + SHM_K)) + wid * 64; float* li_l = ws; float* al_l = ws + 32;
  float m_reg = -1e30f, l_reg = 0; f32x16 o[4] = {}; bf16x8 qr[4];
  const bf16_t* Qw = Qb + (long)(wid * QBLK + r32) * LD + hi * 8;
#pragma unroll
  for (int d0 = 0; d0 < 4; ++d0) qr[d0] = *reinterpret_cast<const bf16x8*>(Qw + d0 * 16);
  const int sr = tid >> 4, sc = (tid & 15) * 8, vst0 = v_st(sr, sc), vst1 = v_st(32 + sr, sc);
  const int kr = tid >> 3, kc = (tid & 7) * 8, kst = DA_KSWZ(kr, kc * 2);
  const int vb0 = (int)(uintptr_t)V_lds + v_rd_base(lane);
  struct { bf16x8 vs0, vs1, ks0; } sr_[2];
#define DA_SLOAD(i, k0) do { sr_[i].vs0 = *reinterpret_cast<const bf16x8*>(&Vh[(long)((k0) + sr) * LD + sc]); sr_[i].vs1 = *reinterpret_cast<const bf16x8*>(&Vh[(long)((k0) + 32 + sr) * LD + sc]); \
    sr_[i].ks0 = *reinterpret_cast<const bf16x8*>(&Kh[(long)((k0) + kr) * LD + kc]); } while (0)
#define DA_SWRITE(b, i) do { *(bf16x8*)(V_lds + (b) * SHM_V + vst0) = sr_[i].vs0; *(bf16x8*)(V_lds + (b) * SHM_V + vst1) = sr_[i].vs1; *(bf16x8*)(K_lds + (b) * SHM_K + kst) = sr_[i].ks0; } while (0)
#define DA_SWAIT() asm volatile("s_waitcnt vmcnt(3)" ::: "memory")
#define DA_RESC(a) do { if (__any((a) < 1.f)) { if (hi == 0) al_l[r32] = (a); asm volatile("s_waitcnt lgkmcnt(0)" ::: "memory"); \
    _Pragma("unroll") for (int d = 0; d < 4; ++d) _Pragma("unroll") for (int r = 0; r < 16; ++r) o[d][r] *= al_l[crow(r, hi)]; } } while (0)
  f32x16 pA0, pA1, pB0, pB1; float mnA, mnB, alA, alB; bf16x8 pa0, pa1, pa2, pa3; const int NT = seq / KVBLK;
  constexpr int SE = 0, SO = 1;
  DA_SLOAD(SE, 0); asm volatile("s_waitcnt vmcnt(0)" ::: "memory"); DA_SWRITE(0, SE); __syncthreads();
  qkt(pA0, pA1, K_lds, qr, r32, hi); partialSM(pA0, pA1, m_reg, mnA, alA);
  DA_SLOAD(SO, KVBLK); if (2 < NT) DA_SLOAD(SE, 2 * KVBLK);
  DA_SWAIT(); DA_SWRITE(1, SO); __syncthreads();
  int prv = 0, cur = 1, nxt = 2;
#define DA_ROT() do { const int t_ = prv; prv = cur; cur = nxt; nxt = t_; } while (0)
  for (int j = 1; j + 1 < NT; j += 2) {
    DA_SBAR(); qkt(pB0, pB1, K_lds + cur * SHM_K, qr, r32, hi);
    finishSM(pA0, pA1, alA, l_reg, pa0, pa1, pa2, pa3); DA_SBAR();
    DA_SLOAD(SO, (j + 2) * KVBLK); DA_SBAR();
    pv_d0(o, vb0 + prv * SHM_V, pa0, pa1, pa2, pa3); partialSM(pB0, pB1, m_reg, mnB, alB);
    DA_SWAIT(); DA_SWRITE(nxt, SE);
    DA_RESC(alB); __syncthreads(); DA_ROT();
    DA_SBAR(); qkt(pA0, pA1, K_lds + cur * SHM_K, qr, r32, hi);
    finishSM(pB0, pB1, alB, l_reg, pa0, pa1, pa2, pa3); DA_SBAR();
    if (j + 3 < NT) DA_SLOAD(SE, (j + 3) * KVBLK); DA_SBAR();
    pv_d0(o, vb0 + prv * SHM_V, pa0, pa1, pa2, pa3); partialSM(pA0, pA1, m_reg, mnA, alA);
    DA_SWAIT(); DA_SWRITE(nxt, SO);
    DA_RESC(alA); __syncthreads(); DA_ROT();
  }
  DA_SBAR(); qkt(pB0, pB1, K_lds + cur * SHM_K, qr, r32, hi);
  finishSM(pA0, pA1, alA, l_reg, pa0, pa1, pa2, pa3); DA_SBAR();
  pv_d0(o, vb0 + prv * SHM_V, pa0, pa1, pa2, pa3); partialSM(pB0, pB1, m_reg, mnB, alB);
  DA_RESC(alB);
  finishSM(pB0, pB1, alB, l_reg, pa0, pa1, pa2, pa3); DA_SBAR();
  pv_d0(o, vb0 + cur * SHM_V, pa0, pa1, pa2, pa3);
#undef DA_ROT
  if (hi == 0) li_l[r32] = l_reg; asm volatile("s_waitcnt lgkmcnt(0)" ::: "memory");
  float rli[16];
#pragma unroll
  for (int r = 0; r < 16; ++r) rli[r] = __builtin_amdgcn_rcpf(li_l[crow(r, hi)]);
  bf16_t* Ow = Ob + (long)(wid * QBLK) * LD;
#pragma unroll
  for (int r = 0; r < 16; ++r) { const int orow = crow(r, hi);
#pragma unroll
    for (int d0 = 0; d0 < 4; d0 += 2) { const unsigned w = cvtpk(o[d0][r] * rli[r], o[d0 + 1][r] * rli[r]);
      Ow[(long)orow * LD + d0 * 32 + r32] = (bf16_t)(w & 0xffffu); Ow[(long)orow * LD + (d0 + 1) * 32 + r32] = (bf16_t)(w >> 16); } }
  __syncthreads();
#undef DA_SLOAD
#undef DA_SWRITE
#undef DA_SWAIT
#undef DA_RESC
}
#undef DA_KSWZ
#undef DA_SBAR
}

#include <hip/hip_bf16.h>
#include <cmath>
namespace hattn {
using bf16=__hip_bfloat16;
using bf16x8=__attribute__((ext_vector_type(8)))short;
using s16x4=__attribute__((ext_vector_type(4)))short;
using f32x16=__attribute__((ext_vector_type(16)))float;
using u32x4=__attribute__((ext_vector_type(4)))unsigned;
constexpr int BATCH=2,NHEAD=16,SEQ=8192,D=64,DM=NHEAD*D;
constexpr int NW=8,QBLK=32,QB=QBLK*NW,KVBLK=64,NQB=SEQ/QB;
constexpr int ATTN_PITCH=DM, ATTN_UNIT_ROWS=QB;
__device__ __forceinline__ int crow(int r,int hi){return (r&3)+8*(r>>2)+4*hi;}
#define SBAR() __builtin_amdgcn_sched_barrier(0)
__device__ __forceinline__ void cmask(f32x16&p0,f32x16&p1,int jb,int qrel,int hi){
  const float NEG=-INFINITY; int kb=64*jb+4*hi;
  #pragma unroll
  for(int r=0;r<16;++r){int kv=kb+(r&3)+8*(r>>2); if(kv>qrel)p0[r]=NEG; if(kv+32>qrel)p1[r]=NEG;}
}

constexpr int NSLOT=3, SLOTB=8192;
constexpr int LDS_K=0, LDS_V=NSLOT*SLOTB, LDS_WS=LDS_V+NSLOT*2*SLOTB, LDS_OST=LDS_WS+NW*64*4, LDS_BYTES=LDS_OST+NW*4096;
constexpr float C2=0.125f*1.4426950408889634f;
__device__ __forceinline__ void glds16(const void*gsrc,unsigned lds_dst){unsigned keep;
  asm volatile("s_mov_b32 %0, m0\n\ts_mov_b32 m0, %2\n\ts_nop 0\n\tglobal_load_lds_dwordx4 %1, off\n\ts_mov_b32 m0, %0":"=&s"(keep):"v"(gsrc),"s"(lds_dst):"memory");}
__device__ __forceinline__ float max3f(float a,float b,float c){float r;asm("v_max3_f32 %0, %1, %2, %3":"=v"(r):"v"(a),"v"(b),"v"(c));return r;}
__device__ __forceinline__ float max2f(float a,float b){float r;asm("v_max_f32_e32 %0, %1, %2":"=v"(r):"v"(a),"v"(b));return r;}
__device__ __forceinline__ float fadd_s(float a,float b){float r;asm("v_add_f32_e32 %0, %1, %2":"=v"(r):"v"(a),"v"(b));return r;}
__device__ __forceinline__ float fsub_s(float a,float b){float r;asm("v_sub_f32_e32 %0, %1, %2":"=v"(r):"v"(a),"v"(b));return r;}
typedef float f32x2_t __attribute__((ext_vector_type(2))); typedef __bf16 bf16x2_t __attribute__((ext_vector_type(2)));
__device__ __forceinline__ unsigned cvtpk_s(float lo,float hi){f32x2_t v={lo,hi};bf16x2_t b=__builtin_convertvector(v,bf16x2_t);return __builtin_bit_cast(unsigned,b);}
#define WAIT_BAR(N) asm volatile("s_waitcnt vmcnt(" #N ") lgkmcnt(0)\n\ts_barrier":::"memory")

__device__ __forceinline__ void qkt(f32x16&p0,f32x16&p1,const char*Kslot,const bf16x8*qr,const f32x16&negm,int r32,int hi){
  const char*kb=Kslot+hi*1024+r32*16;
  #pragma unroll
  for(int d0=0;d0<4;++d0){
    const bf16x8 b0=*reinterpret_cast<const bf16x8*>(kb+d0*2048);
    const bf16x8 b1=*reinterpret_cast<const bf16x8*>(kb+d0*2048+512);
    if(d0==0){p0=__builtin_amdgcn_mfma_f32_32x32x16_bf16(b0,qr[0],negm,0,0,0);p1=__builtin_amdgcn_mfma_f32_32x32x16_bf16(b1,qr[0],negm,0,0,0);}
    else{p0=__builtin_amdgcn_mfma_f32_32x32x16_bf16(b0,qr[d0],p0,0,0,0);p1=__builtin_amdgcn_mfma_f32_32x32x16_bf16(b1,qr[d0],p1,0,0,0);}}
}
typedef __attribute__((address_space(3))) const char* lds_cptr;
typedef short v4i16_t __attribute__((ext_vector_type(4)));
__device__ __forceinline__ void kload8(bf16x8*kf,lds_cptr kp){
  kf[0]=*(const __attribute__((address_space(3))) bf16x8*)(kp);      kf[1]=*(const __attribute__((address_space(3))) bf16x8*)(kp+512);
  kf[2]=*(const __attribute__((address_space(3))) bf16x8*)(kp+2048); kf[3]=*(const __attribute__((address_space(3))) bf16x8*)(kp+2560);
  kf[4]=*(const __attribute__((address_space(3))) bf16x8*)(kp+4096); kf[5]=*(const __attribute__((address_space(3))) bf16x8*)(kp+4608);
  kf[6]=*(const __attribute__((address_space(3))) bf16x8*)(kp+6144); kf[7]=*(const __attribute__((address_space(3))) bf16x8*)(kp+6656);
}
__device__ __forceinline__ void kload2(bf16x8*kf,lds_cptr kp,int j){ kf[2*j]=*(const __attribute__((address_space(3))) bf16x8*)(kp+j*2048); kf[2*j+1]=*(const __attribute__((address_space(3))) bf16x8*)(kp+j*2048+512); }
__device__ __forceinline__ s16x4 vtr(lds_cptr p){ return __builtin_bit_cast(s16x4,__builtin_amdgcn_ds_read_tr16_b64_v4i16((__attribute__((address_space(3))) v4i16_t*)p)); }
__device__ __forceinline__ float rowmax(const f32x16&p0,const f32x16&p1){
  float a=max3f(p0[0],p0[1],p1[0]),b=max3f(p0[2],p0[3],p1[1]);a=max3f(a,p1[2],p1[3]);
  #pragma unroll
  for(int r=4;r<16;r+=4){a=max3f(a,p0[r],p0[r+1]);b=max3f(b,p0[r+2],p0[r+3]);a=max3f(a,p1[r],p1[r+1]);b=max3f(b,p1[r+2],p1[r+3]);}
  const float m=max2f(a,b);
  auto rr=__builtin_amdgcn_permlane32_swap(__float_as_uint(m),__float_as_uint(m),false,false);
  return max2f(__uint_as_float(rr[0]),__uint_as_float(rr[1]));
}
__device__ __forceinline__ void pv(f32x16*o,int vb,bf16x8 pa0,bf16x8 pa1,bf16x8 pa2,bf16x8 pa3){
  #pragma unroll
  for(int d0=0;d0<4;++d0){s16x4 lo[4],hi[4];
    #pragma unroll
    for(int ks=0;ks<4;++ks){
      asm volatile("ds_read_b64_tr_b16 %0,%1 offset:%c2":"=&v"(lo[ks]):"v"(vb),"i"(d0*4096+ks*1024):"memory");
      asm volatile("ds_read_b64_tr_b16 %0,%1 offset:%c2":"=&v"(hi[ks]):"v"(vb),"i"(d0*4096+ks*1024+512):"memory");}
    asm volatile("s_waitcnt lgkmcnt(0)":::"memory");SBAR();
    #define PK(k) (bf16x8){lo[k][0],lo[k][1],lo[k][2],lo[k][3],hi[k][0],hi[k][1],hi[k][2],hi[k][3]}
    o[d0]=__builtin_amdgcn_mfma_f32_32x32x16_bf16(pa0,PK(0),o[d0],0,0,0);
    o[d0]=__builtin_amdgcn_mfma_f32_32x32x16_bf16(pa1,PK(1),o[d0],0,0,0);
    o[d0]=__builtin_amdgcn_mfma_f32_32x32x16_bf16(pa2,PK(2),o[d0],0,0,0);
    o[d0]=__builtin_amdgcn_mfma_f32_32x32x16_bf16(pa3,PK(3),o[d0],0,0,0);
    #undef PK
  }
}

#ifndef ATTN_STORE16
#define ATTN_STORE16(p,v) (*(u32x4*)(p)=(v))
#endif
template<int THRL,bool FAST=false> __device__ __forceinline__ bool attn_unit(long qrow0,long krow0,int NT,int hq,int vcol,const bf16*Q,const bf16*__restrict__ K,const bf16*__restrict__ V,bf16*O,char*shm,
    int fuse=0,float lam=0.f,const float*sgp=nullptr,float gfac=0.f,unsigned char*MIXp=nullptr){
  int tid_o=threadIdx.x; asm volatile("":"+v"(tid_o));
  const int tid=tid_o,lane=tid&63,r32=lane&31,hi=lane>>5; const int wid=__builtin_amdgcn_readfirstlane(tid>>6);
  const bf16*Qw=Q+(qrow0+wid*QBLK)*DM+hq*D;
  const bf16*Kh=K+krow0*DM+hq*D,*Vh=V+krow0*DM+vcol;
  const unsigned lds0=(unsigned)(uintptr_t)shm;
  float*wsf=(float*)(shm+LDS_WS)+wid*64;
  const bf16*ksrc=Kh+(long)lane*DM+wid*8;
  const bf16*vsrc=Vh+(long)(16*(wid&3)+(lane>>2))*DM+(wid>>2)*32+(lane&3)*8;
  const unsigned kdst=lds0+LDS_K+wid*1024, vdst=lds0+LDS_V+wid*1024;
  #define DMA_K(t,slot) glds16(ksrc+(long)(t)*KVBLK*DM,(unsigned)__builtin_amdgcn_readfirstlane(kdst+(slot)))
  #define DMA_V(t,slot) do{ glds16(vsrc+(long)(t)*KVBLK*DM,(unsigned)__builtin_amdgcn_readfirstlane(vdst+2*(slot))); glds16(vsrc+64+(long)(t)*KVBLK*DM,(unsigned)__builtin_amdgcn_readfirstlane(vdst+8192+2*(slot))); }while(0)
  const int vb0=(int)(lds0+LDS_V)+((lane>>4)&1)*32+(lane&3)*8+(4*hi+((lane&15)>>2))*64;
  const char*Kbase=shm+LDS_K; bf16x8 kf[8];
  const lds_cptr shm3=(lds_cptr)shm; const lds_cptr kp0=shm3+LDS_K+hi*1024+r32*16; const lds_cptr vp0=shm3+LDS_V+((lane>>4)&1)*32+(lane&3)*8+(4*hi+((lane&15)>>2))*64;
  DMA_K(0,0);DMA_V(0,0);DMA_K(1,SLOTB);
  bf16x8 qr[4];
  #pragma unroll
  for(int d0=0;d0<4;++d0)qr[d0]=*reinterpret_cast<const bf16x8*>(&Qw[(long)r32*DM+d0*16+hi*8]);
  float mhat=0.f,l_reg=0.f;f32x16 o[4];o[0]=f32x16{};o[1]=f32x16{};o[2]=f32x16{};o[3]=f32x16{};
  #define CMASK(P0,P1,t) do{}while(0)
  bool resc=false;
  #define START(P0,P1) do{ resc=false; if constexpr(!FAST){ const float rm=rowmax(P0,P1); \
    { const float dl=rm; mhat=fadd_s(mhat,dl); \
      _Pragma("unroll") for(int r=0;r<16;++r){P0[r]=fsub_s(P0[r],dl);P1[r]=fsub_s(P1[r],dl);} } } \
    _Pragma("unroll") for(int r=0;r<16;++r)P0[r]=__builtin_amdgcn_exp2f(P0[r]); }while(0)
  #define RESC() do{ if constexpr(!FAST){ if(resc){ asm volatile("s_waitcnt lgkmcnt(0)":::"memory"); \
      _Pragma("unroll") for(int d_=0;d_<4;++d_) _Pragma("unroll") for(int r=0;r<16;++r)o[d_][r]*=wsf[crow(r,hi)]; } } }while(0)
  f32x16 pA0,pA1,pB0,pB1;
  int sl_prev=0,sl_cur=0,sl_next=SLOTB;
  #define ROT() do{sl_prev=sl_cur;sl_cur=sl_next;sl_next=(sl_next==(NSLOT-1)*SLOTB)?0:sl_next+SLOTB;}while(0)
  DMA_K(2,2*SLOTB);
  WAIT_BAR(3);
  { const f32x16 zz=f32x16{}; qkt(pA0,pA1,Kbase,qr,zz,r32,hi); }asm volatile("s_nop 15\n\ts_nop 7":"+v"(pA0),"+v"(pA1));CMASK(pA0,pA1,0);
  START(pA0,pA1);
  _Pragma("unroll") for(int r=0;r<16;++r)pA1[r]=__builtin_amdgcn_exp2f(pA1[r]);
  WAIT_BAR(0);
  DMA_K(3,0);DMA_V(1,SLOTB);
  ROT();
  kload8(kf,kp0+sl_cur);
  WAIT_BAR(3);
  s16x4 vlo[8],vhi[8]; u32x4 pw0,pw1,pw2,pw3;
  #define PKW(P,B) cvtpk_s(P[B],P[B+1])
  #define PAF(k) __builtin_bit_cast(bf16x8,pw##k)
  #define VFR(i) (bf16x8){vlo[i][0],vlo[i][1],vlo[i][2],vlo[i][3],vhi[i][0],vhi[i][1],vhi[i][2],vhi[i][3]}
  #define PIN(x) asm volatile("":"+v"(x))
  #define MX3(a,b,c) __builtin_fmaxf(__builtin_fmaxf((a),(b)),(c))
  #define GAPA(MF,A0,A1,A2,A3,W0,W1,PW) do{ MF; sacc+=A0; sacc+=A1; sacc+=A2; sacc+=A3; PIN(sacc); W0; W1; PIN(PW); SBAR(); }while(0)
  #define EX(v) __builtin_amdgcn_exp2f(v)
  #define GAPB(MF,X,B) do{ MF; X[B]=EX(X[B]); X[B+1]=EX(X[B+1]); X[B+2]=EX(X[B+2]); X[B+3]=EX(X[B+3]); PIN(X); SBAR(); }while(0)
  #define VRD(i) do{ vlo[i]=vtr(vp_+(((i)>>2)*4096+((i)&3)*1024)); vhi[i]=vtr(vp_+(((i)>>2)*4096+((i)&3)*1024+512)); }while(0)
  #define KRD(G,j) do{ if(G){ kload2(kf,kp0+sl_next,j); SBAR(); } }while(0)
  #define GAPB2(MF,X,B) do{ MF; if constexpr(FAST){ X[B]=EX(X[B]); X[B+1]=EX(X[B+1]); } else { X[B]=EX(X[B]-mhat); X[B+1]=EX(X[B+1]-mhat); } PIN(X); SBAR(); }while(0)
  #define VRD2(i) do{ vlo[i]=vtr(vp_+8192+(((i)>>2)*4096+((i)&3)*1024)); vhi[i]=vtr(vp_+8192+(((i)>>2)*4096+((i)&3)*1024+512)); SBAR(); }while(0)
  #define STEP(C0,C1,P0,P1,t,GK,GV,GL) do{ SBAR(); \
    const lds_cptr vp_=vp0+2*sl_prev; \
    VRD(0); SBAR(); float sacc=(P0[0]+P0[1]); \
    GAPA(C0=__builtin_amdgcn_mfma_f32_32x32x16_bf16(kf[0],qr[0],f32x16{},0,0,0), P0[2],P0[3],P0[4],P0[5],     pw0[0]=PKW(P0,0), pw0[1]=PKW(P0,2), pw0); \
    VRD(4); SBAR(); GAPA(C1=__builtin_amdgcn_mfma_f32_32x32x16_bf16(kf[1],qr[0],f32x16{},0,0,0), P0[6],P0[7],P0[8],P0[9],     pw0[2]=PKW(P0,4), pw0[3]=PKW(P0,6), pw0); \
    VRD(1); SBAR(); GAPA(C0=__builtin_amdgcn_mfma_f32_32x32x16_bf16(kf[2],qr[1],C0,0,0,0),   P0[10],P0[11],P0[12],P0[13], pw1[0]=PKW(P0,8), pw1[1]=PKW(P0,10), pw1); \
    VRD(5); SBAR(); GAPA(C1=__builtin_amdgcn_mfma_f32_32x32x16_bf16(kf[3],qr[1],C1,0,0,0),   P0[14],P0[15],P1[0],P1[1],   pw1[2]=PKW(P0,12),pw1[3]=PKW(P0,14), pw1); \
    VRD(2); SBAR(); GAPA(C0=__builtin_amdgcn_mfma_f32_32x32x16_bf16(kf[4],qr[2],C0,0,0,0),   P1[2],P1[3],P1[4],P1[5],     pw2[0]=PKW(P1,0), pw2[1]=PKW(P1,2), pw2); \
    VRD(6); SBAR(); GAPA(C1=__builtin_amdgcn_mfma_f32_32x32x16_bf16(kf[5],qr[2],C1,0,0,0),   P1[6],P1[7],P1[8],P1[9],     pw2[2]=PKW(P1,4), pw2[3]=PKW(P1,6), pw2); \
    VRD(3); SBAR(); GAPA(C0=__builtin_amdgcn_mfma_f32_32x32x16_bf16(kf[6],qr[3],C0,0,0,0),   P1[10],P1[11],P1[12],P1[13], pw3[0]=PKW(P1,8), pw3[1]=PKW(P1,10), pw3); \
    VRD(7); SBAR(); GAPA(C1=__builtin_amdgcn_mfma_f32_32x32x16_bf16(kf[7],qr[3],C1,0,0,0),   P1[14],P1[15],0.f,0.f,       pw3[2]=PKW(P1,12),pw3[3]=PKW(P1,14), pw3); \
    l_reg+=sacc; \
    if(GK){DMA_K((t)+3,sl_cur);} if(GV){DMA_V((t)+1,sl_next);} \
    CMASK(C0,C1,t); \
    if constexpr(!FAST){ float a=MX3(C0[0],C0[1],C1[0]),b=MX3(C0[2],C0[3],C1[1]); a=MX3(a,C1[2],C1[3]); \
      _Pragma("unroll") for(int r=4;r<16;r+=4){a=MX3(a,C0[r],C0[r+1]);b=MX3(b,C0[r+2],C0[r+3]);a=MX3(a,C1[r],C1[r+1]);b=MX3(b,C1[r+2],C1[r+3]);} \
      float rm=__builtin_fmaxf(a,b); { auto rr=__builtin_amdgcn_permlane32_swap(__float_as_uint(rm),__float_as_uint(rm),false,false); rm=__builtin_fmaxf(__uint_as_float(rr[0]),__uint_as_float(rr[1])); } \
      resc=false; \
      if(__builtin_expect(__any(rm-mhat>(float)THRL),0)){ const float dl=__builtin_fmaxf(rm-mhat,0.f); mhat+=dl; \
        const float f=__builtin_amdgcn_exp2f(-dl); l_reg*=f; if(hi==0)wsf[r32]=f; resc=true; } } \
    SBAR(); \
    GAPB2(o[0]=__builtin_amdgcn_mfma_f32_32x32x16_bf16(PAF(0),VFR(0),o[0],0,0,0), C0,0); \
    GAPB2(o[1]=__builtin_amdgcn_mfma_f32_32x32x16_bf16(PAF(0),VFR(4),o[1],0,0,0), C0,2); \
    KRD(GL,0); GAPB2(o[0]=__builtin_amdgcn_mfma_f32_32x32x16_bf16(PAF(1),VFR(1),o[0],0,0,0), C0,4); VRD2(0); \
    KRD(GL,1); GAPB2(o[1]=__builtin_amdgcn_mfma_f32_32x32x16_bf16(PAF(1),VFR(5),o[1],0,0,0), C0,6); VRD2(4); \
    KRD(GL,2); GAPB2(o[0]=__builtin_amdgcn_mfma_f32_32x32x16_bf16(PAF(2),VFR(2),o[0],0,0,0), C0,8); VRD2(1); \
    KRD(GL,3); GAPB2(o[1]=__builtin_amdgcn_mfma_f32_32x32x16_bf16(PAF(2),VFR(6),o[1],0,0,0), C0,10); VRD2(5); \
    GAPB2(o[0]=__builtin_amdgcn_mfma_f32_32x32x16_bf16(PAF(3),VFR(3),o[0],0,0,0), C0,12); VRD2(2); \
    GAPB2(o[1]=__builtin_amdgcn_mfma_f32_32x32x16_bf16(PAF(3),VFR(7),o[1],0,0,0), C0,14); VRD2(6); \
    GAPB2(o[2]=__builtin_amdgcn_mfma_f32_32x32x16_bf16(PAF(0),VFR(0),o[2],0,0,0), C1,0); VRD2(3); \
    GAPB2(o[3]=__builtin_amdgcn_mfma_f32_32x32x16_bf16(PAF(0),VFR(4),o[3],0,0,0), C1,2); VRD2(7); \
    GAPB2(o[2]=__builtin_amdgcn_mfma_f32_32x32x16_bf16(PAF(1),VFR(1),o[2],0,0,0), C1,4); \
    GAPB2(o[3]=__builtin_amdgcn_mfma_f32_32x32x16_bf16(PAF(1),VFR(5),o[3],0,0,0), C1,6); \
    GAPB2(o[2]=__builtin_amdgcn_mfma_f32_32x32x16_bf16(PAF(2),VFR(2),o[2],0,0,0), C1,8); \
    GAPB2(o[3]=__builtin_amdgcn_mfma_f32_32x32x16_bf16(PAF(2),VFR(6),o[3],0,0,0), C1,10); \
    GAPB2(o[2]=__builtin_amdgcn_mfma_f32_32x32x16_bf16(PAF(3),VFR(3),o[2],0,0,0), C1,12); \
    GAPB2(o[3]=__builtin_amdgcn_mfma_f32_32x32x16_bf16(PAF(3),VFR(7),o[3],0,0,0), C1,14); \
    }while(0)
  int t=1;
  #undef CMASK
  #define CMASK(P0,P1,t) do{}while(0)
  for(;t+5<NT;t+=2){
    STEP(pB0,pB1,pA0,pA1,t,true,true,true);     WAIT_BAR(3); RESC(); ROT();
    STEP(pA0,pA1,pB0,pB1,t+1,true,true,true);   WAIT_BAR(3); RESC(); ROT();
  }
  #undef CMASK
  #define CMASK(P0,P1,t) do{}while(0)
  #define ENDW(tt) do{ if((tt)+3<NT){WAIT_BAR(3);} else if((tt)+2<NT){WAIT_BAR(2);} else {WAIT_BAR(0);} }while(0)
  for(;t+1<NT;t+=2){
    STEP(pB0,pB1,pA0,pA1,t,(t+3<NT),(t+1<NT),(t+1<NT));       ENDW(t);   RESC(); ROT();
    STEP(pA0,pA1,pB0,pB1,t+1,(t+4<NT),(t+2<NT),(t+2<NT));     ENDW(t+1); RESC(); ROT();
  }
  STEP(pB0,pB1,pA0,pA1,NT-1,false,false,false); RESC();
  { float sacc=pB0[0]+pB0[1]; _Pragma("unroll") for(int r=2;r<16;++r)sacc+=pB0[r]; _Pragma("unroll") for(int r=0;r<16;++r)sacc+=pB1[r]; l_reg+=sacc;
    pw0=(u32x4){PKW(pB0,0),PKW(pB0,2),PKW(pB0,4),PKW(pB0,6)};pw1=(u32x4){PKW(pB0,8),PKW(pB0,10),PKW(pB0,12),PKW(pB0,14)};pw2=(u32x4){PKW(pB1,0),PKW(pB1,2),PKW(pB1,4),PKW(pB1,6)};pw3=(u32x4){PKW(pB1,8),PKW(pB1,10),PKW(pB1,12),PKW(pB1,14)};
    SBAR(); pv(o,vb0+2*sl_cur,PAF(0),PAF(1),PAF(2),PAF(3)); }
  #undef PKW
  #undef PAF
  #undef VFR
  #undef PIN
  #undef MX3
  #undef GAPA
  #undef GAPB
  #undef EX
  #undef VRD
  #undef KRD
  #undef GAPB2
  #undef VRD2
  #undef STEP
  #undef ENDW
  {auto rr=__builtin_amdgcn_permlane32_swap(__float_as_uint(l_reg),__float_as_uint(l_reg),false,false);l_reg=__uint_as_float(rr[0])+__uint_as_float(rr[1]);}
  if constexpr(FAST){
    #ifdef ATTN_FORCE_RERUN
    const bool bad_=true;
    #else
    const bool bad_=!(l_reg>1e-30f&&l_reg<1e30f);
    #endif
    int*flg=(int*)(shm+LDS_OST); const int bw=__any(bad_)?1:0; if(lane==0)flg[wid*1024]=bw;
    asm volatile("s_waitcnt lgkmcnt(0)\n\ts_barrier":::"memory");
    const int anyb=__any(flg[(lane&7)*1024]!=0);
    asm volatile("s_waitcnt lgkmcnt(0)\n\ts_barrier":::"memory");
    if(anyb)return true;
  }
  if(hi==0)wsf[32+r32]=l_reg;asm volatile("s_waitcnt lgkmcnt(0)":::"memory");
  float rli[16];
  #pragma unroll
  for(int r=0;r<16;++r)rli[r]=__builtin_amdgcn_rcpf(wsf[32+crow(r,hi)]);
  bf16*Ow=O+(qrow0+wid*QBLK)*DM+vcol;
  if(fuse){ bf16*stg=(bf16*)(shm+LDS_OST)+wid*2048; unsigned char*Mw=MIXp+(qrow0+wid*QBLK)*DM+vcol;
    const int ch=lane&7; float dd[2][4][8]; float qs[4]={0.f,0.f,0.f,0.f};
    #pragma unroll
    for(int pss=0;pss<2;++pss){
      #pragma unroll
      for(int r=0;r<16;++r){const int orow=crow(r,hi);
        #pragma unroll
        for(int d0=0;d0<2;++d0)stg[orow*64+d0*32+r32]=__float2bfloat16(o[2*pss+d0][r]*rli[r]);}
      asm volatile("s_waitcnt lgkmcnt(0)":::"memory");
      #pragma unroll
      for(int i=0;i<4;++i){const int row=i*8+(lane>>3); const u32x4 vb_=*(const u32x4*)(stg+row*64+ch*8); const u32x4 va_=*(const u32x4*)(Ow+(long)row*DM+pss*64+ch*8);
        #pragma unroll
        for(int t=0;t<4;++t){ const float a0=__uint_as_float(va_[t]<<16),a1=__uint_as_float(va_[t]&0xffff0000u),b0=__uint_as_float(vb_[t]<<16),b1=__uint_as_float(vb_[t]&0xffff0000u);
          const float e0=a0-lam*b0,e1=a1-lam*b1; dd[pss][i][2*t]=e0; dd[pss][i][2*t+1]=e1; qs[i]+=e0*e0+e1*e1; } }
      asm volatile("s_waitcnt lgkmcnt(0)":::"memory"); }
    #pragma unroll
    for(int i=0;i<4;++i){ float q=qs[i]; q+=__shfl_xor(q,1); q+=__shfl_xor(q,2); q+=__shfl_xor(q,4); qs[i]=1.f/sqrtf(q*(1.f/128.f)+1e-5f); }
    #pragma unroll
    for(int pss=0;pss<2;++pss){ float gv[8];
      #pragma unroll
      for(int t=0;t<8;++t)gv[t]=sgp[pss*64+ch*8+t]*gfac;
      #pragma unroll
      for(int i=0;i<4;++i){const int row=i*8+(lane>>3); unsigned b_[8];
        #pragma unroll
        for(int t=0;t<8;++t)b_[t]=__float_as_uint(__builtin_amdgcn_fmed3f(dd[pss][i][t]*qs[i]*gv[t],-127.0f,127.0f)+12582912.0f);
        typedef unsigned u32x2_ __attribute__((ext_vector_type(2))); u32x2_ w;
        w.x=__builtin_amdgcn_perm(b_[1],b_[0],0x0c0c0400u)|(__builtin_amdgcn_perm(b_[3],b_[2],0x0c0c0400u)<<16);
        w.y=__builtin_amdgcn_perm(b_[5],b_[4],0x0c0c0400u)|(__builtin_amdgcn_perm(b_[7],b_[6],0x0c0c0400u)<<16);
        *(u32x2_*)(Mw+(long)row*DM+pss*64+ch*8)=w;} }
  } else
  { bf16*stg=(bf16*)(shm+LDS_OST)+wid*2048;
    #pragma unroll
    for(int pss=0;pss<2;++pss){
      #pragma unroll
      for(int r=0;r<16;++r){const int orow=crow(r,hi);
        #pragma unroll
        for(int d0=0;d0<2;++d0)stg[orow*64+d0*32+r32]=__float2bfloat16(o[2*pss+d0][r]*rli[r]);}
      asm volatile("s_waitcnt lgkmcnt(0)":::"memory");
      #pragma unroll
      for(int i=0;i<4;++i){const int row=i*8+(lane>>3),ch=lane&7; const u32x4 v=*(const u32x4*)(stg+row*64+ch*8); ATTN_STORE16(Ow+(long)row*DM+pss*64+ch*8,v);}
      asm volatile("s_waitcnt lgkmcnt(0)":::"memory"); } }
  asm volatile("s_waitcnt lgkmcnt(0)\n\ts_barrier":::"memory");
  return false;
  #undef DMA_K
  #undef DMA_V
  #undef CMASK
  #undef START
  #undef RESC
  #undef ROT
}
constexpr int ATTN_LDS_BYTES=LDS_BYTES;
#undef SBAR
#undef WAIT_BAR
}

#define GAS __attribute__((address_space(1)))
#define LAS __attribute__((address_space(3)))
typedef unsigned short bf16;
typedef unsigned v4u __attribute__((ext_vector_type(4)));
typedef float f32x4 __attribute__((ext_vector_type(4)));
typedef short bf16x8 __attribute__((ext_vector_type(8)));
typedef GAS unsigned gu32;
typedef GAS unsigned long long gu64;
#define RLX_AGENT __ATOMIC_RELAXED, __HIP_MEMORY_SCOPE_AGENT
#define LDS_WAIT() asm volatile("s_waitcnt lgkmcnt(0)" ::: "memory")
#define VM_WAIT() asm volatile("s_waitcnt vmcnt(0)" ::: "memory")
__device__ __forceinline__ unsigned long long rt() { return __builtin_amdgcn_s_memrealtime(); }
__device__ __forceinline__ unsigned f2bf(float f) { unsigned u = __builtin_bit_cast(unsigned, f); return (u + 0x7fffu + ((u >> 16) & 1u)) >> 16; }
__device__ __forceinline__ unsigned pk2(float lo, float hi) { return f2bf(lo) | (f2bf(hi) << 16); }

#define XB_TMO      128
#define XB_XCNT(j)  (256  + 64 * (j))
#define XB_XSUB(j)  (1280 + 64 * (j))
#define XB_XGEN(j)  (2304 + 64 * (j))
#define XB_TOP      3328
#define XB_TOPGEN   3392
#define XCD_BAR_WORDS 3456
#define XB_SPIN_CAP (1u << 24)

__device__ __forceinline__ unsigned xb_ld(unsigned* p)              { return __hip_atomic_load(p, __ATOMIC_RELAXED, __HIP_MEMORY_SCOPE_AGENT); }
__device__ __forceinline__ unsigned xb_add(unsigned* p, unsigned v) { return __hip_atomic_fetch_add(p, v, __ATOMIC_RELAXED, __HIP_MEMORY_SCOPE_AGENT); }
__device__ __forceinline__ unsigned xb_xcc_id() { return (unsigned)__builtin_amdgcn_s_getreg((3 << 11) | 20) & 0xFu; }
#define XB_SPIN(cond, bar) do { unsigned _sp = 0; while (cond) { __builtin_amdgcn_s_sleep(1); \
    if ((++_sp & 255u) == 0u) { if (xb_ld(&(bar)[XB_TMO])) break; if (_sp > XB_SPIN_CAP) { atomicAdd(&(bar)[XB_TMO], 1u); break; } } } } while (0)

struct XcdBarrier {
    unsigned* bar; unsigned x;
    volatile LAS unsigned* st;
};

__device__ __forceinline__ XcdBarrier xcd_barrier_post(unsigned* bar, volatile LAS unsigned* st) {
    XcdBarrier b; b.bar = bar; b.x = xb_xcc_id(); b.st = st;
    if (threadIdx.x == 0) (void)xb_add(&bar[XB_XCNT(b.x)], 1u);
    return b;
}
__device__ __forceinline__ void xcd_barrier_complete(unsigned* bar, unsigned x, unsigned& nloc, unsigned& nx) {
    const unsigned G = gridDim.x * gridDim.y * gridDim.z;
    unsigned sum, cnt, mine, sp = 0u;
    for (;;) {
        sum = 0u; cnt = 0u; mine = 0u;
#pragma unroll
        for (unsigned j = 0; j < 16; ++j) { const unsigned c = xb_ld(&bar[XB_XCNT(j)]); sum += c; cnt += (c > 0u) ? 1u : 0u; mine = (j == x) ? c : mine; }
        if (sum == G) break;
        __builtin_amdgcn_s_sleep(1);
        if ((++sp & 255u) == 0u) { if (xb_ld(&bar[XB_TMO])) break; if (sp > XB_SPIN_CAP) { atomicAdd(&bar[XB_TMO], 1u); break; } }
    }
    nloc = mine > 0u ? mine : 1u; nx = cnt > 0u ? cnt : 1u;
}

__device__ __forceinline__ void xcd_barrier(const XcdBarrier& b) {
    asm volatile("s_waitcnt vmcnt(0)" ::: "memory");
    __syncthreads();
    if (threadIdx.x == 0) {
        unsigned* bar = b.bar;
        __builtin_amdgcn_s_waitcnt(0);
        unsigned nloc = b.st[0], nx = b.st[1];
        if (nloc == 0u) { xcd_barrier_complete(bar, b.x, nloc, nx); b.st[0] = nloc; b.st[1] = nx; }
        const unsigned old = xb_add(&bar[XB_XSUB(b.x)], 1u);
        const unsigned gen = old / nloc;
        if (old + 1u == (gen + 1u) * nloc) {
            __builtin_amdgcn_fence(__ATOMIC_RELEASE, "agent");
            asm volatile("s_waitcnt vmcnt(0)" ::: "memory");
            const unsigned og = xb_add(&bar[XB_TOP], 1u);
            const unsigned tg = og / nx;
            if (og + 1u == (tg + 1u) * nx) xb_add(&bar[XB_TOPGEN], 1u);
            else XB_SPIN(xb_ld(&bar[XB_TOPGEN]) == tg, bar);
            __builtin_amdgcn_fence(__ATOMIC_ACQUIRE, "agent");
            xb_add(&bar[XB_XGEN(b.x)], 1u);
            asm volatile("s_waitcnt vmcnt(0)" ::: "memory");
        } else {
            XB_SPIN(xb_ld(&bar[XB_XGEN(b.x)]) == gen, bar);
            __builtin_amdgcn_fence(__ATOMIC_ACQUIRE, "agent");
            asm volatile("s_waitcnt vmcnt(0)" ::: "memory");
        }
    }
    __syncthreads();
}

constexpr int NWAVES = 8;
constexpr int BATCH = 2, SEQ = 8192, DM = 1024, CTXL = 256, DEPTH = 4;
constexpr int RL = BATCH * SEQ, RC = BATCH * CTXL, RT = RL + RC;
constexpr int KVB = SEQ + CTXL;
constexpr int NE = 32, TOPK = 4, CAPB = 296, CAP = CAPB * 256;
constexpr float LN_EPS = 1e-5f, RMS_EPS = 1e-5f;
constexpr float DN_ALPHA = 1.6817928305074290f;
constexpr float OSC = 64.f;
constexpr float WQ = 127.f / 0.25f, WQD = 127.f / 0.105f, ACTQ = 127.f / 16.f;
constexpr int MODK = 16;
#ifndef ONE_LAUNCH
#define ONE_LAUNCH 1
#endif
#ifndef DEBUG_CODES
#define DEBUG_CODES 0
#endif
#ifndef PROBE
#define PROBE 0
#endif
#ifndef DBG_ATTN
#define DBG_ATTN 0
#endif
#ifndef USE_DATTN
#define USE_DATTN DBG_ATTN
#endif

constexpr size_t MiB = 1u << 20;
constexpr size_t WS_CTL = 0, CTL_ZERO_BYTES = 1 * MiB;
constexpr size_t WS_MODP = 1 * MiB, WS_MOD = 6 * MiB, WS_TAB = 7 * MiB;
constexpr size_t WS_WQKV = 8 * MiB, WS_WO = 20 * MiB, WS_FNIN = 24 * MiB, WS_FNOUT = 28 * MiB, WS_WGU = 32 * MiB, WS_WD = 544 * MiB;
constexpr size_t WS_X = 800 * MiB, WS_A1 = 868 * MiB, WS_A2 = 902 * MiB, WS_Q = 936 * MiB, WS_K = 970 * MiB, WS_V = 1004 * MiB, WS_O0 = 1038 * MiB, WS_O1 = 1072 * MiB;
constexpr size_t WS_MIX = 1106 * MiB, WS_Y = 1140 * MiB, WS_U = 1174 * MiB, WS_U2 = 1208 * MiB, WS_Z1 = 1242 * MiB, WS_ZC = 1306 * MiB, WS_T = 1308 * MiB;
constexpr size_t WS_AMOE = 1372 * MiB, WS_DEST = 1817 * MiB, WS_ASGE = 1818 * MiB, WS_ASGS = 1819 * MiB, WS_ASGG = 1820 * MiB;
constexpr size_t WS_WGB = 1821 * MiB, WS_WRT = 1822 * MiB, WS_X2 = 1823 * MiB, WS_ASCR = 1891 * MiB, WS_A1S = 1893 * MiB;
constexpr float MIXCLIP = 6.f;
constexpr size_t WS_MIX8 = WS_O1;
constexpr int CAPE_B = RT / 256, CAPE = RT;
constexpr size_t WS_ACT = 1900 * MiB, WS_OUTM = WS_ACT + (size_t)NE * CAPE * 1024, WS_GATE = WS_OUTM + (size_t)NE * CAPE * 1024, WS_ASCD = WS_GATE + 3 * MiB, WS_TOKR = WS_ASCD + 3 * MiB, WS_END = WS_TOKR + 3 * MiB;
constexpr size_t TB_ROPEC = 0, TB_ROPES = 8192, TB_TWC = 16384, TB_TWS = 49152, TB_DFTC = 81920, TB_DFT1 = 147456, TB_DFT2 = 278528, TB_DFT256 = 344064;
constexpr int CW_DBG = 8, CW_BAR = 4096, CW_CNT = 16384;

constexpr int RING_OFF = 0, RING_BYTES = 131072;
constexpr int LDSCTL_OFF = RING_BYTES, MISC_OFF = LDSCTL_OFF + 320;
constexpr int TAB_OFF = LDSCTL_OFF + 1024;
constexpr int LDS_BYTES = 147456;

__device__ __forceinline__ float shx(float v, int o, int lane) { return __builtin_bit_cast(float, __builtin_amdgcn_ds_bpermute((lane ^ o) << 2, __builtin_bit_cast(int, v))); }
__device__ __forceinline__ int shxi(int v, int o, int lane) { return __builtin_amdgcn_ds_bpermute((lane ^ o) << 2, v); }
__device__ __forceinline__ int shli(int v, int src) { return __builtin_amdgcn_ds_bpermute(src << 2, v); }
template <int CTRL> __device__ __forceinline__ float dppf(float v) { return __builtin_bit_cast(float, __builtin_amdgcn_update_dpp(0, __builtin_bit_cast(int, v), CTRL, 0xF, 0xF, true)); }
__device__ __forceinline__ float row16_sum(float v) { v += dppf<0xB1>(v); v += dppf<0x4E>(v); v += dppf<0x141>(v); v += dppf<0x140>(v); return v; }
__device__ __forceinline__ float wsum(float v) { v = row16_sum(v);
    { auto rr = __builtin_amdgcn_permlane16_swap(__float_as_uint(v), __float_as_uint(v), false, false); v = __uint_as_float(rr[0]) + __uint_as_float(rr[1]); }
    { auto rr = __builtin_amdgcn_permlane32_swap(__float_as_uint(v), __float_as_uint(v), false, false); v = __uint_as_float(rr[0]) + __uint_as_float(rr[1]); }
    return v; }
__device__ __forceinline__ float wmaxf(float v) { v = fmaxf(v, dppf<0xB1>(v)); v = fmaxf(v, dppf<0x4E>(v)); v = fmaxf(v, dppf<0x141>(v)); v = fmaxf(v, dppf<0x140>(v));
    { auto rr = __builtin_amdgcn_permlane16_swap(__float_as_uint(v), __float_as_uint(v), false, false); v = fmaxf(__uint_as_float(rr[0]), __uint_as_float(rr[1])); }
    { auto rr = __builtin_amdgcn_permlane32_swap(__float_as_uint(v), __float_as_uint(v), false, false); v = fmaxf(__uint_as_float(rr[0]), __uint_as_float(rr[1])); }
    return v; }
__device__ __forceinline__ float wave_sum(float v, int lane) {
#pragma unroll
    for (int o = 1; o < 64; o <<= 1) v += shx(v, o, lane);
    return v;
}
__device__ __forceinline__ float wave_max(float v, int lane) {
#pragma unroll
    for (int o = 1; o < 64; o <<= 1) v = fmaxf(v, shx(v, o, lane));
    return v;
}
__device__ __forceinline__ int wave_min_i(int v, int lane) {
#pragma unroll
    for (int o = 1; o < 64; o <<= 1) { const int w = shxi(v, o, lane); v = w < v ? w : v; }
    return v;
}
__device__ __forceinline__ float bf2f(unsigned h) { return __builtin_bit_cast(float, h << 16); }

__device__ __forceinline__ void ld_f32(const float* p, int lane, float (&v)[16]) {
#pragma unroll
    for (int j = 0; j < 2; ++j) { const f32x4 a = *(const f32x4*)(p + 512 * j + 8 * lane), b = *(const f32x4*)(p + 512 * j + 8 * lane + 4);
        v[8 * j + 0] = a[0]; v[8 * j + 1] = a[1]; v[8 * j + 2] = a[2]; v[8 * j + 3] = a[3]; v[8 * j + 4] = b[0]; v[8 * j + 5] = b[1]; v[8 * j + 6] = b[2]; v[8 * j + 7] = b[3]; }
}
__device__ __forceinline__ void st_f32(float* p, int lane, const float (&v)[16]) {
#pragma unroll
    for (int j = 0; j < 2; ++j) { *(f32x4*)(p + 512 * j + 8 * lane) = (f32x4){v[8 * j], v[8 * j + 1], v[8 * j + 2], v[8 * j + 3]}; *(f32x4*)(p + 512 * j + 8 * lane + 4) = (f32x4){v[8 * j + 4], v[8 * j + 5], v[8 * j + 6], v[8 * j + 7]}; }
}
__device__ __forceinline__ void ld_bf16(const bf16* p, int lane, float (&v)[16]) {
#pragma unroll
    for (int j = 0; j < 2; ++j) { const v4u w = *(const v4u*)(p + 512 * j + 8 * lane);
        v[8 * j + 0] = bf2f(w.x & 0xffffu); v[8 * j + 1] = bf2f(w.x >> 16); v[8 * j + 2] = bf2f(w.y & 0xffffu); v[8 * j + 3] = bf2f(w.y >> 16);
        v[8 * j + 4] = bf2f(w.z & 0xffffu); v[8 * j + 5] = bf2f(w.z >> 16); v[8 * j + 6] = bf2f(w.w & 0xffffu); v[8 * j + 7] = bf2f(w.w >> 16); }
}
__device__ __forceinline__ void st_bf16(bf16* p, int lane, const float (&v)[16]) {
#pragma unroll
    for (int j = 0; j < 2; ++j) { v4u w; w.x = pk2(v[8 * j], v[8 * j + 1]); w.y = pk2(v[8 * j + 2], v[8 * j + 3]); w.z = pk2(v[8 * j + 4], v[8 * j + 5]); w.w = pk2(v[8 * j + 6], v[8 * j + 7]); *(v4u*)(p + 512 * j + 8 * lane) = w; }
}
__device__ __forceinline__ void ld_f16(const unsigned short* p, int lane, float (&v)[16]) {
    typedef _Float16 h8 __attribute__((ext_vector_type(8)));
#pragma unroll
    for (int j = 0; j < 2; ++j) { const h8 w = *(const h8*)(p + 512 * j + 8 * lane);
#pragma unroll
        for (int t = 0; t < 8; ++t) v[8 * j + t] = (float)w[t]; }
}
__device__ __forceinline__ void st_f16(unsigned short* p, int lane, const float (&v)[16]) {
    typedef _Float16 h8 __attribute__((ext_vector_type(8)));
#pragma unroll
    for (int j = 0; j < 2; ++j) { h8 w;
#pragma unroll
        for (int t = 0; t < 8; ++t) w[t] = (_Float16)v[8 * j + t];
        *(h8*)(p + 512 * j + 8 * lane) = w; }
}
__device__ __forceinline__ void ld_f32(const LAS float* p, int lane, float (&v)[16]) {
#pragma unroll
    for (int j = 0; j < 2; ++j) { const f32x4 a = *(const LAS f32x4*)(p + 512 * j + 8 * lane), b = *(const LAS f32x4*)(p + 512 * j + 8 * lane + 4);
        v[8 * j + 0] = a[0]; v[8 * j + 1] = a[1]; v[8 * j + 2] = a[2]; v[8 * j + 3] = a[3]; v[8 * j + 4] = b[0]; v[8 * j + 5] = b[1]; v[8 * j + 6] = b[2]; v[8 * j + 7] = b[3]; }
}
template <class P> __device__ __forceinline__ void ln_row(float (&v)[16], P g, P b, int lane) {
    float s = 0.f;
#pragma unroll
    for (int t = 0; t < 16; ++t) s += v[t];
    const float mean = wsum(s) * (1.f / 1024.f); float q = 0.f;
#pragma unroll
    for (int t = 0; t < 16; ++t) { v[t] -= mean; q += v[t] * v[t]; }
    const float rstd = 1.f / sqrtf(wsum(q) * (1.f / 1024.f) + LN_EPS);
    float gg[16], bb[16]; ld_f32(g, lane, gg); ld_f32(b, lane, bb);
#pragma unroll
    for (int t = 0; t < 16; ++t) v[t] = v[t] * rstd * gg[t] + bb[t];
}

__device__ __forceinline__ void transpose_item(const float* W, int K, int N, bf16* WT, LAS float* scr, int k0, int n0, int lane) {
    float ld_[32];
#pragma unroll
    for (int i = 0; i < 32; ++i) ld_[i] = W[(size_t)(k0 + 2 * i + (lane >> 5)) * N + n0 + (lane & 31)];
#pragma unroll
    for (int i = 0; i < 32; ++i) scr[(2 * i + (lane >> 5)) * 33 + (lane & 31)] = ld_[i];
    LDS_WAIT(); asm volatile("" ::: "memory");
    const int c = lane & 7;
#pragma unroll
    for (int j = 0; j < 4; ++j) { const int n = (lane >> 3) + 8 * j; const LAS float* s = scr + (8 * c) * 33 + n;
        v4u o; o.x = pk2(s[0 * 33], s[1 * 33]); o.y = pk2(s[2 * 33], s[3 * 33]); o.z = pk2(s[4 * 33], s[5 * 33]); o.w = pk2(s[6 * 33], s[7 * 33]);
        *(GAS v4u*)(WT + (size_t)n * K + k0 + 8 * c) = o; }
    LDS_WAIT(); asm volatile("" ::: "memory");
}
__device__ __forceinline__ void ti8_load(const float* W, int N, int k0, int n0, int lane, float (&ld_)[32]) {
#pragma unroll
    for (int i = 0; i < 32; ++i) ld_[i] = __builtin_nontemporal_load(W + (size_t)(k0 + 2 * i + (lane >> 5)) * N + n0 + (lane & 31));
}
__device__ __forceinline__ void ti8_finish(const float (&ld_)[32], unsigned char* WT, int Kb, LAS float* scr, int k0, int lane, float scale) {
#pragma unroll
    for (int i = 0; i < 32; ++i) scr[(2 * i + (lane >> 5)) * 33 + (lane & 31)] = ld_[i];
    LDS_WAIT(); asm volatile("" ::: "memory");
    const int n = lane >> 1, kh = lane & 1; const LAS float* s = scr + (32 * kh) * 33 + n;
    unsigned w[8];
#pragma unroll
    for (int q = 0; q < 8; ++q) w[q] = pg8::pk4_i8(s[(4 * q) * 33] * scale, s[(4 * q + 1) * 33] * scale, s[(4 * q + 2) * 33] * scale, s[(4 * q + 3) * 33] * scale);
    GAS v4u* o = (GAS v4u*)(WT + (size_t)n * Kb + k0 + 32 * kh);
    o[0] = (v4u){w[0], w[1], w[2], w[3]}; o[1] = (v4u){w[4], w[5], w[6], w[7]};
    LDS_WAIT(); asm volatile("" ::: "memory");
}
__device__ __forceinline__ void transpose_item_i8(const float* W, int N, unsigned char* WT, int Kb, LAS float* scr, int k0, int n0, int lane, float scale) {
    float ld_[32]; ti8_load(W, N, k0, n0, lane, ld_); ti8_finish(ld_, WT, Kb, scr, k0, lane, scale);
}
__device__ __forceinline__ void ti8_half(const float (&ld_)[32], LAS float* scr, int lane, float scale, unsigned (&w)[8]) {
#pragma unroll
    for (int i = 0; i < 32; ++i) scr[(2 * i + (lane >> 5)) * 33 + (lane & 31)] = ld_[i];
    LDS_WAIT(); asm volatile("" ::: "memory");
    const LAS float* s = scr + (32 * (lane >> 5)) * 33 + (lane & 31);
#pragma unroll
    for (int q = 0; q < 8; ++q) w[q] = pg8::pk4_i8(s[(4 * q) * 33] * scale, s[(4 * q + 1) * 33] * scale, s[(4 * q + 2) * 33] * scale, s[(4 * q + 3) * 33] * scale);
    LDS_WAIT(); asm volatile("" ::: "memory");
}
__device__ __forceinline__ void transpose_item2_i8(const float* W, int N, unsigned char* WT, int Kb, LAS float* scr, int k0, int n0, int lane, float scale, bool nostore = false) {
    float la[32], lb[32]; ti8_load(W, N, k0, n0, lane, la); ti8_load(W, N, k0 + 64, n0, lane, lb);
    unsigned wa[8], wb[8]; ti8_half(la, scr, lane, scale, wa); ti8_half(lb, scr, lane, scale, wb);
    if (nostore) { asm volatile("" :: "v"(wa[0]), "v"(wa[7]), "v"(wb[0]), "v"(wb[7])); return; }
    LAS unsigned char* ob = (LAS unsigned char*)scr;
    { const int n = lane & 31, q = lane >> 5; LAS v4u* d0 = (LAS v4u*)(ob + n * 144 + 32 * q); LAS v4u* d1 = (LAS v4u*)(ob + n * 144 + 64 + 32 * q);
      d0[0] = (v4u){wa[0], wa[1], wa[2], wa[3]}; d0[1] = (v4u){wa[4], wa[5], wa[6], wa[7]}; d1[0] = (v4u){wb[0], wb[1], wb[2], wb[3]}; d1[1] = (v4u){wb[4], wb[5], wb[6], wb[7]}; }
    LDS_WAIT(); asm volatile("" ::: "memory");
#pragma unroll
    for (int i = 0; i < 4; ++i) { const int row = (lane >> 3) + 8 * i, ch = lane & 7; const v4u v = *(const LAS v4u*)(ob + row * 144 + ch * 16);
        *(GAS v4u*)(WT + (size_t)row * Kb + k0 + ch * 16) = v; }
    LDS_WAIT(); asm volatile("" ::: "memory");
}
#ifndef MC_VIA_REGS
#define MC_VIA_REGS 1
#endif
__device__ __forceinline__ void mc_dma(const float* p, int N, unsigned loff, LAS unsigned char* reg) {
#pragma unroll
    for (int i = 0; i < 16; ++i) __builtin_amdgcn_global_load_lds((const unsigned*)((const char*)(p + (size_t)i * N) + loff), (LAS unsigned*)(reg + i * 1024), 16, 0, 0);
}
__device__ __forceinline__ void mc_pack4(const f32x4 (&v)[16], float scale, v4u (&w)[4]) {
#pragma unroll
    for (int j = 0; j < 4; ++j) { unsigned o[4];
#pragma unroll
        for (int q = 0; q < 4; ++q) { unsigned b[4];
#pragma unroll
            for (int i = 0; i < 4; ++i) b[i] = __float_as_uint(__builtin_amdgcn_fmed3f(__builtin_fmaf(v[4 * q + i][j], scale, 12582912.0f), 12582912.0f - 127.0f, 12582912.0f + 127.0f));
            o[q] = __builtin_amdgcn_perm(b[1], b[0], 0x0c0c0400u) | (__builtin_amdgcn_perm(b[3], b[2], 0x0c0c0400u) << 16); }
        w[j] = (v4u){o[0], o[1], o[2], o[3]}; }
}
template <bool GU> __device__ __forceinline__ void moe_conv_stream(const float* W, unsigned char* WT, int i0, int i1, int wi, int nw, LAS unsigned char* reg, int lane, float scale) {
    constexpr int N = GU ? 2048 : 1024, SH = GU ? 9 : 8, KSH = GU ? 6 : 5;
    int it = i0 + wi; if (it >= i1) return;
#define MC_SRC(itx) (W + (size_t)((itx) >> SH) * 1024 * N + (size_t)((((itx) & ((1 << SH) - 1)) >> KSH) * 128) * N + ((itx) & ((1 << KSH) - 1)) * 32)
#define MC_DROW(n0) (GU ? ((n0) < 1024 ? (((n0) >> 7) * 256 + ((n0) & 127)) : (((((n0) - 1024) >> 7) * 256) + 128 + (((n0) - 1024) & 127))) : (n0))
    const unsigned loff = (unsigned)((16 * (lane >> 3)) * N + 4 * (lane & 7)) * 4u;
    const int ch = lane & 7, a = lane >> 3; const LAS unsigned char* rd = reg + (a + 8 * ch) * 16;
#if MC_VIA_REGS
    f32x4 ld_[16];
#define MC_LOAD(itx) do { const float* p_ = MC_SRC(itx); _Pragma("unroll") for (int i = 0; i < 16; ++i) ld_[i] = __builtin_nontemporal_load((const f32x4*)((const char*)(p_ + (size_t)i * N) + loff)); } while (0)
    MC_LOAD(it);
#pragma unroll 1
    for (; it < i1; it += nw) {
#pragma unroll
        for (int i = 0; i < 16; ++i) *(LAS f32x4*)(reg + i * 1024 + lane * 16) = ld_[i];
        __builtin_amdgcn_sched_barrier(0);
        if (it + nw < i1) MC_LOAD(it + nw);
        __builtin_amdgcn_sched_barrier(0);
        asm volatile("s_waitcnt lgkmcnt(0)" ::: "memory");
        f32x4 v[16];
#pragma unroll
        for (int i = 0; i < 16; ++i) v[i] = *(const LAS f32x4*)(rd + i * 1024);
        asm volatile("s_waitcnt lgkmcnt(0)" ::: "memory");
        v4u w[4]; mc_pack4(v, scale, w);
        const int r_ = it & ((1 << SH) - 1), n0 = (r_ & ((1 << KSH) - 1)) * 32;
        unsigned char* dst = WT + (size_t)(it >> SH) * N * 1024 + (size_t)(MC_DROW(n0) + 4 * a) * 1024 + (r_ >> KSH) * 128 + ch * 16;
#pragma unroll
        for (int j = 0; j < 4; ++j) *(GAS v4u*)(dst + (size_t)j * 1024) = w[j];
        asm volatile("" ::: "memory");
    }
#undef MC_LOAD
#else
    mc_dma(MC_SRC(it), N, loff, reg);
#pragma unroll 1
    for (; it < i1; it += nw) {
        asm volatile("s_waitcnt vmcnt(0)" ::: "memory");
        f32x4 v[16];
#pragma unroll
        for (int i = 0; i < 16; ++i) v[i] = *(const LAS f32x4*)(rd + i * 1024);
        asm volatile("s_waitcnt lgkmcnt(0)" ::: "memory");
        if (it + nw < i1) mc_dma(MC_SRC(it + nw), N, loff, reg);
        v4u w[4]; mc_pack4(v, scale, w);
        const int r_ = it & ((1 << SH) - 1), n0 = (r_ & ((1 << KSH) - 1)) * 32;
        unsigned char* dst = WT + (size_t)(it >> SH) * N * 1024 + (size_t)(MC_DROW(n0) + 4 * a) * 1024 + (r_ >> KSH) * 128 + ch * 16;
#pragma unroll
        for (int j = 0; j < 4; ++j) *(GAS v4u*)(dst + (size_t)j * 1024) = w[j];
    }
#endif
#undef MC_SRC
#undef MC_DROW
}
__device__ __forceinline__ void moe_conv_range(const float* Wgu, unsigned char* WTgu, const float* Wd, unsigned char* WTd, int gu0, int gu1, int d0, int d1, int wi, int nw, LAS float* scr, int lane) {
    moe_conv_stream<true>(Wgu, WTgu, gu0, gu1, wi, nw, (LAS unsigned char*)scr, lane, WQ);
    moe_conv_stream<false>(Wd, WTd, d0, d1, wi, nw, (LAS unsigned char*)scr, lane, WQD);
}
__device__ __forceinline__ void st_i8(unsigned char* p, int lane, const float (&v)[16], float scale) {
#pragma unroll
    for (int j = 0; j < 2; ++j) { typedef unsigned u32x2_t __attribute__((ext_vector_type(2))); u32x2_t w;
        w.x = pg8::pk4_i8(v[8 * j] * scale, v[8 * j + 1] * scale, v[8 * j + 2] * scale, v[8 * j + 3] * scale); w.y = pg8::pk4_i8(v[8 * j + 4] * scale, v[8 * j + 5] * scale, v[8 * j + 6] * scale, v[8 * j + 7] * scale);
        *(u32x2_t*)(p + 512 * j + 8 * lane) = w; }
}
__device__ __forceinline__ float st_i8_row(unsigned char* p, float* sc, int lane, const float (&v)[16]) {
    float am = 0.f;
#pragma unroll
    for (int t = 0; t < 16; ++t) am = fmaxf(am, fabsf(v[t]));
    am = fmaxf(wmaxf(am), 1e-20f); st_i8(p, lane, v, 127.f / am); if (lane == 0) *sc = am * (1.f / 127.f);
    return am * (1.f / 127.f);
}
__device__ __forceinline__ float silu_f(float x) { return x / (1.f + expf(-x)); }

struct Args { const float* in[21]; float* out; unsigned char* ws; int ph_lo, ph_hi; };

template <class P> __device__ __forceinline__ void pm1_comb(int lane, const v4u (&xw)[2], const v4u (&yw)[2], P g1p, float (&v)[16]) {
    float y[16], g1[16]; ld_f32(g1p, lane, g1);
#pragma unroll
    for (int j = 0; j < 2; ++j) { typedef _Float16 h8 __attribute__((ext_vector_type(8))); const h8 hx = __builtin_bit_cast(h8, xw[j]);
#pragma unroll
        for (int t = 0; t < 8; ++t) v[8 * j + t] = (float)hx[t];
        y[8 * j + 0] = bf2f(yw[j].x & 0xffffu); y[8 * j + 1] = bf2f(yw[j].x >> 16); y[8 * j + 2] = bf2f(yw[j].y & 0xffffu); y[8 * j + 3] = bf2f(yw[j].y >> 16);
        y[8 * j + 4] = bf2f(yw[j].z & 0xffffu); y[8 * j + 5] = bf2f(yw[j].z >> 16); y[8 * j + 6] = bf2f(yw[j].w & 0xffffu); y[8 * j + 7] = bf2f(yw[j].w >> 16); }
#pragma unroll
    for (int t = 0; t < 16; ++t) v[t] = DN_ALPHA * v[t] + g1[t] * y[t];
}
template <class P> __device__ __forceinline__ float pm1_pre2(int r, int lane, P scp, P shp, P lng, P lnb, unsigned short* X2, unsigned char* A2, float* asr, float (&v)[16]) {
    ln_row(v, lng, lnb, lane);
    st_f16(X2 + (size_t)r * 1024, lane, v);
    { float sc[16], sh[16]; ld_f32(scp, lane, sc); ld_f32(shp, lane, sh);
#pragma unroll
      for (int t = 0; t < 16; ++t) v[t] = v[t] * (1.f + sc[t]) + sh[t]; }
    return st_i8_row(A2 + (size_t)r * 1024, asr + r, lane, v);
}
__device__ __forceinline__ void pm1_post(int r, bool active, bool first, int lane, float (&p)[32], const float* brt, LAS float* LG, LAS int* TAB, int* asg_e, int* asg_s, float* asg_g) {
#define RSTEP(half, msk) { const bool up = (lane & (msk)) != 0; _Pragma("unroll") for (int t = 0; t < (half); ++t) { const float keep = up ? p[t + (half)] : p[t], send = up ? p[t] : p[t + (half)]; p[t] = keep + shx(send, (msk), lane); } }
    RSTEP(16, 32) RSTEP(8, 16) RSTEP(4, 8) RSTEP(2, 4) RSTEP(1, 2)
#undef RSTEP
    float lg = p[0] + shx(p[0], 1, lane);
    const int myE = (lane >> 1) & 31;
    lg += brt[myE];
    float val = (lane & 1) ? -INFINITY : lg; float mx = 0.f, esum = 0.f, myex = 0.f; int rank = 4;
#pragma unroll
    for (int kx = 0; kx < 4; ++kx) { const float m = wmaxf(val); const unsigned long long bal = __ballot(val == m); const int win = __builtin_ctzll(bal);
        if (kx == 0) mx = m;
        const float ex = expf(m - mx); esum += ex;
        if (lane == win) { rank = kx; myex = ex; val = -INFINITY; } }
    const bool sel = rank < 4; const float ex = myex, gs = esum;
    if (sel && active && first) { const int sl = __hip_atomic_fetch_add(TAB + myE, 1, __ATOMIC_RELAXED, __HIP_MEMORY_SCOPE_WORKGROUP);
        asg_e[r * 4 + rank] = myE; asg_s[r * 4 + rank] = sl; asg_g[r * 4 + rank] = ex / gs; }
}
__device__ __forceinline__ void pm1_top4(bool active, bool first, int lane, float lg, LAS int* TAB, LAS int* rec) {
    const int myE = lane & 31;
    float val = (lane < 32) ? lg : -INFINITY; float mx = 0.f, esum = 0.f, myex = 0.f; int rank = 4;
#pragma unroll
    for (int kx = 0; kx < 4; ++kx) { const float m = wmaxf(val); const unsigned long long bal = __ballot(val == m); const int win = __builtin_ctzll(bal);
        if (kx == 0) mx = m;
        const float ex = expf(m - mx); esum += ex;
        if (lane == win) { rank = kx; myex = ex; val = -INFINITY; } }
    if (rank < 4 && active && first) { const int sl = __hip_atomic_fetch_add(TAB + myE, 1, __ATOMIC_RELAXED, __HIP_MEMORY_SCOPE_WORKGROUP);
        rec[rank] = myE; rec[4 + rank] = sl; rec[8 + rank] = __builtin_bit_cast(int, myex / esum); }
}
typedef const float* cfptr_t;
typedef const cfptr_t __attribute__((address_space(4)))* kin_t;
#define PHASE_BASES unsigned long long wsi_ = (unsigned long long)args.ws; asm volatile("" : "+s"(wsi_)); GAS unsigned char* w_ = (GAS unsigned char*)wsi_; kin_t in_ = (kin_t)__builtin_amdgcn_kernarg_segment_ptr(); asm volatile("" : "+s"(in_)); \
    int tid_o_ = threadIdx.x; asm volatile("" : "+v"(tid_o_)); const int tid = tid_o_, lane = tid & 63; (void)tid; (void)lane; (void)in_;
#define WSP(T, off) ((T*)(GAS T*)(w_ + (off)))
#define INP(k) ((const float*)(const GAS float*)(unsigned long long)in_[k])
#define MODP(i, s, part) (WSP(float, WS_MOD) + (size_t)((((i) * 3 + (s)) * 6 + (part)) * 1024))

__global__ void __launch_bounds__(NWAVES * 64, 2) fwd_kernel(Args args) {
    extern __shared__ __attribute__((aligned(16))) unsigned char lds[];
    LAS unsigned char* const L = (LAS unsigned char*)lds;
    volatile LAS unsigned* const MISC = (volatile LAS unsigned*)(L + MISC_OFF);
    LAS int* const TAB = (LAS int*)(L + TAB_OFF);
    const int tid = threadIdx.x, lane = tid & 63, wave = __builtin_amdgcn_readfirstlane(tid >> 6);
    const int G = gridDim.x; const int bx = blockIdx.x; const int vcu = (G % 8 == 0) ? (bx % 8) * (G / 8) + bx / 8 : bx;
    const int gw = vcu * NWAVES + wave, NGW = G * NWAVES;

    for (int u = tid; u < (LDS_BYTES - LDSCTL_OFF) / 4; u += NWAVES * 64) ((LAS unsigned*)(L + LDSCTL_OFF))[u] = 0u;
    __syncthreads();
    XcdBarrier bar; bar.bar = (unsigned*)(args.ws + WS_CTL) + CW_BAR; bar.x = 0; bar.st = nullptr;
#if ONE_LAUNCH
    bar = xcd_barrier_post((unsigned*)(args.ws + WS_CTL) + CW_BAR, MISC + 8);
#define GRID_BAR() xcd_barrier(bar)
#else
#define GRID_BAR() do { } while (0)
#endif
    const int lo = args.ph_lo, hi = args.ph_hi;
#define IN(k) (lo <= (k) && (k) < hi)
#if PROBE
    int nstamp = 1; unsigned long long* const TSB = (unsigned long long*)(args.ws + WS_CTL) + 16384;
    if (bx == 0 && tid == 0) TSB[0] = __builtin_amdgcn_s_memrealtime();
#define SEAM(k) do { if (IN(k) && IN((k) + 1)) GRID_BAR(); if (bx == 0 && threadIdx.x == 0) TSB[nstamp] = __builtin_amdgcn_s_memrealtime(); ++nstamp; } while (0)
#else
#define SEAM(k) do { if (IN(k) && IN((k) + 1)) GRID_BAR(); } while (0)
#endif
#ifndef PHASE_MASK
#define PHASE_MASK 0xffffffffu
#endif
#ifndef PHASE_MASK0
#define PHASE_MASK0 7u
#endif
#define INL(t, bit) (((PHASE_MASK >> (bit)) & 1u) && IN(pb + (t)))
#define INL0(k) (((PHASE_MASK0 >> (k)) & 1u) && IN(k))
#ifndef REP_BIT
#define REP_BIT (-1)
#define REP_N 1
#endif
#define REP_ON(bit) (REP_BIT == (bit) || (REP_BIT == 99 && (bit) >= 16 && (bit) <= 20))
#ifndef REP_LY
#define REP_LY (-1)
#endif
#ifndef QKV_PROBE
#define QKV_PROBE 0
#endif
    int rep_ly_ = -1; (void)rep_ly_;
#define REP_HERE(bit) (REP_ON(bit) && (REP_LY < 0 || rep_ly_ == REP_LY))
#define REP_BEGIN(bit) for (int rep_ = 0; rep_ < (REP_HERE(bit) ? REP_N : 1); ++rep_) {
#define REP_END(bit) if (REP_HERE(bit) && rep_ + 1 < REP_N) GRID_BAR(); }

#if defined(P0_NOSTORE_ON_REP)
#define P0_NS (rep_ > 0)
#else
#define P0_NS false
#endif
    REP_BEGIN(30)
    if (INL0(0)) {
        PHASE_BASES
        LAS float* scr = (LAS float*)(L + RING_OFF + wave * 16384);
        {
            const float* W = INP(8); unsigned char* WT = WSP(unsigned char, WS_WQKV);
            for (int it = gw; it < 2 * 1536; it += NGW) { const int j = it / 1536, r = it % 1536, kb = r / 96, nb = r % 96;
                transpose_item_i8(W + (size_t)j * 1024 * 3072, 3072, WT + (size_t)j * 3072 * 1024 + (size_t)(nb * 32) * 1024, 1024, scr, kb * 64, nb * 32, lane, WQ); }
        }
        {
            for (int it = NGW - 1 - gw; it < 6 * 512; it += NGW) { const int mat = it / 512, r = it % 512, kb = r / 32, nb = r % 32;
                const float* W = (mat < 2 ? INP(11) : (mat < 4 ? INP(12) : INP(14))) + (size_t)(mat & 1) * 1024 * 1024;
                if (mat < 4) { unsigned char* WT8 = (unsigned char*)(GAS unsigned char*)(w_ + (mat < 2 ? WS_WO : WS_FNIN)) + (size_t)(mat & 1) * 1024 * 1024;
                    transpose_item_i8(W, 1024, WT8 + (size_t)(nb * 32) * 1024, 1024, scr, kb * 64, nb * 32, lane, WQ); }
                else { bf16* WT = (bf16*)(GAS bf16*)(w_ + WS_FNOUT) + (size_t)(mat & 1) * 1024 * 1024;
                    transpose_item(W, 1024, 1024, WT + (size_t)(nb * 32) * 1024, scr, kb * 64, nb * 32, lane); } }
        }
        {
            const float* wm = INP(4); const float* cv = INP(1); const float* cc = INP(3); float* MODPART = WSP(float, WS_MODP);
#define SILV(j) ((LAS float*)(L + RING_OFF + (j) * 16384 + 12288))
            for (int q_ = tid; q_ < 3072; q_ += NWAVES * 64) SILV(q_ >> 10)[q_ & 1023] = silu_f(q_ < 2048 ? cv[q_] : cc[q_ - 2048]);
            __syncthreads();
            for (int it = gw; it < 4 * 24 * MODK; it += NGW) { const int kc = it % MODK, rest = it / MODK, cb = rest % 24, i = rest / 24, n = cb * 256 + 4 * lane;
                f32x4 a0 = {0.f, 0.f, 0.f, 0.f}, a1 = a0, a2 = a0;
#pragma unroll 8
                for (int kk = 0; kk < 64; ++kk) { const int k = kc * 64 + kk; const f32x4 w = *(const f32x4*)(wm + ((size_t)i * 1024 + k) * 6144 + n);
                    const float s0 = SILV(0)[k], s1 = SILV(1)[k], s2 = SILV(2)[k]; a0 += w * s0; a1 += w * s1; a2 += w * s2; }
                float* o = MODPART + (size_t)((kc * 4 + i) * 3) * 6144 + n;
                *(f32x4*)(o) = a0; *(f32x4*)(o + 6144) = a1; *(f32x4*)(o + 2 * 6144) = a2; }
        }
        {
            float* ROPEC = WSP(float, WS_TAB + TB_ROPEC); float* ROPES = WSP(float, WS_TAB + TB_ROPES); float* TWC = WSP(float, WS_TAB + TB_TWC); float* TWS = WSP(float, WS_TAB + TB_TWS);
            bf16* DFTC = WSP(bf16, WS_TAB + TB_DFTC); bf16* DFT1 = WSP(bf16, WS_TAB + TB_DFT1); bf16* DFT2 = WSP(bf16, WS_TAB + TB_DFT2); bf16* DFT256 = WSP(bf16, WS_TAB + TB_DFT256);
            const int gt = gw * 64 + lane, NT_ = NGW * 64;
            for (int idx = gt; idx < 2048; idx += NT_) { const int pos = idx >> 4, f = idx & 15; const float inv = powf(10000.f, -(float)f / 16.f); const float ang = (float)pos * inv; ROPEC[idx] = cosf(ang); ROPES[idx] = sinf(ang); }
            for (int idx = gt; idx < 8192; idx += NT_) { const int kl = idx >> 6, nl = idx & 63; float s, c; sincospif(2.f * (float)(kl * nl) / 8192.f, &s, &c); TWC[idx] = c; TWS[idx] = s; }
            for (int idx = gt; idx < 256 * 128; idx += NT_) { const int row = idx >> 7, cc2 = idx & 127, reim = row >> 7, m = row & 127; float s, c; sincospif(2.f * (float)((m * cc2) & 127) / 128.f, &s, &c);
                DFTC[idx] = (bf16)f2bf((reim ? -s : c) * 0.08838834764831845f); }
            for (int idx = gt; idx < 256 * 256; idx += NT_) { const int row = idx >> 8, col = idx & 255, ro = row >> 7, kl = row & 127, ri = col >> 7, nh = col & 127; float s, c; sincospif(2.f * (float)((nh * kl) & 127) / 128.f, &s, &c);
                const float v = (ro == ri) ? c : (ro == 0 ? s : -s); DFT1[idx] = (bf16)f2bf(v * 0.08838834764831845f); }
            for (int idx = gt; idx < 256 * 128; idx += NT_) { const int row = idx >> 7, col = idx & 127, ri = col >> 6, nl = col & 63; float s, c; sincospif(2.f * (float)((nl * row) & 63) / 64.f, &s, &c);
                DFT2[idx] = (bf16)f2bf(row < 64 ? (ri ? s : c) * 0.125f : 0.f); }
            for (int idx = gt; idx < 256 * 512; idx += NT_) { const int row = idx >> 9, col = idx & 511, ri = col >> 8, j = col & 255; float s, c; sincospif(2.f * (float)((j * row) & 255) / 256.f, &s, &c);
                DFT256[idx] = (bf16)f2bf((ri ? s : c) * 0.0625f); }
        }
    }
    REP_END(30)
    SEAM(0);
    REP_BEGIN(31)
    if (INL0(1)) {
        PHASE_BASES
        const float* bm = INP(5); const float* MODPART = WSP(float, WS_MODP); float* MOD = WSP(float, WS_MOD);
        for (int idx = gw * 64 + lane; idx < 4 * 3 * 6144; idx += NGW * 64) { const int n = idx % 6144, is = idx / 6144, i = is / 3; float a = bm[i * 6144 + n];
#pragma unroll
            for (int kc = 0; kc < MODK; ++kc) a += MODPART[(size_t)kc * (4 * 3 * 6144) + idx];
            MOD[idx] = a; }
    }
    REP_END(31)
    SEAM(1);
    REP_BEGIN(32)
    if (INL0(2)) {
        PHASE_BASES
        const float* xin = INP(0); const float* cin = INP(2); unsigned short* X = WSP(unsigned short, WS_X); unsigned char* A1 = WSP(unsigned char, WS_A1); float* a1s = WSP(float, WS_A1S);
        float nv[16];
#define P2_SRC(rr) ((rr) < RL ? xin + (size_t)(rr) * 1024 : cin + (size_t)((rr) - RL) * 1024)
        if (gw < RT) ld_f32(P2_SRC(gw), lane, nv);
        for (int r = gw; r < RT; r += NGW) { const int s = r < RL ? (r >> 13) : 2;
            float v[16], sc[16], sh[16];
#pragma unroll
            for (int t = 0; t < 16; ++t) v[t] = nv[t];
            if (r + NGW < RT) ld_f32(P2_SRC(r + NGW), lane, nv);
            st_f16(X + (size_t)r * 1024, lane, v); ld_f32(MODP(0, s, 1), lane, sc); ld_f32(MODP(0, s, 0), lane, sh);
#pragma unroll
            for (int t = 0; t < 16; ++t) v[t] = v[t] * (1.f + sc[t]) + sh[t];
            st_i8_row(A1 + (size_t)r * 1024, a1s + r, lane, v); }
#undef P2_SRC
    }
    REP_END(32)
    SEAM(2);

#if defined(EXTRA_BARS)
    for (int eb = 0; eb < EXTRA_BARS; ++eb) GRID_BAR();
#endif
    for (int ly = 0; ly < DEPTH; ++ly) {
        const int pb = 3 + ly * 12;
        rep_ly_ = ly;
        const int jj = ly >> 1;
        const bool ctx_full = ly < 2;
        const int nrows = ctx_full ? RT : RL;
        const int nMt = (ly < 3) ? (RT / 256) : (RL / 256);
        if ((ly & 1) == 0) {
            REP_BEGIN(0)
            if (INL(0, 0)) {
                PHASE_BASES
                int kk_ = 512; asm volatile("" : "+s"(kk_));
                pg8::Gemm g{(const bf16*)WSP(unsigned char, WS_A1), (const bf16*)(WSP(unsigned char, WS_WQKV) + (size_t)jj * 3072 * 1024), nMt * 256, 3072, kk_}; pg8::StaticOrder S; S.init(nMt * 256, 3072, G, bx);
                pg8::EpiQKV E{WSP(bf16, WS_Q), (unsigned)((WS_K - WS_Q) / 2), WSP(float, WS_TAB + TB_ROPEC), WSP(float, WS_TAB + TB_ROPES), 0.125f * 1.4426950408889634f, WSP(float, WS_A1S), 1.f / WQ, (rep_ > 0) ? QKV_PROBE : 0};
                static_assert(WS_V - WS_K == WS_K - WS_Q, "Q | K | V equally spaced");
                pg8::gemm_phase<pg8::EpiQKV, pg8::StaticOrder, true, true, 1>(L + RING_OFF, g, S, E);
                const int remq = (nMt * 12) % G;
                if (remq != 0 && bx >= remq) { __syncthreads();
                    const int nwt = (G - remq) * NWAVES, tq = nwt * 2;
                    moe_conv_stream<false>(INP(19), WSP(unsigned char, WS_WD), ly * 32 * 256, ly * 32 * 256 + tq, (bx - remq) * NWAVES + wave, nwt, (LAS unsigned char*)(L + RING_OFF + wave * 16384), lane, WQD); }
            }
            REP_END(0)
            SEAM(pb + 0);
            REP_BEGIN(1)
            if (INL(1, 1)) {
                PHASE_BASES
                const int NU = 1024 + (ly == 0 ? 32 : 0);
                const int remq_ = (nMt * 12) % G, tq_ = remq_ ? (G - remq_) * NWAVES * 2 : 0;
                const int NGRP = (G % 32 == 0) ? 4 : 1, grp = (NGRP == 4) ? ((vcu & 31) >> 3) : 0;
#ifndef CONV_REP
#define CONV_REP 1
#endif
#define ATTN_CONV() do { PHASE_BASES const int cpg = G / NGRP, wig = ((NGRP == 4) ? ((vcu >> 5) * 8 + (vcu & 7)) : vcu) * NWAVES + wave, nwv = cpg * NWAVES; \
                         for (int cr_ = 0; cr_ < CONV_REP; ++cr_) moe_conv_range(INP(17), WSP(unsigned char, WS_WGU), INP(19), WSP(unsigned char, WS_WD), ly * 32 * 512 + grp * (64 * 512 / NGRP), ly * 32 * 512 + (grp + 1) * (64 * 512 / NGRP), \
                                       ly * 32 * 256 + tq_ + (64 * 256 - tq_) * grp / NGRP, ly * 32 * 256 + tq_ + (64 * 256 - tq_) * (grp + 1) / NGRP, wig, nwv, (LAS float*)(L + RING_OFF + wave * 16384), lane); __syncthreads(); } while (0)
                const float* lamp = INP(9) + jj * 256; const float* sg = INP(10) + jj * 128;
                const float linit = 0.8f - 0.6f * expf(-0.3f * (float)ly);
                const float d1 = wave_sum(lamp[lane] * lamp[64 + lane], lane), d2 = wave_sum(lamp[128 + lane] * lamp[192 + lane], lane);
                const float lam = __builtin_bit_cast(float, __builtin_amdgcn_readfirstlane(__builtin_bit_cast(int, expf(d1) - expf(d2) + linit)));
                float mg_ = fmaxf(fabsf(sg[lane]), fabsf(sg[64 + lane])) * fabsf(1.f - linit);
                mg_ = fmaxf(wave_max(mg_, lane), 1e-20f);
                const float mixq = __builtin_bit_cast(float, __builtin_amdgcn_readfirstlane(__builtin_bit_cast(int, 127.f / (MIXCLIP * mg_))));
                int un_ = 0, P_ = vcu, c_ = 0; bool failed_ = false, convd_ = false;
#define ATTN_LOOP(FASTF) \
                for (;; P_ += G, c_ = 0) { const bool havep = P_ < 512; \
                    const int qb = P_ & 31, xg = (P_ >> 5) & 7, it2 = P_ >> 8, grp2 = xg * 2 + it2, b = grp2 >> 3, h = grp2 & 7; \
                    _Pragma("unroll 1") for (; c_ < 2; ++c_, ++un_) { \
                        if (un_ == grp && rep_ == 0 && !convd_) { ATTN_CONV(); convd_ = true; } \
                        if (!havep) break; \
                        const long qrow0 = (long)b * SEQ + qb * 256, krow0 = (long)b * KVB; const int hq = 2 * h + c_; \
                        if (hattn::attn_unit<8, FASTF>(qrow0, krow0, KVB / 64, hq, h * 128, WSP(const hattn::bf16, WS_Q), WSP(const hattn::bf16, WS_K), WSP(const hattn::bf16, WS_V), \
                                            WSP(hattn::bf16, WS_O0), (char*)lds + RING_OFF, c_, lam, sg, (1.f - linit) * mixq, WSP(unsigned char, WS_MIX8))) { failed_ = true; break; } \
                    } \
                    if (failed_ || !havep) break; }
                ATTN_LOOP(true)
                if (failed_) { failed_ = false; ATTN_LOOP(false) }
#undef ATTN_LOOP
                if (ly == 0 && vcu < 16) {
                    const int b = vcu >> 3, h = vcu & 7; const long qrow0 = RL + (long)b * CTXL, krow0 = (long)b * KVB + SEQ;
#pragma unroll 1
                    for (int c = 0; c < 2; ++c)
                        hattn::attn_unit<8>(qrow0, krow0, CTXL / 64, 2 * h + c, h * 128, WSP(const hattn::bf16, WS_Q), WSP(const hattn::bf16, WS_K), WSP(const hattn::bf16, WS_V),
                                            WSP(hattn::bf16, WS_O0), (char*)lds + RING_OFF, c, lam, sg, (1.f - linit) * mixq, WSP(unsigned char, WS_MIX8));
                }
                if (grp > un_ && rep_ == 0 && !convd_) ATTN_CONV();
#undef ATTN_CONV
            }
            REP_END(1)
#if DBG_ATTN
            if (ly == 0) {
                GRID_BAR();
                { PHASE_BASES
                  const int NU = 1024 + 32;
                  for (int U = vcu; U < NU; U += G) {
                    long qrow0, krow0; int seq, hq;
                    if (U < 1024) { const int qb = U & 31, xg = (U >> 5) & 7, it = U >> 8, grp = xg * 4 + it, b = grp >> 4; hq = grp & 15; qrow0 = (long)b * SEQ + qb * 256; krow0 = (long)b * KVB; seq = KVB; }
                    else { const int w = U - 1024, b = w >> 4; hq = w & 15; qrow0 = RL + (long)b * CTXL; krow0 = (long)b * KVB + SEQ; seq = CTXL; }
                    const int h = hq >> 1, c = hq & 1;
                    hattn::attn_unit<8>(qrow0, krow0, seq / 64, hq, h * 128, WSP(const hattn::bf16, WS_Q), WSP(const hattn::bf16, WS_K), WSP(const hattn::bf16, WS_V),
                                        (hattn::bf16*)(GAS hattn::bf16*)(w_ + (c ? WS_U2 : WS_U)), (char*)lds + RING_OFF);
                  } }
                GRID_BAR();
                { PHASE_BASES
                  unsigned worst = 0;
                  for (int r = gw; r < RT; r += NGW) {
#pragma unroll
                    for (int c = 0; c < 2; ++c) { float a[16], b[16]; ld_bf16(WSP(bf16, c ? WS_O1 : WS_O0) + (size_t)r * 1024, lane, a); ld_bf16(WSP(bf16, c ? WS_U2 : WS_U) + (size_t)r * 1024, lane, b);
                      float e = 0.f; bool bad = false;
#pragma unroll
                      for (int t = 0; t < 16; ++t) { const float d = fabsf(a[t] - b[t]) / (fmaxf(fabsf(a[t]), fabsf(b[t])) + 0.01f); if (!(d == d)) bad = true; e = fmaxf(e, d); }
                      unsigned code = bad ? 7u : (e < 0.02f ? 0u : (e < 0.05f ? 2u : (e < 0.1f ? 3u : (e < 0.3f ? 4u : (e < 1.f ? 5u : 6u)))));
                      if (code) code += 10u * c + (r >= RL ? 20u : 0u);
                      worst = code > worst ? code : worst; } }
                  if (worst) atomicMax((unsigned*)(WSP(unsigned, WS_CTL) + CW_DBG), worst);
                }
                GRID_BAR();
            }
#endif
            SEAM(pb + 1);
        } else {
            REP_BEGIN(16)
            if (INL(0, 16)) {
                PHASE_BASES
                int kk_ = 512; asm volatile("" : "+s"(kk_));
                pg8::Gemm g{(const bf16*)WSP(unsigned char, WS_A1), (const bf16*)(WSP(unsigned char, WS_FNIN) + (size_t)jj * 1024 * 1024), nrows, 1024, kk_}; pg8::StaticOrder S; S.init(nrows, 1024, G, bx);
                pg8::EpiPF1 E{WSP(bf16, WS_U2), WSP(float, WS_A1S), 1.f / WQ, INP(13) + jj * 1024, (LAS float*)(TAB + 1536), RMS_EPS, RL};
                pg8::gemm_phase<pg8::EpiPF1, pg8::StaticOrder, true, true, 1>(L + RING_OFF, g, S, E);
            }
            REP_END(16)
            SEAM(pb + 0);
            REP_BEGIN(18)
            if (INL(2, 18)) {
                PHASE_BASES
                int kk_ = 128; asm volatile("" : "+s"(kk_)); pg8::Gemm g{WSP(bf16, WS_TAB + TB_DFTC), WSP(bf16, WS_U2), 256, 0, kk_}; pg8::LinearOrder S{ctx_full ? 528 : 512, G, vcu};
                pg8::EpiZ1 E{WSP(bf16, WS_Z1), WSP(bf16, WS_ZC)};
                pg8::gemm_phase<pg8::EpiZ1, pg8::LinearOrder, true, true>(L + RING_OFF, g, S, E);
            }
            REP_END(18)
            SEAM(pb + 2);
            REP_BEGIN(19)
            if (INL(3, 19)) {
                PHASE_BASES
                int kk_ = 256; asm volatile("" : "+s"(kk_)); pg8::Gemm g{WSP(bf16, WS_TAB + TB_DFT1), WSP(bf16, WS_Z1), 256, 0, kk_}; pg8::LinearOrder S{512, G, vcu};
                pg8::EpiFFT1 E{WSP(bf16, WS_T), WSP(float, WS_TAB + TB_TWC), WSP(float, WS_TAB + TB_TWS)};
                pg8::gemm_phase<pg8::EpiFFT1, pg8::LinearOrder, true, true>(L + RING_OFF, g, S, E);
            }
            REP_END(19)
            SEAM(pb + 3);
            REP_BEGIN(20)
            if (INL(4, 20)) {
                { PHASE_BASES
                  int kk_ = 128; asm volatile("" : "+s"(kk_)); pg8::Gemm g{WSP(bf16, WS_TAB + TB_DFT2), WSP(bf16, WS_T), 256, 0, kk_}; pg8::LinearOrder S{1024, G, vcu};
                  pg8::EpiFFT2 E{WSP(bf16, WS_MIX)};
                  pg8::gemm_phase<pg8::EpiFFT2, pg8::LinearOrder, true, true>(L + RING_OFF, g, S, E); }
                if (ctx_full) { __syncthreads();
                  PHASE_BASES
                  int kk_ = 512; asm volatile("" : "+s"(kk_)); pg8::Gemm g{WSP(bf16, WS_TAB + TB_DFT256), WSP(bf16, WS_ZC), 256, 0, kk_}; pg8::LinearOrder S{8, G, vcu};
                  pg8::EpiDFT256 E{WSP(bf16, WS_MIX)};
                  pg8::gemm_phase<pg8::EpiDFT256, pg8::LinearOrder, true, true>(L + RING_OFF, g, S, E); }
            }
            REP_END(20)
            SEAM(pb + 4);
        }
        REP_BEGIN(5)
        if (INL(5, 5)) {
            PHASE_BASES
            pg8::StaticOrder S; S.init(nrows, 1024, G, bx);
            if (ly & 1) {
                const bf16* Wt = (const bf16*)(const GAS bf16*)(w_ + WS_FNOUT) + (size_t)jj * 1024 * 1024;
                pg8::Gemm g{WSP(bf16, WS_MIX), Wt, nrows, 1024, 1024};
                pg8::EpiBf16<0> E{WSP(bf16, WS_Y), 1024, nullptr, 0, 0, 1.f};
                pg8::gemm_phase<pg8::EpiBf16<0>, pg8::StaticOrder, true, true>(L + RING_OFF, g, S, E);
            } else {
                const float* sg = INP(10) + jj * 128; const float linit = 0.8f - 0.6f * expf(-0.3f * (float)ly);
                float mg_ = fmaxf(fabsf(sg[lane]), fabsf(sg[64 + lane])) * fabsf(1.f - linit);
                mg_ = fmaxf(wave_max(mg_, lane), 1e-20f);
                const float deq = __builtin_bit_cast(float, __builtin_amdgcn_readfirstlane(__builtin_bit_cast(int, (MIXCLIP * mg_) * (1.f / 127.f))));
                int kk_ = 512; asm volatile("" : "+s"(kk_));
                pg8::Gemm g{(const bf16*)WSP(unsigned char, WS_MIX8), (const bf16*)(WSP(unsigned char, WS_WO) + (size_t)jj * 1024 * 1024), nrows, 1024, kk_};
                pg8::EpiI8Bf16 E{WSP(bf16, WS_Y), nullptr, 1.f / WQ, deq};
                pg8::gemm_phase<pg8::EpiI8Bf16, pg8::StaticOrder, true, true, 1>(L + RING_OFF, g, S, E);
            }
        }
        REP_END(5)
        SEAM(pb + 5);
        REP_BEGIN(6)
        if (INL(6, 6)) {
            PHASE_BASES
            constexpr int HP = 1028;
            LAS float* H = (LAS float*)(L + RING_OFF); LAS float* PART = H + 16 * HP;
            if (tid < 32 && rep_ == 0) TAB[tid] = 0;
            float wb0[32], wb1[32];
            { const float* wr = INP(15) + (size_t)ly * 32768 + (size_t)(128 * wave + 32 * (lane >> 4)) * 32 + (lane & 15);
#pragma unroll
              for (int s_ = 0; s_ < 32; ++s_) { wb0[s_] = wr[s_ * 32]; wb1[s_] = wr[s_ * 32 + 16]; } }
            __syncthreads();
            const unsigned short* X = WSP(unsigned short, WS_X); unsigned short* X2 = WSP(unsigned short, WS_X2); const bf16* Y = WSP(bf16, WS_Y); unsigned char* A2 = WSP(unsigned char, WS_A2); float* asr = WSP(float, WS_ASCR);
            const float* brt = INP(16) + ly * 32; const float* lng = INP(6) + (size_t)(ly * 2) * 1024; const float* lnb = INP(7) + (size_t)(ly * 2) * 1024;
            const int nit = (nrows - vcu * NWAVES + NGW - 1) / NGW;
            LAS float* const MV = PART + 8 * 16 * 32;
            LAS int* const REC = (LAS int*)(MV + 5 * 1024);
            for (int q_ = tid; q_ < 512; q_ += NWAVES * 64) { const int vec = q_ >> 8, off = (q_ & 255) * 4; *(LAS f32x4*)(MV + 3072 + vec * 1024 + off) = *(const f32x4*)((vec ? lnb : lng) + off); }
            int cur_s = -1;
#pragma unroll 1
            for (int i0 = 0; i0 < nit; i0 += 2) {
                { const int r0 = vcu * NWAVES + i0 * NGW, s_ = r0 < RL ? (r0 >> 13) : 2;
                  if (s_ != cur_s) { const float* src = MODP(ly, s_, 2);
                      for (int q_ = tid; q_ < 768; q_ += NWAVES * 64) *(LAS f32x4*)(MV + q_ * 4) = *(const f32x4*)(src + q_ * 4);
                      cur_s = s_; __syncthreads(); } }
#pragma unroll 1
                for (int q = 0; q < 2; ++q) { const int r = gw + (i0 + q) * NGW;
                    if (r < nrows) {
                        float v[16];
                        { v4u xw[2], yw[2];
#pragma unroll
                          for (int j_ = 0; j_ < 2; ++j_) { xw[j_] = *(const v4u*)(X + (size_t)r * 1024 + 512 * j_ + 8 * lane); yw[j_] = *(const v4u*)(Y + (size_t)r * 1024 + 512 * j_ + 8 * lane); }
                          pm1_comb(lane, xw, yw, (const LAS float*)MV, v); }
                        const float rsc_ = pm1_pre2(r, lane, (const LAS float*)(MV + 2048), (const LAS float*)(MV + 1024), (const LAS float*)(MV + 3072), (const LAS float*)(MV + 4096), X2, A2, asr, v);
                        if (lane == 0) REC[((i0 + q) * NWAVES + wave) * 16 + 12] = __builtin_bit_cast(int, rsc_);
                        LAS float* hr = H + (2 * wave + q) * HP + 8 * lane;
#pragma unroll
                        for (int j_ = 0; j_ < 2; ++j_) { *(LAS f32x4*)(hr + 512 * j_) = (f32x4){v[8 * j_], v[8 * j_ + 1], v[8 * j_ + 2], v[8 * j_ + 3]}; *(LAS f32x4*)(hr + 512 * j_ + 4) = (f32x4){v[8 * j_ + 4], v[8 * j_ + 5], v[8 * j_ + 6], v[8 * j_ + 7]}; }
                    }
                    asm volatile("" ::: "memory"); }
                __syncthreads();
                {
                    f32x4 c0 = {0.f, 0.f, 0.f, 0.f}, c1 = c0;
                    const LAS float* ha = H + (lane & 15) * HP + 128 * wave + 32 * (lane >> 4);
#pragma unroll
                    for (int s8 = 0; s8 < 8; ++s8) { const f32x4 a4 = *(const LAS f32x4*)(ha + 4 * s8);
#pragma unroll
                        for (int t = 0; t < 4; ++t) { c0 = __builtin_amdgcn_mfma_f32_16x16x4f32(a4[t], wb0[4 * s8 + t], c0, 0, 0, 0); c1 = __builtin_amdgcn_mfma_f32_16x16x4f32(a4[t], wb1[4 * s8 + t], c1, 0, 0, 0); } }
                    LAS float* pw = PART + (wave * 16 + 4 * (lane >> 4)) * 32 + (lane & 15);
#pragma unroll
                    for (int t = 0; t < 4; ++t) { pw[t * 32] = c0[t]; pw[t * 32 + 16] = c1[t]; }
                }
                __syncthreads();
#pragma unroll 1
                for (int q = 0; q < 2; ++q) { const int r = gw + (i0 + q) * NGW;
                    float lg = brt[lane & 31];
#pragma unroll
                    for (int w_ = 0; w_ < 8; ++w_) lg += PART[(w_ * 16 + 2 * wave + q) * 32 + (lane & 31)];
                    pm1_top4(r < nrows, rep_ == 0, lane, lg, TAB, REC + ((i0 + q) * NWAVES + wave) * 16); }
            }
            __syncthreads();
            if (tid < 32 && rep_ == 0) { int* counts = WSP(int, WS_CTL) + CW_CNT; const int h = TAB[tid]; const int base = h ? __hip_atomic_fetch_add(counts + ly * 32 + tid, h, __ATOMIC_RELAXED, __HIP_MEMORY_SCOPE_AGENT) : 0; TAB[32 + tid] = tid * CAPE + base; }
            __syncthreads();
            if (rep_ == 0) { float* const gate = WSP(float, WS_GATE); int* const dest = WSP(int, WS_DEST); float* const ascd = WSP(float, WS_ASCD); int* const tokr = WSP(int, WS_TOKR);
                for (int i_ = 0; i_ < nit; ++i_) { const int r = gw + i_ * NGW;
                    if (r < nrows && lane < 4) { const LAS int* rec = REC + (i_ * NWAVES + wave) * 16; const int e = rec[lane], d = TAB[32 + e] + rec[4 + lane];
                        gate[d] = __builtin_bit_cast(float, rec[8 + lane]); ascd[d] = __builtin_bit_cast(float, rec[12]); dest[r * 4 + lane] = d; tokr[d] = r; } } }
        }
        __syncthreads();
        REP_END(6)
        SEAM(pb + 6);
        if (INL(8, 8) || INL(9, 9)) {
            PHASE_BASES
            const int* counts = WSP(int, WS_CTL) + CW_CNT;
            __syncthreads();
            if (tid < CAPB + 8) { int acc = 0, ef = 31, jf = 0; for (int e = 0; e < 32; ++e) { const int nb = (counts[ly * 32 + e] + 255) >> 8; if (tid >= acc && tid < acc + nb) { ef = e; jf = tid - acc; } acc += nb; }
                TAB[128 + tid] = ef | ((ef * CAPE_B + jf) << 8); if (tid == 0) TAB[64] = acc; }
            __syncthreads();
        }
        REP_BEGIN(8)
        if (INL(8, 8)) {
            PHASE_BASES
            const int NB = TAB[64];
            int kk_ = 512; asm volatile("" : "+s"(kk_));
            pg8::Gemm g{(const bf16*)WSP(unsigned char, WS_A2), (const bf16*)(WSP(unsigned char, WS_WGU) + (size_t)ly * 32 * 2048 * 1024), 0, 0, kk_, WSP(int, WS_TOKR), TAB + 1024, (unsigned)(RT - 1)}; pg8::MoeOrder S{(const LAS int*)(TAB + 128), NB, 8, G, vcu};
            #if defined(MOE1_NOSTORE_ON_REP)
            const int ns_ = rep_ > 0 ? 2 : 0;
#else
            const int ns_ = 0;
#endif
            pg8::EpiSwiGLU E{WSP(unsigned char, WS_ACT), INP(18) + (size_t)ly * 32 * 2048, WSP(float, WS_ASCD), 1.f / WQ, ACTQ, ns_};
            pg8::gemm_phase<pg8::EpiSwiGLU, pg8::MoeOrder, true, true, 1, true>(L + RING_OFF, g, S, E);
        }
        REP_END(8)
        SEAM(pb + 8);
        REP_BEGIN(9)
        if (INL(9, 9)) {
            PHASE_BASES
            const int NB = TAB[64];
            int kk_ = 512; asm volatile("" : "+s"(kk_));
            pg8::Gemm g{(const bf16*)WSP(unsigned char, WS_ACT), (const bf16*)(WSP(unsigned char, WS_WD) + (size_t)ly * 32 * 1024 * 1024), 0, 0, kk_}; pg8::MoeOrder S{(const LAS int*)(TAB + 128), NB, 4, G, vcu};
            #if defined(MOE2_NOEPI_ON_REP)
            const int ns2_ = rep_ > 0 ? MOE2_NOEPI_ON_REP : 0;
#else
            const int ns2_ = 0;
#endif
            pg8::EpiMoE2 E{WSP(unsigned char, WS_OUTM), INP(20) + (size_t)ly * 32 * 1024, WSP(float, WS_GATE), 1.f / (ACTQ * WQD), OSC, ns2_};
            pg8::gemm_phase<pg8::EpiMoE2, pg8::MoeOrder, true, true, 1>(L + RING_OFF, g, S, E);
        }
        REP_END(9)
        SEAM(pb + 9);
        REP_BEGIN(10)
        if (INL(10, 10)) {
            PHASE_BASES
            const int* dest = WSP(int, WS_DEST); const unsigned char* OM = WSP(unsigned char, WS_OUTM); unsigned short* X = WSP(unsigned short, WS_X); const unsigned short* X2 = WSP(unsigned short, WS_X2); unsigned char* A1 = WSP(unsigned char, WS_A1); float* a1s = WSP(float, WS_A1S);
            const float* lng = INP(6) + (size_t)(ly * 2 + 1) * 1024; const float* lnb = INP(7) + (size_t)(ly * 2 + 1) * 1024;
            LAS float* const MV5 = (LAS float*)(L + RING_OFF);
            for (int q_ = tid; q_ < 11 * 256; q_ += NWAVES * 64) { const int vec = q_ >> 8, off = (q_ & 255) * 4; const float* src;
                if (vec < 9) { const int s_ = vec / 3, k_ = vec % 3; src = (k_ == 0 || ly + 1 >= DEPTH) ? MODP(ly, s_, 5) : MODP(ly + 1, s_, k_ == 1 ? 0 : 1); } else src = (vec == 9) ? lng : lnb;
                *(LAS f32x4*)(MV5 + vec * 1024 + off) = *(const f32x4*)(src + off); }
            __syncthreads();
            int nd0 = 0, nd1 = 0, nd2 = 0, nd3 = 0;
            if (gw < nrows) { nd0 = dest[gw * 4 + 0]; nd1 = dest[gw * 4 + 1]; nd2 = dest[gw * 4 + 2]; nd3 = dest[gw * 4 + 3]; }
            for (int r = gw; r < nrows; r += NGW) { const int s = r < RL ? (r >> 13) : 2;
                float v[16], acc[16];
                { const int d0 = nd0, d1 = nd1, d2 = nd2, d3 = nd3;
                  if (r + NGW < nrows) { nd0 = dest[(r + NGW) * 4 + 0]; nd1 = dest[(r + NGW) * 4 + 1]; nd2 = dest[(r + NGW) * 4 + 2]; nd3 = dest[(r + NGW) * 4 + 3]; }
                  typedef unsigned u32x2_t __attribute__((ext_vector_type(2)));
#pragma unroll
                  for (int j = 0; j < 2; ++j) {
                      const u32x2_t w0 = *(const u32x2_t*)(OM + (size_t)d0 * 1024 + 512 * j + 8 * lane), w1 = *(const u32x2_t*)(OM + (size_t)d1 * 1024 + 512 * j + 8 * lane);
                      const u32x2_t w2 = *(const u32x2_t*)(OM + (size_t)d2 * 1024 + 512 * j + 8 * lane), w3 = *(const u32x2_t*)(OM + (size_t)d3 * 1024 + 512 * j + 8 * lane);
#define F8(w, b) __builtin_amdgcn_cvt_f32_fp8((int)(w), (b))
#define SUM4(c, b) ((((F8(w0.c, b) + F8(w1.c, b)) + F8(w2.c, b)) + F8(w3.c, b)) * (1.f / OSC))
                      acc[8 * j + 0] = SUM4(x, 0); acc[8 * j + 1] = SUM4(x, 1); acc[8 * j + 2] = SUM4(x, 2); acc[8 * j + 3] = SUM4(x, 3);
                      acc[8 * j + 4] = SUM4(y, 0); acc[8 * j + 5] = SUM4(y, 1); acc[8 * j + 6] = SUM4(y, 2); acc[8 * j + 7] = SUM4(y, 3);
#undef SUM4
#undef F8
                  } }
                { float g2[16]; ld_f16(X2 + (size_t)r * 1024, lane, v); ld_f32((const LAS float*)(MV5 + (3 * s) * 1024), lane, g2);
#pragma unroll
                  for (int t = 0; t < 16; ++t) v[t] = DN_ALPHA * v[t] + g2[t] * acc[t]; }
                ln_row(v, (const LAS float*)(MV5 + 9 * 1024), (const LAS float*)(MV5 + 10 * 1024), lane);
                if (ly == DEPTH - 1) { st_f32((float*)(GAS float*)(unsigned long long)args.out + (size_t)r * 1024, lane, v); }
                else { st_f16(X + (size_t)r * 1024, lane, v);
                    if (r < RL || ly < 2) { float sc[16], sh[16]; ld_f32((const LAS float*)(MV5 + (3 * s + 2) * 1024), lane, sc); ld_f32((const LAS float*)(MV5 + (3 * s + 1) * 1024), lane, sh);
#pragma unroll
                        for (int t = 0; t < 16; ++t) v[t] = v[t] * (1.f + sc[t]) + sh[t];
                        st_i8_row(A1 + (size_t)r * 1024, a1s + r, lane, v); } }
            }
        }
        REP_END(10)
        SEAM(pb + 10);
    }
#if PROBE
    {
        GRID_BAR();
        const unsigned long long* T = (const unsigned long long*)(args.ws + WS_CTL) + 16384;
        const float t1 = (float)(__hip_atomic_load(T + PROBE_A1, RLX_AGENT) - __hip_atomic_load(T + PROBE_A0, RLX_AGENT)) * 0.01f, t2 = (float)(__hip_atomic_load(T + PROBE_B1, RLX_AGENT) - __hip_atomic_load(T + PROBE_B0, RLX_AGENT)) * 0.01f;
        const float cv = sqrtf(t1); float* o = (float*)(GAS float*)(unsigned long long)args.out;
        for (size_t idx = (size_t)gw * 64 + (tid & 63); idx < (size_t)RL * 1024; idx += (size_t)NGW * 64) o[idx] = idx == 0 ? 10.f * t2 : cv;
    }
#endif
#if DEBUG_CODES
    {
        gu32* ctl = (gu32*)(args.ws + WS_CTL);
        unsigned code = __hip_atomic_load(ctl + CW_DBG, RLX_AGENT); if (__hip_atomic_load(ctl + CW_BAR + XB_TMO, RLX_AGENT)) code = 90;
        if (code && IN(3 + (DEPTH - 1) * 12 + 10)) { __syncthreads(); const float cv = sqrtf((float)code); for (size_t idx = (size_t)gw * 64 + lane; idx < (size_t)RL * 1024; idx += (size_t)NGW * 64) args.out[idx] = cv; }
    }
#endif
#undef IN
#undef SEAM
}

constexpr int N_PHASES = 3 + DEPTH * 12 - 1;
extern "C" void kernel_launch(void* const* d_in, const int* in_sizes, int n_in, void* d_out, int out_size, void* d_ws, size_t ws_size, hipStream_t stream) {
    static int grid = 0;
    if (grid == 0) {
        if (n_in != 21 || out_size != RL * DM || ws_size < WS_END) { fprintf(stderr, "kernel_launch: unexpected problem (n_in %d, out %d, ws %zu)\n", n_in, out_size, ws_size); grid = -1; return; }
        int dev = 0, cus = 0, per_cu = 0;
        if (hipGetDevice(&dev) != hipSuccess || hipDeviceGetAttribute(&cus, hipDeviceAttributeMultiprocessorCount, dev) != hipSuccess) { grid = -1; return; }
        if (hipFuncSetAttribute((const void*)fwd_kernel, hipFuncAttributeMaxDynamicSharedMemorySize, LDS_BYTES) != hipSuccess) { fprintf(stderr, "kernel_launch: hipFuncSetAttribute failed\n"); grid = -1; return; }
        if (hipOccupancyMaxActiveBlocksPerMultiprocessor(&per_cu, (const void*)fwd_kernel, NWAVES * 64, LDS_BYTES) != hipSuccess || per_cu < 1) { fprintf(stderr, "kernel_launch: occupancy query reports %d workgroups per CU\n", per_cu); }
        (void)hipGetLastError();
        grid = cus;
    }
    if (grid < 0) return;
    (void)hipMemsetAsync((char*)d_ws + WS_CTL, 0, CTL_ZERO_BYTES, stream);
    Args a{};
    for (int i = 0; i < 21; ++i) a.in[i] = (const float*)d_in[i];
    a.out = (float*)d_out; a.ws = (unsigned char*)d_ws;
#if ONE_LAUNCH
    a.ph_lo = 0; a.ph_hi = N_PHASES;
    hipLaunchKernelGGL(fwd_kernel, dim3(grid), dim3(NWAVES * 64), LDS_BYTES, stream, a);
#else
    for (int p = 0; p < N_PHASES; ++p) {
        const int q = (p - 3) % 12, ly = (p - 3) / 12;
        if (p >= 3) { if (q == 11) continue; if ((ly & 1) == 0 && (q == 3 || q == 4)) continue; }
        a.ph_lo = p; a.ph_hi = p + 1;
        hipLaunchKernelGGL(fwd_kernel, dim3(grid), dim3(NWAVES * 64), LDS_BYTES, stream, a);
    }
#endif
}
```

```cpp
#include <hip/hip_runtime.h>
#include <cstdio>
#include <cstdint>

namespace pg8 {
#define PG8_LAS __attribute__((address_space(3)))
typedef unsigned short bf16_t;
typedef short bf16x8 __attribute__((ext_vector_type(8)));
typedef float f32x4 __attribute__((ext_vector_type(4)));
typedef unsigned u32x4 __attribute__((ext_vector_type(4)));
typedef int i32x4_t __attribute__((ext_vector_type(4)));
template <int MODE> struct AccSel { typedef f32x4 type; };
template <> struct AccSel<1> { typedef i32x4_t type; };
constexpr int BM = 256, BK = 64, HALF = 128, HTB = HALF * BK * 2  , STAGE_BYTES = 8 * HTB, NXCD = 8, WGM = 8;

__host__ __device__ __forceinline__ int lds_byte(int r, int c) { const int st = (r >> 4) * 2 + (c >> 5), rr = r & 15, cc = c & 31, ob = rr * 64 + cc * 2; return st * 1024 + (ob ^ (((ob >> 9) & 1) << 5)); }
__host__ __device__ __forceinline__ void stage_rc(int b, int& R, int& C) { const int st = b / 1024, sb = b % 1024, swz = sb ^ (((sb >> 9) & 1) << 5); R = (st >> 1) * 16 + swz / 64; C = (st & 1) * 32 + (swz % 64) / 2; }
__host__ __device__ __forceinline__ int perm32(int rho) { const int n = rho >> 4, i = rho & 15; return 8 * (i >> 2) + 4 * n + (i & 3); }

struct Unit { int pm, pn; int aux = 0; };
template <class E> struct EpiStg { static constexpr int N = 0; };
struct Gemm { const bf16_t* A; const bf16_t* Bt; int M, N, K; const int* rowidx = nullptr; PG8_LAS int* idx = nullptr; unsigned idx_max = 0xffffffffu; };

struct StaticOrder {
    int nM, nN, nwg, G, c;
    __host__ __device__ void init(int M, int N, int G_, int c_) { nM = M / BM; nN = N / BM; nwg = nM * nN; G = G_; c = c_; }
    __host__ __device__ bool next(int i, Unit& u) const {
        const long L = (long)i * G + c; if (L >= nwg) return false;
        int wgid = (int)L; { const int q = nwg / NXCD, r = nwg % NXCD, xcd = wgid % NXCD, off = wgid / NXCD; wgid = (xcd < r ? xcd * (q + 1) : r * (q + 1) + (xcd - r) * q) + off; }
        const int nig = WGM * nN, gid = wgid / nig, fm = gid * WGM, gsz = (nM - fm) < WGM ? (nM - fm) : WGM;
        u.pm = fm + ((wgid % nig) % gsz); u.pn = (wgid % nig) / gsz; return true;
    }
    __device__ __forceinline__ void a_ready(const Unit&) const {}
    __device__ __forceinline__ void done(const Unit&) const {}
};

__device__ __forceinline__ unsigned cvt_pk_bf16(float lo, float hi) { unsigned r; asm volatile("v_cvt_pk_bf16_f32 %0, %1, %2" : "=v"(r) : "v"(lo), "v"(hi)); return r; }
typedef float f32x2 __attribute__((ext_vector_type(2)));
__device__ __forceinline__ f32x2 gelu_pk(f32x2 v) {
    const f32x2 av = __builtin_elementwise_abs(v), d = av * 0.2316418882f + 1.0f;
    f32x2 t; t.x = __builtin_amdgcn_rcpf(d.x); t.y = __builtin_amdgcn_rcpf(d.y);
    f32x2 q = t * 0.5307027145f + (-0.7265760135f); q = q * t + 0.7107068705f; q = q * t + (-0.142248368f); q = q * t + 0.127414796f; q = q * t;
    const f32x2 s = (v * v) * (-0.72134752044f);
    f32x2 e; e.x = __builtin_amdgcn_exp2f(s.x); e.y = __builtin_amdgcn_exp2f(s.y);
    const f32x2 m = v * (q * e), r = v - m;
    f32x2 o; o.x = v.x < 0.f ? m.x : r.x; o.y = v.y < 0.f ? m.y : r.y; return o;
}

template <int ACT  > struct EpiBf16 {
    static constexpr bool PERM = true, AFTER_DRAIN = false; static_assert(ACT == 0 || ACT == 1, "EpiBf16: ACT is 0 (none) or 1 (gelu_pk)");
    bf16_t* O; int ldc; const float* bias; int split_cols; size_t split_stride; float scale0;
    __device__ __forceinline__ void operator()(const f32x4 (&acc)[2][2][4][2], const Unit& u, int wr, int wc, int fr, int fq) const {
        const int row0 = u.pm * BM + wr * 64 + fr; int colt = u.pn * BM; bf16_t* base = O;
        float sc = 1.f; if (split_cols) { const int t = colt / split_cols; base += (size_t)t * split_stride; colt -= t * split_cols; if (t == 0) sc = scale0; }
        const int col0 = colt + wc * 32 + 8 * fq, bcol0 = u.pn * BM + wc * 32 + 8 * fq;
        f32x4 bv[2][2];
#pragma unroll
        for (int bj = 0; bj < 2; ++bj)
#pragma unroll
            for (int n = 0; n < 2; ++n) bv[bj][n] = bias ? *(const f32x4*)(bias + bcol0 + bj * HALF + 4 * n) : (f32x4){0.f, 0.f, 0.f, 0.f};
#pragma unroll
        for (int ai = 0; ai < 2; ++ai)
#pragma unroll
            for (int m = 0; m < 4; ++m) { bf16_t* rowp = base + (size_t)(row0 + ai * HALF + m * 16) * ldc + col0;
#pragma unroll
                for (int bj = 0; bj < 2; ++bj) { f32x4 v0 = acc[ai][bj][m][0] + bv[bj][0], v1 = acc[ai][bj][m][1] + bv[bj][1];
                    if (ACT == 1) { f32x2 a = gelu_pk((f32x2){v0[0], v0[1]}), b = gelu_pk((f32x2){v0[2], v0[3]}), c = gelu_pk((f32x2){v1[0], v1[1]}), d = gelu_pk((f32x2){v1[2], v1[3]});
                        v0 = (f32x4){a.x, a.y, b.x, b.y}; v1 = (f32x4){c.x, c.y, d.x, d.y}; }
                    v0 = v0 * sc; v1 = v1 * sc; u32x4 w; w.x = cvt_pk_bf16(v0[0], v0[1]); w.y = cvt_pk_bf16(v0[2], v0[3]); w.z = cvt_pk_bf16(v1[0], v1[1]); w.w = cvt_pk_bf16(v1[2], v1[3]);
                    *(u32x4*)(rowp + bj * HALF) = w; } }
    }
};

typedef unsigned u32x2 __attribute__((ext_vector_type(2)));
__device__ __forceinline__ u32x4 pack8(const f32x4 v0, const f32x4 v1) { u32x4 w; w.x = cvt_pk_bf16(v0[0], v0[1]); w.y = cvt_pk_bf16(v0[2], v0[3]); w.z = cvt_pk_bf16(v1[0], v1[1]); w.w = cvt_pk_bf16(v1[2], v1[3]); return w; }

__device__ __forceinline__ unsigned pk4_i8(float a, float b, float c, float d) {
    const int ia = (int)__builtin_rintf(fminf(fmaxf(a, -127.f), 127.f)), ib = (int)__builtin_rintf(fminf(fmaxf(b, -127.f), 127.f));
    const int ic = (int)__builtin_rintf(fminf(fmaxf(c, -127.f), 127.f)), id = (int)__builtin_rintf(fminf(fmaxf(d, -127.f), 127.f));
    return (unsigned)(ia & 0xff) | ((unsigned)(ib & 0xff) << 8) | ((unsigned)(ic & 0xff) << 16) | ((unsigned)id << 24); }
struct LinearOrder {
    int nwg, G, c;
    __device__ __forceinline__ bool next(int i, Unit& u) const { const long L = (long)i * G + c; if (L >= nwg) return false; int z = 0; asm volatile("" : "+s"(z)); u.pm = z; u.pn = (int)L; return true; }
    __device__ __forceinline__ void a_ready(const Unit&) const {}
    __device__ __forceinline__ void done(const Unit&) const {}
};
struct MoeOrder {
    const PG8_LAS int* blk_e; int NB, NJ, G, v;
    __device__ __forceinline__ bool next(int i, Unit& u) const { const long L = (long)i * G + v; if (L >= (long)NB * NJ) return false; const int blk = (int)(L / NJ), j = (int)(L - (long)blk * NJ);
        const int w = __builtin_amdgcn_readfirstlane(blk_e[blk]); const int e = w & 255; u.pm = w >> 8; u.pn = e * NJ + j; return true; }
    __device__ __forceinline__ void a_ready(const Unit&) const {}
    __device__ __forceinline__ void done(const Unit&) const {}
};

struct EpiQKV {
    static constexpr bool PERM = false, AFTER_DRAIN = false;
    bf16_t* Q; unsigned kv_stride; const float* ropec; const float* ropes; float qscale; const float* asc; float wsc_inv; int probe = 0;
    __device__ __forceinline__ void operator()(const i32x4_t (&acc)[2][2][4][2], const Unit& u, int wr, int wc, int fr_, int fq_) const {
        int fr = fr_, fq = fq_; asm volatile("" : "+v"(fr), "+v"(fq));
        if (probe == 2) { asm volatile("" :: "v"(acc[0][0][0][0]), "v"(acc[1][1][3][1])); return; }
        const int t = u.pn >> 2;
        const bool ctx = u.pm >= 64;
        bf16_t* dst = Q + (size_t)t * kv_stride;
        const float sc = t == 0 ? qscale : 1.f;
        const bool rope = (t < 2) && !ctx;
        const unsigned colofs2 = (unsigned)((u.pn & 3) * 256 + wc * 32 + ((fq & 1) ? 16 + 4 * (fq - 1) : 4 * fq));
        const unsigned tabofs = (unsigned)(4 * fq);
        const int r0 = u.pm * 256 + wr * 64 + fr;
        float rsv[8];
#pragma unroll
        for (int g = 0; g < 8; ++g) rsv[g] = *(const float*)((const char*)asc + (unsigned)(r0 + (g >> 2) * 128 + (g & 3) * 16) * 4u);
        f32x4 cN, sN; cN = sN = (f32x4){0.f, 0.f, 0.f, 0.f};
#define QKV_TAB(g, cD, sD) { if (rope) { const int n_ = (r0 + ((g) >> 2) * 128 + ((g) & 3) * 16) & 8191; const unsigned pos_ = (unsigned)((wc & 1) ? (n_ & 63) : (n_ >> 6)); \
            cD = *(const f32x4*)((const char*)ropec + ((pos_ * 16u + tabofs) * 4u)); sD = *(const f32x4*)((const char*)ropes + ((pos_ * 16u + tabofs) * 4u)); } }
        QKV_TAB(0, cN, sN)
#pragma unroll
        for (int g = 0; g < 8; ++g) {
            const int ai = g >> 2, m = g & 3;
            const int r = r0 + ai * 128 + m * 16;
            unsigned drow;
            if (t == 0) drow = (unsigned)r;
            else if (!ctx) drow = (unsigned)(r + ((r >> 13) << 8));
            else { const int rc = r - 16384; drow = (unsigned)((rc >> 8) * 8448 + 8192 + (rc & 255)); }
            const f32x4 c4 = cN, s4 = sN;
            if (g < 7) QKV_TAB(g + 1, cN, sN)
            const unsigned off2 = drow * 1024u + colofs2;
            const float rs = rsv[g] * wsc_inv;
#pragma unroll
            for (int bj = 0; bj < 2; ++bj) {
                const f32x4 x1 = __builtin_convertvector(acc[ai][bj][m][0], f32x4) * rs, x2 = __builtin_convertvector(acc[ai][bj][m][1], f32x4) * rs;
                f32x4 o1, o2;
                if (rope) { o1 = (x1 * c4 - x2 * s4) * sc; o2 = (x2 * c4 + x1 * s4) * sc; } else { o1 = x1 * sc; o2 = x2 * sc; }
                u32x2 w1, w2; w1.x = cvt_pk_bf16(o1[0], o1[1]); w1.y = cvt_pk_bf16(o1[2], o1[3]); w2.x = cvt_pk_bf16(o2[0], o2[1]); w2.y = cvt_pk_bf16(o2[2], o2[3]);
                { const auto s0_ = __builtin_amdgcn_permlane16_swap(w1.x, w2.x, false, false); const auto s1_ = __builtin_amdgcn_permlane16_swap(w1.y, w2.y, false, false);
                  const u32x4 wv_ = {s0_[0], s1_[0], s0_[1], s1_[1]};
                  *(u32x4*)(dst + (off2 + bj * 128)) = wv_; }
            }
            asm volatile("" ::: "memory");
        }
#undef QKV_TAB
    }
};

struct EpiI8Bf16 {
    static constexpr bool PERM = true, AFTER_DRAIN = false;
    bf16_t* O; const float* asc; float wsc_inv; float cscale = 1.f;
    __device__ __forceinline__ void operator()(const i32x4_t (&acc)[2][2][4][2], const Unit& u, int wr, int wc, int fr_, int fq_) const {
        int fr = fr_, fq = fq_; asm volatile("" : "+v"(fr), "+v"(fq));
        const unsigned cofs = (unsigned)(u.pn * 256 + wc * 32 + 8 * fq);
        float rsv[8];
#pragma unroll
        for (int g = 0; g < 8; ++g) rsv[g] = asc ? *(const float*)((const char*)asc + (unsigned)(u.pm * 256 + (g >> 2) * 128 + wr * 64 + (g & 3) * 16 + fr) * 4u) : cscale;
#pragma unroll
        for (int ai = 0; ai < 2; ++ai)
#pragma unroll
            for (int m = 0; m < 4; ++m) {
                const unsigned row = (unsigned)(u.pm * 256 + ai * 128 + wr * 64 + m * 16 + fr);
                const float rs = rsv[ai * 4 + m] * wsc_inv;
#pragma unroll
                for (int bj = 0; bj < 2; ++bj) *(u32x4*)((char*)O + (row * 1024u + cofs + (unsigned)(bj * 128)) * 2u) = pack8(__builtin_convertvector(acc[ai][bj][m][0], f32x4) * rs, __builtin_convertvector(acc[ai][bj][m][1], f32x4) * rs);
                asm volatile("" ::: "memory");
            }
    }
};
struct EpiPF1 {
    static constexpr bool PERM = true, AFTER_DRAIN = false;
    bf16_t* U2; const float* asc; float wsc_inv; const float* ng; PG8_LAS float* SS; float eps; int rl;
    __device__ __forceinline__ void operator()(const i32x4_t (&acc)[2][2][4][2], const Unit& u, int wr, int wc, int fr_, int fq_) const {
        int fr = fr_, fq = fq_; asm volatile("" : "+v"(fr), "+v"(fq));
        const int lane_ = fr + 16 * fq;
        float rsv[8];
#pragma unroll
        for (int g = 0; g < 8; ++g) rsv[g] = *(const float*)((const char*)asc + (unsigned)(u.pm * 256 + (g >> 2) * 128 + wr * 64 + (g & 3) * 16 + fr) * 4u) * wsc_inv;
#pragma unroll
        for (int ai = 0; ai < 2; ++ai)
#pragma unroll
            for (int m = 0; m < 4; ++m) { const float rs = rsv[ai * 4 + m];
#pragma unroll
                for (int bj = 0; bj < 2; ++bj) { const f32x4 v0 = __builtin_convertvector(acc[ai][bj][m][0], f32x4) * rs, v1 = __builtin_convertvector(acc[ai][bj][m][1], f32x4) * rs;
                    float q = (v0[0] * v0[0] + v0[1] * v0[1]) + (v0[2] * v0[2] + v0[3] * v0[3]) + (v1[0] * v1[0] + v1[1] * v1[1]) + (v1[2] * v1[2] + v1[3] * v1[3]);
                    { auto r1_ = __builtin_amdgcn_permlane16_swap(__float_as_uint(q), __float_as_uint(q), false, false); q = __uint_as_float(r1_[0]) + __uint_as_float(r1_[1]); }
                    { auto r2_ = __builtin_amdgcn_permlane32_swap(__float_as_uint(q), __float_as_uint(q), false, false); q = __uint_as_float(r2_[0]) + __uint_as_float(r2_[1]); }
                    if (fq == 0) SS[((ai * 128 + wr * 64 + m * 16 + fr) * 2 + bj) * 4 + wc] = q; } }
        (void)lane_;
        asm volatile("s_waitcnt lgkmcnt(0)\n\ts_barrier" ::: "memory");
        f32x4 gv[2][2];
#pragma unroll
        for (int bj = 0; bj < 2; ++bj)
#pragma unroll
            for (int n = 0; n < 2; ++n) gv[bj][n] = *(const f32x4*)(ng + u.pn * 256 + bj * 128 + wc * 32 + 8 * fq + 4 * n);
#pragma unroll
        for (int ai = 0; ai < 2; ++ai)
#pragma unroll
            for (int m = 0; m < 4; ++m) { const float rs = rsv[ai * 4 + m];
                const int rloc = ai * 128 + wr * 64 + m * 16 + fr, r = u.pm * 256 + rloc;
#pragma unroll
                for (int bj = 0; bj < 2; ++bj) { const int g = 2 * u.pn + bj;
                    const f32x4 p = *(const PG8_LAS f32x4*)(SS + (rloc * 2 + bj) * 4);
                    const float rn = rs / __builtin_sqrtf(((p[0] + p[1]) + (p[2] + p[3])) * (1.f / 128.f) + eps);
                    unsigned drow;
                    if (r < rl) { const int b = r >> 13, n_ = r & 8191; drow = (unsigned)(((b * 8 + g) * 64 + (n_ & 63)) * 128 + (n_ >> 6)); }
                    else { const int rc = r - rl; drow = 131072u + (unsigned)(((rc >> 8) * 8 + g) * 256 + (rc & 255)); }
                    *(u32x4*)((char*)U2 + (drow * 128u + (unsigned)(wc * 32 + 8 * fq)) * 2u) = pack8(__builtin_convertvector(acc[ai][bj][m][0], f32x4) * rn * gv[bj][0], __builtin_convertvector(acc[ai][bj][m][1], f32x4) * rn * gv[bj][1]); }
                asm volatile("" ::: "memory"); }
    }
};
struct EpiZ1 {
    static constexpr bool PERM = true, AFTER_DRAIN = false;
    bf16_t* Z1; bf16_t* Zc;
    __device__ __forceinline__ void operator()(const f32x4 (&acc)[2][2][4][2], const Unit& u, int wr, int wc, int fr_, int fq_) const {
        int fr = fr_, fq = fq_; asm volatile("" : "+v"(fr), "+v"(fq));
        const int mm0 = wr * 64 + fr;
#pragma unroll
        for (int bj = 0; bj < 2; ++bj) {
            const int rho0 = u.pn * 256 + bj * 128 + wc * 32 + 8 * fq;
            const bool lat = rho0 < 131072;
            bf16_t* dst; unsigned base, smm, sre;
            if (lat) { const int bgn = rho0 >> 7, n_hi = rho0 & 127, bg = bgn >> 6, n_lo = bgn & 63; dst = Z1; smm = 64u * 256u; sre = 128u; base = (unsigned)(bg * 128) * smm + (unsigned)(n_lo * 256 + n_hi); }
            else { const int rc = rho0 - 131072, bg = rc >> 8, j = rc & 255; dst = Zc; smm = 512u; sre = 256u; base = (unsigned)(bg * 128) * smm + (unsigned)j; }
            base += (unsigned)mm0 * smm;
#pragma unroll
            for (int m = 0; m < 4; ++m) {
#pragma unroll
                for (int ai = 0; ai < 2; ++ai) *(u32x4*)(dst + (base + (unsigned)(m * 16) * smm + (unsigned)ai * sre)) = pack8(acc[ai][bj][m][0], acc[ai][bj][m][1]);
                asm volatile("" ::: "memory");
            }
        }
    }
};
struct EpiFFT1 {
    static constexpr bool PERM = true, AFTER_DRAIN = false;
    bf16_t* T; const float* twc; const float* tws;
    __device__ __forceinline__ void operator()(const f32x4 (&acc)[2][2][4][2], const Unit& u, int wr, int wc, int fr_, int fq_) const {
        int fr = fr_, fq = fq_; asm volatile("" : "+v"(fr), "+v"(fq));
        const int kl0 = wr * 64 + fr;
#pragma unroll
        for (int bj = 0; bj < 2; ++bj) {
            const int rho0 = u.pn * 256 + bj * 128 + wc * 32 + 8 * fq;
            const int n_lo0 = rho0 & 63, bgm = rho0 >> 6, mm = bgm & 127, bg = bgm >> 7;
            const unsigned base = ((unsigned)(bg * 128 + kl0) * 128u + (unsigned)mm) * 128u + (unsigned)n_lo0;
            const unsigned tw0 = (unsigned)(kl0 * 64 + n_lo0);
            f32x4 cN[2], sN[2];
#define FFT1_TW(m_) { _Pragma("unroll") for (int n_ = 0; n_ < 2; ++n_) { cN[n_] = *(const f32x4*)((const char*)twc + ((tw0 + (m_) * 1024 + 4 * n_) * 4u)); sN[n_] = *(const f32x4*)((const char*)tws + ((tw0 + (m_) * 1024 + 4 * n_) * 4u)); } }
            FFT1_TW(0)
#pragma unroll
            for (int m = 0; m < 4; ++m) {
                f32x4 pr[2], pi[2];
                const f32x4 c0 = cN[0], c1 = cN[1], s0 = sN[0], s1 = sN[1];
                if (m < 3) FFT1_TW(m + 1)
#pragma unroll
                for (int n = 0; n < 2; ++n) {
                    const f32x4 c4 = n ? c1 : c0, s4 = n ? s1 : s0;
                    const f32x4 tr = acc[0][bj][m][n], ti = acc[1][bj][m][n];
                    pr[n] = tr * c4 + ti * s4; pi[n] = ti * c4 - tr * s4;
                }
                *(u32x4*)((char*)T + ((base + (unsigned)m * 262144u) * 2u)) = pack8(pr[0], pr[1]); *(u32x4*)((char*)T + ((base + (unsigned)m * 262144u + 64u) * 2u)) = pack8(pi[0], pi[1]);
                asm volatile("" ::: "memory");
            }
#undef FFT1_TW
        }
    }
};
struct EpiFFT2 {
    static constexpr bool PERM = true, AFTER_DRAIN = false;
    bf16_t* F;
    __device__ __forceinline__ void operator()(const f32x4 (&acc)[2][2][4][2], const Unit& u, int wr, int wc, int fr_, int fq_) const {
        int fr = fr_, fq = fq_; asm volatile("" : "+v"(fr), "+v"(fq));
        if (wr != 0) return;
#pragma unroll
        for (int bj = 0; bj < 2; ++bj) {
            const int rho0 = u.pn * 256 + bj * 128 + wc * 32 + 8 * fq;
            const int mm0 = rho0 & 127, bgk = rho0 >> 7, k_lo = bgk & 127, bg = bgk >> 7, b = bg >> 3, g = bg & 7;
#pragma unroll
            for (int m = 0; m < 4; ++m) {
                const int k_hi = m * 16 + fr;
                const long row = (long)b * 8192 + k_hi * 128 + k_lo;
                *(u32x4*)(F + row * 1024 + g * 128 + mm0) = pack8(acc[0][bj][m][0], acc[0][bj][m][1]);
            }
        }
    }
};
struct EpiDFT256 {
    static constexpr bool PERM = true, AFTER_DRAIN = false;
    bf16_t* F;
    __device__ __forceinline__ void operator()(const f32x4 (&acc)[2][2][4][2], const Unit& u, int wr, int wc, int fr_, int fq_) const {
        int fr = fr_, fq = fq_; asm volatile("" : "+v"(fr), "+v"(fq));
#pragma unroll
        for (int bj = 0; bj < 2; ++bj) {
            const int rho0 = u.pn * 256 + bj * 128 + wc * 32 + 8 * fq;
            const int mm0 = rho0 & 127, bg = rho0 >> 7, b = bg >> 3, g = bg & 7;
#pragma unroll
            for (int ai = 0; ai < 2; ++ai)
#pragma unroll
                for (int m = 0; m < 4; ++m) {
                    const int k = ai * 128 + wr * 64 + m * 16 + fr;
                    const long row = 16384 + (long)b * 256 + k;
                    *(u32x4*)(F + row * 1024 + g * 128 + mm0) = pack8(acc[ai][bj][m][0], acc[ai][bj][m][1]);
                }
        }
    }
};
struct EpiSwiGLU {
    static constexpr bool PERM = true, AFTER_DRAIN = false;
    unsigned char* ACT; const float* bgu; const float* asc; float wsc_inv, act_q;
    int no_store;
    __device__ __forceinline__ const float* stg_src0(int pm_, int pn_, int lane) const { (void)pn_; return asc + pm_ * 256 + 4 * lane; }
    __device__ __forceinline__ const float* stg_src1(int pm_, int pn_, int lane) const { (void)pm_; const int e = pn_ >> 3, j = pn_ & 7; return bgu + e * 2048 + j * 128 + (lane < 32 ? 4 * lane : 1024 + 4 * (lane - 32)); }
    __device__ __forceinline__ void operator()(const i32x4_t (&acc)[2][2][4][2], const Unit& u, int wr, int wc, int fr_, int fq_) const {
        int fr = fr_, fq = fq_; asm volatile("" : "+v"(fr), "+v"(fq));
        if (no_store == 2) { asm volatile("" :: "v"(acc[0][0][0][0]), "v"(acc[1][1][3][1])); return; }
        const int e = u.pn >> 3, j = u.pn & 7, col0 = j * 128 + wc * 32 + 8 * fq; (void)e;
        const PG8_LAS float* sg_ = (const PG8_LAS float*)(size_t)(unsigned)u.aux;
        f32x4 bg[2], bu[2];
#pragma unroll
        for (int n = 0; n < 2; ++n) { bg[n] = *(const PG8_LAS f32x4*)(sg_ + 256 + wc * 32 + 8 * fq + 4 * n); bu[n] = *(const PG8_LAS f32x4*)(sg_ + 384 + wc * 32 + 8 * fq + 4 * n); }
        float rsv[8];
#pragma unroll
        for (int g = 0; g < 8; ++g) rsv[g] = sg_[(g >> 2) * 128 + wr * 64 + (g & 3) * 16 + fr];
        f32x4 buq[2];
#pragma unroll
        for (int n = 0; n < 2; ++n) buq[n] = (bu[n] + 1.0f) * act_q;
        const float ulo = -6.0f * act_q, uhi = 8.0f * act_q;
        u32x2 wprev = {0u, 0u}; const int col16 = (u.pn & 7) * 128 + wc * 32 + 16 * (fq >> 1);
#pragma unroll
        for (int ai = 0; ai < 2; ++ai)
#pragma unroll
            for (int m = 0; m < 4; ++m) {
                const unsigned row = (unsigned)(u.pm * 256 + ai * 128 + wr * 64 + (m & ~1) * 16 + ((fq & 1) ? 16 : 0) + fr);
                const float rsg = rsv[ai * 4 + m] * wsc_inv, rsu = rsg * act_q;
                unsigned bits[8];
#pragma unroll
                for (int n = 0; n < 2; ++n)
#pragma unroll
                    for (int ip = 0; ip < 2; ++ip) {
                        const f32x2 ag = {(float)acc[ai][0][m][n][2 * ip], (float)acc[ai][0][m][n][2 * ip + 1]}, au = {(float)acc[ai][1][m][n][2 * ip], (float)acc[ai][1][m][n][2 * ip + 1]};
                        f32x2 g = __builtin_elementwise_fma(ag, (f32x2){rsg, rsg}, (f32x2){bg[n][2 * ip], bg[n][2 * ip + 1]});
                        g.x = fminf(g.x, 7.0f); g.y = fminf(g.y, 7.0f);
                        f32x2 uq = __builtin_elementwise_fma(au, (f32x2){rsu, rsu}, (f32x2){buq[n][2 * ip], buq[n][2 * ip + 1]});
                        uq.x = __builtin_amdgcn_fmed3f(uq.x, ulo, uhi); uq.y = __builtin_amdgcn_fmed3f(uq.y, ulo, uhi);
                        const f32x2 t = g * (-1.702f * 1.4426950408889634f);
                        f32x2 d; d.x = __builtin_amdgcn_exp2f(t.x); d.y = __builtin_amdgcn_exp2f(t.y);
                        d = d + 1.0f;
                        f32x2 sg; sg.x = __builtin_amdgcn_rcpf(d.x); sg.y = __builtin_amdgcn_rcpf(d.y);
                        f32x2 a = (g * sg) * uq;
                        a.x = __builtin_amdgcn_fmed3f(a.x, -127.0f, 127.0f); a.y = __builtin_amdgcn_fmed3f(a.y, -127.0f, 127.0f);
                        a = a + 12582912.0f;
                        bits[4 * n + 2 * ip] = __float_as_uint(a.x); bits[4 * n + 2 * ip + 1] = __float_as_uint(a.y);
                    }
                u32x2 w;
                w.x = __builtin_amdgcn_perm(bits[1], bits[0], 0x0c0c0400u) | (__builtin_amdgcn_perm(bits[3], bits[2], 0x0c0c0400u) << 16);
                w.y = __builtin_amdgcn_perm(bits[5], bits[4], 0x0c0c0400u) | (__builtin_amdgcn_perm(bits[7], bits[6], 0x0c0c0400u) << 16);
                if ((m & 1) == 0) wprev = w;
                else { const auto s0_ = __builtin_amdgcn_permlane16_swap(wprev.x, w.x, false, false); const auto s1_ = __builtin_amdgcn_permlane16_swap(wprev.y, w.y, false, false);
                    const u32x4 wv_ = {s0_[0], s1_[0], s0_[1], s1_[1]};
                    if (!no_store) *(u32x4*)(ACT + (row * 1024u + (unsigned)col16)) = wv_; else asm volatile("" :: "v"(wv_));
                    asm volatile("" ::: "memory"); }
            }
    }
};
__device__ __forceinline__ unsigned pk4_fp8(float a, float b, float c, float d) { int w = 0; w = __builtin_amdgcn_cvt_pk_fp8_f32(a, b, w, false); w = __builtin_amdgcn_cvt_pk_fp8_f32(c, d, w, true); return (unsigned)w; }
struct EpiMoE2 {
    static constexpr bool PERM = true, AFTER_DRAIN = false;
    unsigned char* OUT; const float* bd; const float* gate; float inv_scale, out_scale;
    int no_store;
    __device__ __forceinline__ const float* stg_src0(int pm_, int pn_, int lane) const { (void)pn_; return gate + pm_ * 256 + 4 * lane; }
    __device__ __forceinline__ const float* stg_src1(int pm_, int pn_, int lane) const { (void)pm_; const int e = pn_ >> 2, j = pn_ & 3; return bd + e * 1024 + j * 256 + 4 * lane; }
    __device__ __forceinline__ void operator()(const i32x4_t (&acc)[2][2][4][2], const Unit& u, int wr, int wc, int fr_, int fq_) const {
        int fr = fr_, fq = fq_; asm volatile("" : "+v"(fr), "+v"(fq));
        if (no_store == 2) { asm volatile("" :: "v"(acc[0][0][0][0]), "v"(acc[1][1][3][1])); return; }
        const int e = u.pn >> 2, j = u.pn & 3; (void)e;
        const PG8_LAS float* sg_ = (const PG8_LAS float*)(size_t)(unsigned)u.aux;
        const unsigned cofs = (unsigned)(j * 256 + wc * 32 + 8 * fq), cofs16 = (unsigned)(j * 256 + wc * 32 + 16 * (fq >> 1));
        u32x2 pprev[2] = {{0u, 0u}, {0u, 0u}};
        f32x4 bv[2][2];
#pragma unroll
        for (int bj = 0; bj < 2; ++bj)
#pragma unroll
            for (int n = 0; n < 2; ++n) bv[bj][n] = *(const PG8_LAS f32x4*)(sg_ + 256 + bj * 128 + wc * 32 + 8 * fq + 4 * n);
        float gtv[8];
#pragma unroll
        for (int g = 0; g < 8; ++g) gtv[g] = sg_[(g >> 2) * 128 + wr * 64 + (g & 3) * 16 + fr] * out_scale;
#pragma unroll
        for (int ai = 0; ai < 2; ++ai)
#pragma unroll
            for (int m = 0; m < 4; ++m) {
                const unsigned row = (unsigned)(u.pm * 256 + ai * 128 + wr * 64 + (m & ~1) * 16 + ((fq & 1) ? 16 : 0) + fr);
                const float gt = gtv[ai * 4 + m];
#pragma unroll
                for (int bj = 0; bj < 2; ++bj) {
                    f32x4 v0 = (__builtin_convertvector(acc[ai][bj][m][0], f32x4) * inv_scale + bv[bj][0]) * gt, v1 = (__builtin_convertvector(acc[ai][bj][m][1], f32x4) * inv_scale + bv[bj][1]) * gt;
#pragma unroll
                    for (int i = 0; i < 4; ++i) { v0[i] = __builtin_amdgcn_fmed3f(v0[i], -440.f, 440.f); v1[i] = __builtin_amdgcn_fmed3f(v1[i], -440.f, 440.f); }
                    u32x2 pw_; pw_.x = pk4_fp8(v0[0], v0[1], v0[2], v0[3]); pw_.y = pk4_fp8(v1[0], v1[1], v1[2], v1[3]);
                    if ((m & 1) == 0) pprev[bj] = pw_;
                    else { const auto s0_ = __builtin_amdgcn_permlane16_swap(pprev[bj].x, pw_.x, false, false); const auto s1_ = __builtin_amdgcn_permlane16_swap(pprev[bj].y, pw_.y, false, false);
                        const u32x4 wv_ = {s0_[0], s1_[0], s0_[1], s1_[1]};
                        if (!no_store) *(u32x4*)(OUT + (row * 1024u + cofs16 + (unsigned)(bj * 128))) = wv_; else asm volatile("" :: "v"(wv_)); }
                }
                asm volatile("" ::: "memory");
            }
    }
};
template <> struct EpiStg<EpiSwiGLU> { static constexpr int N = 2; };
template <> struct EpiStg<EpiMoE2> { static constexpr int N = 2; };

template <class E> struct NoZeroC { static constexpr bool value = false; };
template <> struct NoZeroC<EpiBf16<0>> { static constexpr bool value = true; };
template <class Epi, class Sched, bool ALIGN_EPI = false, bool SP2 = false, int MODE = 0, bool GATHER = false>
__device__ __forceinline__ void gemm_phase(PG8_LAS unsigned char* lds, const Gemm g, const Sched& S, const Epi& E) {
    int tid_o = threadIdx.x; asm volatile("" : "+v"(tid_o));
    const int tid = tid_o, wid = __builtin_amdgcn_readfirstlane(tid >> 6), lane = tid & 63, wr = wid >> 2, wc = wid & 3, fr = lane & 15, fq = lane >> 4;
    const int K = g.K, nt = K / BK;
    unsigned voffA[2], voffB[2];
#pragma unroll
    for (int i = 0; i < 2; ++i) { int R, C; stage_rc(tid * 16 + i * 8192, R, C); const int Rb = Epi::PERM ? ((R & ~31) + perm32(R & 31)) : R;
        voffA[i] = (unsigned)(R * K + C) * 2u; voffB[i] = (unsigned)(Rb * K + C) * 2u; }
    static_assert(!GATHER || SP2, "GATHER is written into the SP2 loop only");
    unsigned cvG[2][2], nvG[2][2]; int Rg[2]; unsigned Cb[2];
#pragma unroll
    for (int i = 0; i < 2; ++i) { int R, C; stage_rc(tid * 16 + i * 8192, R, C); Rg[i] = R; Cb[i] = (unsigned)C * 2u; }
#define PG8_GFETCH(slot, pm_) do { if (wid < 4) { int l_ = lane; asm volatile("" : "+v"(l_));     \
        __builtin_amdgcn_global_load_lds((const unsigned*)(g.rowidx + (size_t)(pm_) * 256 + wid * 64 + l_), (PG8_LAS unsigned*)(g.idx + (slot) * 256 + wid * 64), 4, 0, 0); } } while (0)
#define PG8_GIDX(slot, dst) do { int tg_ = threadIdx.x; asm volatile("" : "+v"(tg_)); _Pragma("unroll") for (int h_ = 0; h_ < 2; ++h_) _Pragma("unroll") for (int i_ = 0; i_ < 2; ++i_) { int R_, C_; stage_rc(tg_ * 16 + i_ * 8192, R_, C_); const int Rg_ = R_; const unsigned Cb_ = (unsigned)C_ * 2u; unsigned ix_ = (unsigned)g.idx[(slot) * 256 + h_ * 128 + Rg_]; ix_ = ix_ < g.idx_max ? ix_ : g.idx_max; dst[h_][i_] = ix_ * (unsigned)(2 * K) + Cb_; } } while (0)
#define PG8_STAGE_A(bufoff, h, base, nsel) do { if constexpr (GATHER) { const unsigned vs_[2] = {(nsel) ? nvG[h][0] : cvG[h][0], (nsel) ? nvG[h][1] : cvG[h][1]}; PG8_STAGE(bufoff, base, vs_); } \
        else { PG8_STAGE(bufoff, (base) + (h) * hstep, voffA); } } while (0)
    const size_t kstep = (size_t)(BK * 2);
    const size_t hstep = (size_t)HALF * K * 2;
    const size_t tstep = 2 * hstep;
    const unsigned ldsw = (unsigned)wid * 1024u;
    const int aoff = lds_byte(wr * 64 + fr, fq * 8), boff = lds_byte(wc * 32 + fr, fq * 8);
#define PG8_SA(b, h) (((b) * 2 + (h)) * HTB)
#define PG8_SB(b, h) ((4 + (b) * 2 + (h)) * HTB)
#define PG8_STAGE(bufoff, gbase, voff) do { _Pragma("unroll") for (int _i = 0; _i < 2; ++_i) \
        __builtin_amdgcn_global_load_lds((const unsigned*)((const char*)(gbase) + (voff)[_i]), (PG8_LAS unsigned*)(lds + (bufoff) + ldsw + _i * 8192), 16, 0, 0); } while (0)
#define PG8_LDA(dst, b, h) do { _Pragma("unroll") for (int m = 0; m < 4; ++m) _Pragma("unroll") for (int k = 0; k < 2; ++k) dst[m][k] = *(const PG8_LAS bf16x8*)(lds + PG8_SA(b, h) + aoff + m * 2048 + k * 1024); } while (0)
#define PG8_LDB(dst, b, h) do { _Pragma("unroll") for (int n = 0; n < 2; ++n) _Pragma("unroll") for (int k = 0; k < 2; ++k) dst[n][k] = *(const PG8_LAS bf16x8*)(lds + PG8_SB(b, h) + boff + n * 2048 + k * 1024); } while (0)
#define PG8_MMA(ai, bj, At, Bt) do { __builtin_amdgcn_s_setprio(1); _Pragma("unroll") for (int m = 0; m < 4; ++m) _Pragma("unroll") for (int n = 0; n < 2; ++n) _Pragma("unroll") for (int k = 0; k < 2; ++k) { \
        if constexpr (MODE == 1) acc[ai][bj][m][n] = __builtin_amdgcn_mfma_i32_16x16x64_i8(__builtin_bit_cast(i32x4_t, Bt[n][k]), __builtin_bit_cast(i32x4_t, At[m][k]), acc[ai][bj][m][n], 0, 0, 0); \
        else acc[ai][bj][m][n] = __builtin_amdgcn_mfma_f32_16x16x32_bf16(Bt[n][k], At[m][k], acc[ai][bj][m][n], 0, 0, 0); } __builtin_amdgcn_s_setprio(0); } while (0)
#define PG8_MMAZ(ai, bj, At, Bt) do { __builtin_amdgcn_s_setprio(1); _Pragma("unroll") for (int m = 0; m < 4; ++m) _Pragma("unroll") for (int n = 0; n < 2; ++n) { \
        if constexpr (MODE == 1) asm volatile("v_mfma_i32_16x16x64_i8 %0, %1, %2, 0" : "+v"(acc[ai][bj][m][n]) : "v"(Bt[n][0]), "v"(At[m][0])); \
        else asm volatile("v_mfma_f32_16x16x32_bf16 %0, %1, %2, 0" : "+v"(acc[ai][bj][m][n]) : "v"(Bt[n][0]), "v"(At[m][0])); } \
        __builtin_amdgcn_sched_barrier(0); \
        _Pragma("unroll") for (int m = 0; m < 4; ++m) _Pragma("unroll") for (int n = 0; n < 2; ++n) { \
        if constexpr (MODE == 1) acc[ai][bj][m][n] = __builtin_amdgcn_mfma_i32_16x16x64_i8(__builtin_bit_cast(i32x4_t, Bt[n][1]), __builtin_bit_cast(i32x4_t, At[m][1]), acc[ai][bj][m][n], 0, 0, 0); \
        else acc[ai][bj][m][n] = __builtin_amdgcn_mfma_f32_16x16x32_bf16(Bt[n][1], At[m][1], acc[ai][bj][m][n], 0, 0, 0); } __builtin_amdgcn_s_setprio(0); } while (0)
#define PG8_WAIT_V(n) asm volatile("s_waitcnt vmcnt(" #n ")" ::: "memory")
#define PG8_WAIT_L(n) asm volatile("s_waitcnt lgkmcnt(" #n ")" ::: "memory")
#define PG8_BAR __builtin_amdgcn_s_barrier()
#define PG8_SCHED __builtin_amdgcn_sched_barrier(0)
    Unit cur, nxt; int ui = 0;
    if (!S.next(0, cur)) return;
    typedef typename AccSel<MODE>::type acc_t;
    const unsigned stga_ = (unsigned)(size_t)lds + 131072u + 1024u + 1536u * 4u;
    constexpr bool ZC = !NoZeroC<Epi>::value;
    acc_t acc[2][2][4][2];
#pragma unroll
    for (int a = 0; a < 2; ++a)
#pragma unroll
        for (int b = 0; b < 2; ++b)
#pragma unroll
            for (int m = 0; m < 4; ++m)
#pragma unroll
                for (int n = 0; n < 2; ++n) { if constexpr (ZC) asm volatile("" : "=v"(acc[a][b][m][n])); else acc[a][b][m][n] = acc_t{}; }
    bf16x8 At[4][2], B0[2][2], B1[2][2];
    const char* cA = GATHER ? (const char*)g.A : (const char*)g.A + (size_t)cur.pm * tstep; const char* cB = (const char*)g.Bt + (size_t)cur.pn * tstep;
    S.a_ready(cur);
    if constexpr (EpiStg<Epi>::N > 0) {
        if (wid == 4) __builtin_amdgcn_global_load_lds((const unsigned*)E.stg_src0(cur.pm, cur.pn, lane), (PG8_LAS unsigned*)(size_t)(stga_), 16, 0, 0);
        else if (wid == 5) __builtin_amdgcn_global_load_lds((const unsigned*)E.stg_src1(cur.pm, cur.pn, lane), (PG8_LAS unsigned*)(size_t)(stga_ + 1024u), 16, 0, 0); }
    if constexpr (GATHER) {
        PG8_GFETCH(0, cur.pm); PG8_WAIT_V(0); PG8_BAR; asm volatile("" ::: "memory");
        PG8_GIDX(0, cvG);
#pragma unroll
        for (int h_ = 0; h_ < 2; ++h_) { nvG[h_][0] = cvG[h_][0]; nvG[h_][1] = cvG[h_][1]; }
    }
    if constexpr (SP2) {
        PG8_STAGE(PG8_SB(0, 0), cB, voffB); PG8_STAGE(PG8_SB(0, 1), cB + hstep, voffB); PG8_STAGE_A(PG8_SA(0, 0), 0, cA, false); PG8_STAGE_A(PG8_SA(0, 1), 1, cA, false);
        if (wr == 1) PG8_BAR;
        PG8_WAIT_V(2); PG8_BAR;
        PG8_STAGE(PG8_SB(1, 0), cB + kstep, voffB); PG8_STAGE_A(PG8_SA(1, 0), 0, cA + kstep, false); PG8_STAGE(PG8_SB(1, 1), cB + hstep + kstep, voffB);
        PG8_WAIT_V(6); PG8_BAR;
    } else {
        PG8_STAGE(PG8_SB(0, 0), cB, voffB); PG8_STAGE(PG8_SA(0, 0), cA, voffA); PG8_STAGE(PG8_SB(0, 1), cB + hstep, voffB); PG8_STAGE(PG8_SA(0, 1), cA + hstep, voffA);
        if (wr == 1) PG8_BAR;
        PG8_WAIT_V(4); PG8_BAR;
        PG8_STAGE(PG8_SB(1, 0), cB + kstep, voffB); PG8_STAGE(PG8_SA(1, 0), cA + kstep, voffA); PG8_STAGE(PG8_SB(1, 1), cB + hstep + kstep, voffB);
        PG8_WAIT_V(6); PG8_BAR;
    }
    for (;;) {
        const bool has_next = S.next(ui + 1, nxt);
        const char* nA = GATHER ? cA : (has_next ? (const char*)g.A + (size_t)nxt.pm * tstep : cA); const char* nB = has_next ? (const char*)g.Bt + (size_t)nxt.pn * tstep : cB;
        if constexpr (EpiStg<Epi>::N > 0) { if (has_next) { int l_ = lane; asm volatile("" : "+v"(l_));
            if (wid == 4) __builtin_amdgcn_global_load_lds((const unsigned*)E.stg_src0(nxt.pm, nxt.pn, l_), (PG8_LAS unsigned*)(size_t)(stga_ + (unsigned)((ui + 1) % 3) * 2048u), 16, 0, 0);
            else if (wid == 5) __builtin_amdgcn_global_load_lds((const unsigned*)E.stg_src1(nxt.pm, nxt.pn, l_), (PG8_LAS unsigned*)(size_t)(stga_ + (unsigned)((ui + 1) % 3) * 2048u + 1024u), 16, 0, 0); } }
        if constexpr (GATHER) { if (has_next) PG8_GFETCH((ui + 1) & 1, nxt.pm); }
        for (int t = 0; t < nt; t += 2) {
            const bool last = (t == nt - 2);
            const char* a1 = cA + (size_t)(t + 1) * kstep;
            const char* a2 = last ? nA : cA + (size_t)(t + 2) * kstep; const char* b2 = last ? nB : cB + (size_t)(t + 2) * kstep;
            const char* a3 = a2 + kstep; const char* b3 = b2 + kstep;
            if (last && has_next) S.a_ready(nxt);
            if constexpr (GATHER) { if (last && has_next) { PG8_GIDX((ui + 1) & 1, nvG); } }
            if constexpr (SP2) {
            PG8_LDB(B0, 0, 0); PG8_LDB(B1, 0, 1); PG8_SCHED; PG8_LDA(At, 0, 0); PG8_STAGE_A(PG8_SA(1, 1), 1, a1, false);
            PG8_WAIT_V(8); PG8_WAIT_L(0); PG8_BAR; if (ZC && t == 0) { PG8_MMAZ(0, 0, At, B0); PG8_MMAZ(0, 1, At, B1); } else { PG8_MMA(0, 0, At, B0); PG8_MMA(0, 1, At, B1); } PG8_BAR; PG8_SCHED;
            PG8_LDA(At, 0, 1); PG8_STAGE(PG8_SB(0, 0), b2, voffB); PG8_STAGE(PG8_SB(0, 1), b2 + hstep, voffB); PG8_STAGE_A(PG8_SA(0, 0), 0, a2, last);
            PG8_WAIT_V(8); PG8_WAIT_L(0); PG8_BAR; if (ZC && t == 0) { PG8_MMAZ(1, 0, At, B0); PG8_MMAZ(1, 1, At, B1); } else { PG8_MMA(1, 0, At, B0); PG8_MMA(1, 1, At, B1); } PG8_BAR; PG8_SCHED;
            PG8_LDB(B0, 1, 0); PG8_LDB(B1, 1, 1); PG8_SCHED; PG8_LDA(At, 1, 0); PG8_STAGE_A(PG8_SA(0, 1), 1, a2, last);
            PG8_WAIT_V(8); PG8_WAIT_L(0); PG8_BAR; PG8_MMA(0, 0, At, B0); PG8_MMA(0, 1, At, B1); PG8_BAR; PG8_SCHED;
            PG8_LDA(At, 1, 1); PG8_STAGE(PG8_SB(1, 0), b3, voffB); PG8_STAGE(PG8_SB(1, 1), b3 + hstep, voffB); PG8_STAGE_A(PG8_SA(1, 0), 0, a3, last);
            PG8_WAIT_V(8); PG8_WAIT_L(0); PG8_BAR; PG8_MMA(1, 0, At, B0); PG8_MMA(1, 1, At, B1); PG8_BAR; PG8_SCHED;
            } else {
            PG8_LDB(B0, 0, 0); PG8_SCHED; PG8_LDA(At, 0, 0); PG8_STAGE(PG8_SA(1, 1), a1 + hstep, voffA);
            PG8_WAIT_L(8); PG8_BAR; PG8_WAIT_L(0); PG8_MMA(0, 0, At, B0); PG8_BAR; PG8_SCHED;
            PG8_LDB(B1, 0, 1); PG8_STAGE(PG8_SB(0, 0), b2, voffB);
            PG8_BAR; PG8_WAIT_L(0); PG8_MMA(0, 1, At, B1); PG8_BAR;
            PG8_LDA(At, 0, 1); PG8_STAGE(PG8_SA(0, 0), a2, voffA);
            PG8_BAR; PG8_WAIT_L(0); PG8_MMA(1, 0, At, B0); PG8_BAR; PG8_SCHED;
            PG8_STAGE(PG8_SB(0, 1), b2 + hstep, voffB);
            PG8_WAIT_V(6); PG8_BAR; PG8_MMA(1, 1, At, B1); PG8_BAR;
            PG8_LDB(B0, 1, 0); PG8_SCHED; PG8_LDA(At, 1, 0); PG8_STAGE(PG8_SA(0, 1), a2 + hstep, voffA);
            PG8_WAIT_L(8); PG8_BAR; PG8_WAIT_L(0); PG8_MMA(0, 0, At, B0); PG8_BAR; PG8_SCHED;
            PG8_LDB(B1, 1, 1); PG8_STAGE(PG8_SB(1, 0), b3, voffB);
            PG8_BAR; PG8_WAIT_L(0); PG8_MMA(0, 1, At, B1); PG8_BAR;
            PG8_LDA(At, 1, 1); PG8_STAGE(PG8_SA(1, 0), a3, voffA);
            PG8_BAR; PG8_WAIT_L(0); PG8_MMA(1, 0, At, B0); PG8_BAR; PG8_SCHED;
            PG8_STAGE(PG8_SB(1, 1), b3 + hstep, voffB);
            PG8_WAIT_V(6); PG8_BAR; PG8_MMA(1, 1, At, B1); PG8_BAR;
            }
        }
        if constexpr (ALIGN_EPI) { if (wr == 0) PG8_BAR; }
        cur.aux = (int)(stga_ + (unsigned)(ui % 3) * 2048u);
        if constexpr (!Epi::AFTER_DRAIN) { int t2_ = threadIdx.x; asm volatile("" : "+v"(t2_)); E(acc, cur, wr, wc, t2_ & 15, (t2_ & 63) >> 4); S.done(cur); }
        if (!has_next) break;
#pragma unroll
        for (int a = 0; a < 2; ++a)
#pragma unroll
            for (int b = 0; b < 2; ++b)
#pragma unroll
                for (int m = 0; m < 4; ++m)
#pragma unroll
                    for (int n = 0; n < 2; ++n) { if constexpr (ZC) asm volatile("" : "=v"(acc[a][b][m][n]));
                        else { typedef unsigned long long u64x2_ __attribute__((ext_vector_type(2))); u64x2_ z_;
                            asm volatile("v_pk_mov_b32 %0, 0, 0" : "=v"(z_.x)); asm volatile("v_pk_mov_b32 %0, 0, 0" : "=v"(z_.y)); acc[a][b][m][n] = __builtin_bit_cast(acc_t, z_); } }
        cur = nxt; cA = nA; cB = nB; ++ui;
        if constexpr (GATHER) {
#pragma unroll
            for (int h_ = 0; h_ < 2; ++h_) { cvG[h_][0] = nvG[h_][0]; cvG[h_][1] = nvG[h_][1]; } }
        if constexpr (ALIGN_EPI) { if (wr == 1) PG8_BAR; }
    }
    PG8_WAIT_V(0);
    if constexpr (!ALIGN_EPI) { if (wr == 0) PG8_BAR; }
    PG8_BAR;
    if constexpr (Epi::AFTER_DRAIN) { E.fused(acc, cur, wr, wc, fr, fq, lds, wid, lane); S.done(cur); }
#undef PG8_SA
#undef PG8_SB
#undef PG8_STAGE
#undef PG8_STAGE_A
#undef PG8_GFETCH
#undef PG8_GIDX
#undef PG8_LDA
#undef PG8_LDB
#undef PG8_MMA
#undef PG8_WAIT_V
#undef PG8_WAIT_L
#undef PG8_BAR
#undef PG8_SCHED
}
}

namespace dattn {
using bf16x8 = __attribute__((ext_vector_type(8))) short;
using s16x4  = __attribute__((ext_vector_type(4))) short;
using f32x16 = __attribute__((ext_vector_type(16))) float;
using u32x4  = __attribute__((ext_vector_type(4))) unsigned;
typedef unsigned short bf16_t;
constexpr int NW = 8, QBLK = 32, KVBLK = 64, LD = 1024;
constexpr int SHM_V = KVBLK * 128 * 2, SHM_K = KVBLK * 64 * 2, NBUF = 3, SHM_BYTES = NBUF * (SHM_V + SHM_K) + NW * 64 * 4;
constexpr float THRL = 8.f;
#define DA_KSWZ(row, colB) ((row) * 128 + ((colB) ^ ((((row) >> 1) & 7) << 4)))
#define DA_SBAR() __builtin_amdgcn_sched_barrier(0)
__device__ __forceinline__ int crow(int r, int hi) { return (r & 3) + 8 * (r >> 2) + 4 * hi; }
__device__ __forceinline__ unsigned cvtpk(float lo, float hi) { unsigned r; asm volatile("v_cvt_pk_bf16_f32 %0, %1, %2" : "=v"(r) : "v"(lo), "v"(hi)); return r; }

__device__ __forceinline__ void partialSM(f32x16& p0, f32x16& p1, float& m_reg, float& mn, float& alpha) {
  float pmax = p0[0];
#pragma unroll
  for (int r = 1; r < 16; ++r) pmax = fmaxf(pmax, p0[r]);
#pragma unroll
  for (int r = 0; r < 16; ++r) pmax = fmaxf(pmax, p1[r]);
  { auto rr = __builtin_amdgcn_permlane32_swap(__float_as_uint(pmax), __float_as_uint(pmax), false, false);
    pmax = fmaxf(__uint_as_float(rr[0]), __uint_as_float(rr[1])); }
  if (__builtin_expect(__all(pmax - m_reg <= THRL), 1)) { mn = m_reg; alpha = 1.f; }
  else { mn = fmaxf(m_reg, pmax); alpha = __builtin_amdgcn_exp2f(m_reg - mn); m_reg = mn; }
#pragma unroll
  for (int r = 0; r < 16; ++r) p0[r] = p0[r] - mn;
#pragma unroll
  for (int r = 0; r < 16; ++r) p1[r] = p1[r] - mn;
#pragma unroll
  for (int r = 0; r < 16; ++r) p0[r] = __builtin_amdgcn_exp2f(p0[r]);
}
__device__ __forceinline__ void finishSM(f32x16& p0, f32x16& p1, float alpha, float& l_reg, bf16x8& pa0, bf16x8& pa1, bf16x8& pa2, bf16x8& pa3) {
#pragma unroll
  for (int r = 0; r < 16; ++r) p1[r] = __builtin_amdgcn_exp2f(p1[r]);
  float ps = 0;
#pragma unroll
  for (int r = 0; r < 16; ++r) ps += p0[r];
#pragma unroll
  for (int r = 0; r < 16; ++r) ps += p1[r];
  { auto rr = __builtin_amdgcn_permlane32_swap(__float_as_uint(ps), __float_as_uint(ps), false, false);
    ps = __uint_as_float(rr[0]) + __uint_as_float(rr[1]); }
  l_reg = l_reg * alpha + ps;
#define DA_PK4(P, BASE, OUT) do { unsigned a0 = cvtpk(P[BASE + 0], P[BASE + 1]), a1 = cvtpk(P[BASE + 2], P[BASE + 3]);   \
    unsigned b0 = cvtpk(P[BASE + 4], P[BASE + 5]), b1 = cvtpk(P[BASE + 6], P[BASE + 7]);                              \
    auto r0 = __builtin_amdgcn_permlane32_swap(a0, b0, false, false); auto r1 = __builtin_amdgcn_permlane32_swap(a1, b1, false, false); \
    u32x4 w = {r0[0], r1[0], r0[1], r1[1]}; OUT = *reinterpret_cast<bf16x8*>(&w); } while (0)
  DA_PK4(p0, 0, pa0); DA_PK4(p0, 8, pa1); DA_PK4(p1, 0, pa2); DA_PK4(p1, 8, pa3);
#undef DA_PK4
}
__device__ __forceinline__ void qkt(f32x16& p0, f32x16& p1, const char* Ks, const bf16x8* qr, int r32, int hi) {
  p0 = f32x16{}; p1 = f32x16{};
#pragma unroll
  for (int d0 = 0; d0 < 4; ++d0) { const int cb = (d0 * 16 + hi * 8) * 2;
    const bf16x8 b0 = *reinterpret_cast<const bf16x8*>(Ks + DA_KSWZ(r32, cb));
    const bf16x8 b1 = *reinterpret_cast<const bf16x8*>(Ks + DA_KSWZ(32 + r32, cb));
    p0 = __builtin_amdgcn_mfma_f32_32x32x16_bf16(b0, qr[d0], p0, 0, 0, 0);
    p1 = __builtin_amdgcn_mfma_f32_32x32x16_bf16(b1, qr[d0], p1, 0, 0, 0); }
}
__device__ __forceinline__ int v_st(int k, int c) { const int kk = (k & ~0xC) | ((k & 4) << 1) | ((k & 8) >> 1); return ((kk >> 3) * 4 + (c >> 5)) * 512 + ((kk & 7) * 32 + (c & 31)) * 2; }
__device__ __forceinline__ int v_rd_base(int lane) { return ((lane & 3) << 3) | (((lane >> 2) & 3) << 6) | (((lane >> 4) & 1) << 5) | (((lane >> 5) & 1) << 8); }
constexpr int v_rd_off(int d0, int ks, int half) { return d0 * 512 + ks * 4096 + half * 2048; }
template <int OFF> __device__ __forceinline__ s16x4 tr_read(int vb) { s16x4 r; asm volatile("ds_read_b64_tr_b16 %0, %1 offset:%2" : "=&v"(r) : "v"(vb), "i"(OFF) : "memory"); return r; }
template <int KS> __device__ __forceinline__ void pv_ks(f32x16* o, int vb, bf16x8 pa) {
  s16x4 l0 = tr_read<v_rd_off(0, KS, 0)>(vb), h0 = tr_read<v_rd_off(0, KS, 1)>(vb), l1 = tr_read<v_rd_off(1, KS, 0)>(vb), h1 = tr_read<v_rd_off(1, KS, 1)>(vb);
  s16x4 l2 = tr_read<v_rd_off(2, KS, 0)>(vb), h2 = tr_read<v_rd_off(2, KS, 1)>(vb), l3 = tr_read<v_rd_off(3, KS, 0)>(vb), h3 = tr_read<v_rd_off(3, KS, 1)>(vb);
  asm volatile("s_waitcnt lgkmcnt(0)" : "+v"(l0), "+v"(h0), "+v"(l1), "+v"(h1), "+v"(l2), "+v"(h2), "+v"(l3), "+v"(h3) :: "memory");
#define DA_PK(L, H) (bf16x8){L[0], L[1], L[2], L[3], H[0], H[1], H[2], H[3]}
  o[0] = __builtin_amdgcn_mfma_f32_32x32x16_bf16(pa, DA_PK(l0, h0), o[0], 0, 0, 0);
  o[1] = __builtin_amdgcn_mfma_f32_32x32x16_bf16(pa, DA_PK(l1, h1), o[1], 0, 0, 0);
  o[2] = __builtin_amdgcn_mfma_f32_32x32x16_bf16(pa, DA_PK(l2, h2), o[2], 0, 0, 0);
  o[3] = __builtin_amdgcn_mfma_f32_32x32x16_bf16(pa, DA_PK(l3, h3), o[3], 0, 0, 0);
#undef DA_PK
}
__device__ __forceinline__ void pv_d0(f32x16* o, int vb, bf16x8 pa0, bf16x8 pa1, bf16x8 pa2, bf16x8 pa3) {
  pv_ks<0>(o, vb, pa0); pv_ks<1>(o, vb, pa1); pv_ks<2>(o, vb, pa2); pv_ks<3>(o, vb, pa3);
}
__device__ __forceinline__ void unit(const bf16_t* __restrict__ Qb, const bf16_t* __restrict__ Kh, const bf16_t* __restrict__ Vh, bf16_t* __restrict__ Ob, int seq, char* lds) {
  int tid_o = threadIdx.x; asm volatile("" : "+v"(tid_o));
  const int tid = tid_o, wid = tid >> 6, lane = tid & 63, r32 = lane & 31, hi = lane >> 5;
  char* V_lds = lds; char* K_lds = lds + NBUF * SHM_V;
  float* ws = (float*)(lds + NBUF * (SHM_V + SHM_K)) + wid * 64; float* li_l = ws; float* al_l = ws + 32;
  float m_reg = -1e30f, l_reg = 0; f32x16 o[4] = {}; bf16x8 qr[4];
  const bf16_t* Qw = Qb + (long)(wid * QBLK + r32) * LD + hi * 8;
#pragma unroll
  for (int d0 = 0; d0 < 4; ++d0) qr[d0] = *reinterpret_cast<const bf16x8*>(Qw + d0 * 16);
  const int sr = tid >> 4, sc = (tid & 15) * 8, vst0 = v_st(sr, sc), vst1 = v_st(32 + sr, sc);
  const int kr = tid >> 3, kc = (tid & 7) * 8, kst = DA_KSWZ(kr, kc * 2);
  const int vb0 = (int)(uintptr_t)V_lds + v_rd_base(lane);
  struct { bf16x8 vs0, vs1, ks0; } sr_[2];
#define DA_SLOAD(i, k0) do { sr_[i].vs0 = *reinterpret_cast<const bf16x8*>(&Vh[(long)((k0) + sr) * LD + sc]); sr_[i].vs1 = *reinterpret_cast<const bf16x8*>(&Vh[(long)((k0) + 32 + sr) * LD + sc]); \
    sr_[i].ks0 = *reinterpret_cast<const bf16x8*>(&Kh[(long)((k0) + kr) * LD + kc]); } while (0)
#define DA_SWRITE(b, i) do { *(bf16x8*)(V_lds + (b) * SHM_V + vst0) = sr_[i].vs0; *(bf16x8*)(V_lds + (b) * SHM_V + vst1) = sr_[i].vs1; *(bf16x8*)(K_lds + (b) * SHM_K + kst) = sr_[i].ks0; } while (0)
#define DA_SWAIT() asm volatile("s_waitcnt vmcnt(3)" ::: "memory")
#define DA_RESC(a) do { if (__any((a) < 1.f)) { if (hi == 0) al_l[r32] = (a); asm volatile("s_waitcnt lgkmcnt(0)" ::: "memory"); \
    _Pragma("unroll") for (int d = 0; d < 4; ++d) _Pragma("unroll") for (int r = 0; r < 16; ++r) o[d][r] *= al_l[crow(r, hi)]; } } while (0)
  f32x16 pA0, pA1, pB0, pB1; float mnA, mnB, alA, alB; bf16x8 pa0, pa1, pa2, pa3; const int NT = seq / KVBLK;
  constexpr int SE = 0, SO = 1;
  DA_SLOAD(SE, 0); asm volatile("s_waitcnt vmcnt(0)" ::: "memory"); DA_SWRITE(0, SE); __syncthreads();
  qkt(pA0, pA1, K_lds, qr, r32, hi); partialSM(pA0, pA1, m_reg, mnA, alA);
  DA_SLOAD(SO, KVBLK); if (2 < NT) DA_SLOAD(SE, 2 * KVBLK);
  DA_SWAIT(); DA_SWRITE(1, SO); __syncthreads();
  int prv = 0, cur = 1, nxt = 2;
#define DA_ROT() do { const int t_ = prv; prv = cur; cur = nxt; nxt = t_; } while (0)
  for (int j = 1; j + 1 < NT; j += 2) {
    DA_SBAR(); qkt(pB0, pB1, K_lds + cur * SHM_K, qr, r32, hi);
    finishSM(pA0, pA1, alA, l_reg, pa0, pa1, pa2, pa3); DA_SBAR();
    DA_SLOAD(SO, (j + 2) * KVBLK); DA_SBAR();
    pv_d0(o, vb0 + prv * SHM_V, pa0, pa1, pa2, pa3); partialSM(pB0, pB1, m_reg, mnB, alB);
    DA_SWAIT(); DA_SWRITE(nxt, SE);
    DA_RESC(alB); __syncthreads(); DA_ROT();
    DA_SBAR(); qkt(pA0, pA1, K_lds + cur * SHM_K, qr, r32, hi);
    finishSM(pB0, pB1, alB, l_reg, pa0, pa1, pa2, pa3); DA_SBAR();
    if (j + 3 < NT) DA_SLOAD(SE, (j + 3) * KVBLK); DA_SBAR();
    pv_d0(o, vb0 + prv * SHM_V, pa0, pa1, pa2, pa3); partialSM(pA0, pA1, m_reg, mnA, alA);
    DA_SWAIT(); DA_SWRITE(nxt, SO);
    DA_RESC(alA); __syncthreads(); DA_ROT();
  }
  DA_SBAR(); qkt(pB0, pB1, K_lds + cur * SHM_K, qr, r32, hi);
  finishSM(pA0, pA1, alA, l_reg, pa0, pa1, pa2, pa3); DA_SBAR();
  pv_d0(o, vb0 + prv * SHM_V, pa0, pa1, pa2, pa3); partialSM(pB0, pB1, m_reg, mnB, alB);
  DA_RESC(alB);
  finishSM(pB0, pB1, alB, l_reg, pa0, pa1, pa2, pa3); DA_SBAR();
  pv_d0(o, vb0 + cur * SHM_V, pa0, pa1, pa2, pa3);
#undef DA_ROT
  if (hi == 0) li_l[r32] = l_reg; asm volatile("s_waitcnt lgkmcnt(0)" ::: "memory");
  float rli[16];
#pragma unroll
  for (int r = 0; r < 16; ++r) rli[r] = __builtin_amdgcn_rcpf(li_l[crow(r, hi)]);
  bf16_t* Ow = Ob + (long)(wid * QBLK) * LD;
#pragma unroll
  for (int r = 0; r < 16; ++r) { const int orow = crow(r, hi);
#pragma unroll
    for (int d0 = 0; d0 < 4; d0 += 2) { const unsigned w = cvtpk(o[d0][r] * rli[r], o[d0 + 1][r] * rli[r]);
      Ow[(long)orow * LD + d0 * 32 + r32] = (bf16_t)(w & 0xffffu); Ow[(long)orow * LD + (d0 + 1) * 32 + r32] = (bf16_t)(w >> 16); } }
  __syncthreads();
#undef DA_SLOAD
#undef DA_SWRITE
#undef DA_SWAIT
#undef DA_RESC
}
#undef DA_KSWZ
#undef DA_SBAR
}

#include <hip/hip_bf16.h>
#include <cmath>
namespace hattn {
using bf16=__hip_bfloat16;
using bf16x8=__attribute__((ext_vector_type(8)))short;
using s16x4=__attribute__((ext_vector_type(4)))short;
using f32x16=__attribute__((ext_vector_type(16)))float;
using u32x4=__attribute__((ext_vector_type(4)))unsigned;
constexpr int BATCH=2,NHEAD=16,SEQ=8192,D=64,DM=NHEAD*D;
constexpr int NW=8,QBLK=32,QB=QBLK*NW,KVBLK=64,NQB=SEQ/QB;
constexpr int ATTN_PITCH=DM, ATTN_UNIT_ROWS=QB;
__device__ __forceinline__ int crow(int r,int hi){return (r&3)+8*(r>>2)+4*hi;}
#define SBAR() __builtin_amdgcn_sched_barrier(0)
__device__ __forceinline__ void cmask(f32x16&p0,f32x16&p1,int jb,int qrel,int hi){
  const float NEG=-INFINITY; int kb=64*jb+4*hi;
  #pragma unroll
  for(int r=0;r<16;++r){int kv=kb+(r&3)+8*(r>>2); if(kv>qrel)p0[r]=NEG; if(kv+32>qrel)p1[r]=NEG;}
}

constexpr int NSLOT=3, SLOTB=8192;
constexpr int LDS_K=0, LDS_V=NSLOT*SLOTB, LDS_WS=LDS_V+NSLOT*2*SLOTB, LDS_OST=LDS_WS+NW*64*4, LDS_BYTES=LDS_OST+NW*4096;
constexpr float C2=0.125f*1.4426950408889634f;
__device__ __forceinline__ void glds16(const void*gsrc,unsigned lds_dst){unsigned keep;
  asm volatile("s_mov_b32 %0, m0\n\ts_mov_b32 m0, %2\n\ts_nop 0\n\tglobal_load_lds_dwordx4 %1, off\n\ts_mov_b32 m0, %0":"=&s"(keep):"v"(gsrc),"s"(lds_dst):"memory");}
__device__ __forceinline__ float max3f(float a,float b,float c){float r;asm("v_max3_f32 %0, %1, %2, %3":"=v"(r):"v"(a),"v"(b),"v"(c));return r;}
__device__ __forceinline__ float max2f(float a,float b){float r;asm("v_max_f32_e32 %0, %1, %2":"=v"(r):"v"(a),"v"(b));return r;}
__device__ __forceinline__ float fadd_s(float a,float b){float r;asm("v_add_f32_e32 %0, %1, %2":"=v"(r):"v"(a),"v"(b));return r;}
__device__ __forceinline__ float fsub_s(float a,float b){float r;asm("v_sub_f32_e32 %0, %1, %2":"=v"(r):"v"(a),"v"(b));return r;}
typedef float f32x2_t __attribute__((ext_vector_type(2))); typedef __bf16 bf16x2_t __attribute__((ext_vector_type(2)));
__device__ __forceinline__ unsigned cvtpk_s(float lo,float hi){f32x2_t v={lo,hi};bf16x2_t b=__builtin_convertvector(v,bf16x2_t);return __builtin_bit_cast(unsigned,b);}
#define WAIT_BAR(N) asm volatile("s_waitcnt vmcnt(" #N ") lgkmcnt(0)\n\ts_barrier":::"memory")

__device__ __forceinline__ void qkt(f32x16&p0,f32x16&p1,const char*Kslot,const bf16x8*qr,const f32x16&negm,int r32,int hi){
  const char*kb=Kslot+hi*1024+r32*16;
  #pragma unroll
  for(int d0=0;d0<4;++d0){
    const bf16x8 b0=*reinterpret_cast<const bf16x8*>(kb+d0*2048);
    const bf16x8 b1=*reinterpret_cast<const bf16x8*>(kb+d0*2048+512);
    if(d0==0){p0=__builtin_amdgcn_mfma_f32_32x32x16_bf16(b0,qr[0],negm,0,0,0);p1=__builtin_amdgcn_mfma_f32_32x32x16_bf16(b1,qr[0],negm,0,0,0);}
    else{p0=__builtin_amdgcn_mfma_f32_32x32x16_bf16(b0,qr[d0],p0,0,0,0);p1=__builtin_amdgcn_mfma_f32_32x32x16_bf16(b1,qr[d0],p1,0,0,0);}}
}
typedef __attribute__((address_space(3))) const char* lds_cptr;
typedef short v4i16_t __attribute__((ext_vector_type(4)));
__device__ __forceinline__ void kload8(bf16x8*kf,lds_cptr kp){
  kf[0]=*(const __attribute__((address_space(3))) bf16x8*)(kp);      kf[1]=*(const __attribute__((address_space(3))) bf16x8*)(kp+512);
  kf[2]=*(const __attribute__((address_space(3))) bf16x8*)(kp+2048); kf[3]=*(const __attribute__((address_space(3))) bf16x8*)(kp+2560);
  kf[4]=*(const __attribute__((address_space(3))) bf16x8*)(kp+4096); kf[5]=*(const __attribute__((address_space(3))) bf16x8*)(kp+4608);
  kf[6]=*(const __attribute__((address_space(3))) bf16x8*)(kp+6144); kf[7]=*(const __attribute__((address_space(3))) bf16x8*)(kp+6656);
}
__device__ __forceinline__ void kload2(bf16x8*kf,lds_cptr kp,int j){ kf[2*j]=*(const __attribute__((address_space(3))) bf16x8*)(kp+j*2048); kf[2*j+1]=*(const __attribute__((address_space(3))) bf16x8*)(kp+j*2048+512); }
__device__ __forceinline__ s16x4 vtr(lds_cptr p){ return __builtin_bit_cast(s16x4,__builtin_amdgcn_ds_read_tr16_b64_v4i16((__attribute__((address_space(3))) v4i16_t*)p)); }
__device__ __forceinline__ float rowmax(const f32x16&p0,const f32x16&p1){
  float a=max3f(p0[0],p0[1],p1[0]),b=max3f(p0[2],p0[3],p1[1]);a=max3f(a,p1[2],p1[3]);
  #pragma unroll
  for(int r=4;r<16;r+=4){a=max3f(a,p0[r],p0[r+1]);b=max3f(b,p0[r+2],p0[r+3]);a=max3f(a,p1[r],p1[r+1]);b=max3f(b,p1[r+2],p1[r+3]);}
  const float m=max2f(a,b);
  auto rr=__builtin_amdgcn_permlane32_swap(__float_as_uint(m),__float_as_uint(m),false,false);
  return max2f(__uint_as_float(rr[0]),__uint_as_float(rr[1]));
}
__device__ __forceinline__ void pv(f32x16*o,int vb,bf16x8 pa0,bf16x8 pa1,bf16x8 pa2,bf16x8 pa3){
  #pragma unroll
  for(int d0=0;d0<4;++d0){s16x4 lo[4],hi[4];
    #pragma unroll
    for(int ks=0;ks<4;++ks){
      asm volatile("ds_read_b64_tr_b16 %0,%1 offset:%c2":"=&v"(lo[ks]):"v"(vb),"i"(d0*4096+ks*1024):"memory");
      asm volatile("ds_read_b64_tr_b16 %0,%1 offset:%c2":"=&v"(hi[ks]):"v"(vb),"i"(d0*4096+ks*1024+512):"memory");}
    asm volatile("s_waitcnt lgkmcnt(0)":::"memory");SBAR();
    #define PK(k) (bf16x8){lo[k][0],lo[k][1],lo[k][2],lo[k][3],hi[k][0],hi[k][1],hi[k][2],hi[k][3]}
    o[d0]=__builtin_amdgcn_mfma_f32_32x32x16_bf16(pa0,PK(0),o[d0],0,0,0);
    o[d0]=__builtin_amdgcn_mfma_f32_32x32x16_bf16(pa1,PK(1),o[d0],0,0,0);
    o[d0]=__builtin_amdgcn_mfma_f32_32x32x16_bf16(pa2,PK(2),o[d0],0,0,0);
    o[d0]=__builtin_amdgcn_mfma_f32_32x32x16_bf16(pa3,PK(3),o[d0],0,0,0);
    #undef PK
  }
}

#ifndef ATTN_STORE16
#define ATTN_STORE16(p,v) (*(u32x4*)(p)=(v))
#endif
template<int THRL,bool FAST=false> __device__ __forceinline__ bool attn_unit(long qrow0,long krow0,int NT,int hq,int vcol,const bf16*Q,const bf16*__restrict__ K,const bf16*__restrict__ V,bf16*O,char*shm,
    int fuse=0,float lam=0.f,const float*sgp=nullptr,float gfac=0.f,unsigned char*MIXp=nullptr){
  int tid_o=threadIdx.x; asm volatile("":"+v"(tid_o));
  const int tid=tid_o,lane=tid&63,r32=lane&31,hi=lane>>5; const int wid=__builtin_amdgcn_readfirstlane(tid>>6);
  const bf16*Qw=Q+(qrow0+wid*QBLK)*DM+hq*D;
  const bf16*Kh=K+krow0*DM+hq*D,*Vh=V+krow0*DM+vcol;
  const unsigned lds0=(unsigned)(uintptr_t)shm;
  float*wsf=(float*)(shm+LDS_WS)+wid*64;
  const bf16*ksrc=Kh+(long)lane*DM+wid*8;
  const bf16*vsrc=Vh+(long)(16*(wid&3)+(lane>>2))*DM+(wid>>2)*32+(lane&3)*8;
  const unsigned kdst=lds0+LDS_K+wid*1024, vdst=lds0+LDS_V+wid*1024;
  #define DMA_K(t,slot) glds16(ksrc+(long)(t)*KVBLK*DM,(unsigned)__builtin_amdgcn_readfirstlane(kdst+(slot)))
  #define DMA_V(t,slot) do{ glds16(vsrc+(long)(t)*KVBLK*DM,(unsigned)__builtin_amdgcn_readfirstlane(vdst+2*(slot))); glds16(vsrc+64+(long)(t)*KVBLK*DM,(unsigned)__builtin_amdgcn_readfirstlane(vdst+8192+2*(slot))); }while(0)
  const int vb0=(int)(lds0+LDS_V)+((lane>>4)&1)*32+(lane&3)*8+(4*hi+((lane&15)>>2))*64;
  const char*Kbase=shm+LDS_K; bf16x8 kf[8];
  const lds_cptr shm3=(lds_cptr)shm; const lds_cptr kp0=shm3+LDS_K+hi*1024+r32*16; const lds_cptr vp0=shm3+LDS_V+((lane>>4)&1)*32+(lane&3)*8+(4*hi+((lane&15)>>2))*64;
  DMA_K(0,0);DMA_V(0,0);DMA_K(1,SLOTB);
  bf16x8 qr[4];
  #pragma unroll
  for(int d0=0;d0<4;++d0)qr[d0]=*reinterpret_cast<const bf16x8*>(&Qw[(long)r32*DM+d0*16+hi*8]);
  float mhat=0.f,l_reg=0.f;f32x16 o[4];
  { typedef unsigned long long u64x8_ __attribute__((ext_vector_type(8)));
    _Pragma("unroll") for(int i_=0;i_<4;++i_){ u64x8_ z_; _Pragma("unroll") for(int j_=0;j_<8;++j_){ unsigned long long t_; asm volatile("v_pk_mov_b32 %0, 0, 0":"=v"(t_)); z_[j_]=t_; } o[i_]=__builtin_bit_cast(f32x16,z_); } }
  #define CMASK(P0,P1,t) do{}while(0)
  bool resc=false;
  #define START(P0,P1) do{ resc=false; if constexpr(!FAST){ const float rm=rowmax(P0,P1); \
    { const float dl=rm; mhat=fadd_s(mhat,dl); \
      _Pragma("unroll") for(int r=0;r<16;++r){P0[r]=fsub_s(P0[r],dl);P1[r]=fsub_s(P1[r],dl);} } } \
    _Pragma("unroll") for(int r=0;r<16;++r)P0[r]=__builtin_amdgcn_exp2f(P0[r]); }while(0)
  #define RESC() do{ if constexpr(!FAST){ if(resc){ asm volatile("s_waitcnt lgkmcnt(0)":::"memory"); \
      _Pragma("unroll") for(int d_=0;d_<4;++d_) _Pragma("unroll") for(int r=0;r<16;++r)o[d_][r]*=wsf[crow(r,hi)]; } } }while(0)
  f32x16 pA0,pA1,pB0,pB1;
  int sl_prev=0,sl_cur=0,sl_next=SLOTB;
  #define ROT() do{sl_prev=sl_cur;sl_cur=sl_next;sl_next=(sl_next==(NSLOT-1)*SLOTB)?0:sl_next+SLOTB;}while(0)
  DMA_K(2,2*SLOTB);
  WAIT_BAR(3);
  { const f32x16 zz=f32x16{}; qkt(pA0,pA1,Kbase,qr,zz,r32,hi); }asm volatile("s_nop 15\n\ts_nop 7":"+v"(pA0),"+v"(pA1));CMASK(pA0,pA1,0);
  START(pA0,pA1);
  _Pragma("unroll") for(int r=0;r<16;++r)pA1[r]=__builtin_amdgcn_exp2f(pA1[r]);
  WAIT_BAR(0);
  DMA_K(3,0);DMA_V(1,SLOTB);
  ROT();
  kload8(kf,kp0+sl_cur);
  WAIT_BAR(3);
  s16x4 vlo[8],vhi[8]; u32x4 pw0,pw1,pw2,pw3;
  #define PKW(P,B) cvtpk_s(P[B],P[B+1])
  #define PAF(k) __builtin_bit_cast(bf16x8,pw##k)
  #define VFR(i) (bf16x8){vlo[i][0],vlo[i][1],vlo[i][2],vlo[i][3],vhi[i][0],vhi[i][1],vhi[i][2],vhi[i][3]}
  #define PIN(x) asm volatile("":"+v"(x))
  #define MX3(a,b,c) __builtin_fmaxf(__builtin_fmaxf((a),(b)),(c))
  #define GAPA(MF,A0,A1,A2,A3,W0,W1,PW) do{ MF; sacc+=A0; sacc+=A1; sacc+=A2; sacc+=A3; PIN(sacc); W0; W1; PIN(PW); SBAR(); }while(0)
  #define EX(v) __builtin_amdgcn_exp2f(v)
  #define GAPB(MF,X,B) do{ MF; X[B]=EX(X[B]); X[B+1]=EX(X[B+1]); X[B+2]=EX(X[B+2]); X[B+3]=EX(X[B+3]); PIN(X); SBAR(); }while(0)
  #define VRD(i) do{ vlo[i]=vtr(vp_+(((i)>>2)*4096+((i)&3)*1024)); vhi[i]=vtr(vp_+(((i)>>2)*4096+((i)&3)*1024+512)); }while(0)
  #define KRD(G,j) do{ if(G){ kload2(kf,kp0+sl_next,j); SBAR(); } }while(0)
  #define GAPB2(MF,X,B) do{ MF; if constexpr(FAST){ X[B]=EX(X[B]); X[B+1]=EX(X[B+1]); } else { X[B]=EX(X[B]-mhat); X[B+1]=EX(X[B+1]-mhat); } PIN(X); SBAR(); }while(0)
  #define VRD2(i) do{ vlo[i]=vtr(vp_+8192+(((i)>>2)*4096+((i)&3)*1024)); vhi[i]=vtr(vp_+8192+(((i)>>2)*4096+((i)&3)*1024+512)); SBAR(); }while(0)
  #define STEP(C0,C1,P0,P1,t,GK,GV,GL) do{ SBAR(); \
    const lds_cptr vp_=vp0+2*sl_prev; \
    VRD(0); SBAR(); float sacc=(P0[0]+P0[1]); \
    GAPA(C0=__builtin_amdgcn_mfma_f32_32x32x16_bf16(kf[0],qr[0],f32x16{},0,0,0), P0[2],P0[3],P0[4],P0[5],     pw0[0]=PKW(P0,0), pw0[1]=PKW(P0,2), pw0); \
    VRD(4); SBAR(); GAPA(C1=__builtin_amdgcn_mfma_f32_32x32x16_bf16(kf[1],qr[0],f32x16{},0,0,0), P0[6],P0[7],P0[8],P0[9],     pw0[2]=PKW(P0,4), pw0[3]=PKW(P0,6), pw0); \
    VRD(1); SBAR(); GAPA(C0=__builtin_amdgcn_mfma_f32_32x32x16_bf16(kf[2],qr[1],C0,0,0,0),   P0[10],P0[11],P0[12],P0[13], pw1[0]=PKW(P0,8), pw1[1]=PKW(P0,10), pw1); \
    VRD(5); SBAR(); GAPA(C1=__builtin_amdgcn_mfma_f32_32x32x16_bf16(kf[3],qr[1],C1,0,0,0),   P0[14],P0[15],P1[0],P1[1],   pw1[2]=PKW(P0,12),pw1[3]=PKW(P0,14), pw1); \
    VRD(2); SBAR(); GAPA(C0=__builtin_amdgcn_mfma_f32_32x32x16_bf16(kf[4],qr[2],C0,0,0,0),   P1[2],P1[3],P1[4],P1[5],     pw2[0]=PKW(P1,0), pw2[1]=PKW(P1,2), pw2); \
    VRD(6); SBAR(); GAPA(C1=__builtin_amdgcn_mfma_f32_32x32x16_bf16(kf[5],qr[2],C1,0,0,0),   P1[6],P1[7],P1[8],P1[9],     pw2[2]=PKW(P1,4), pw2[3]=PKW(P1,6), pw2); \
    VRD(3); SBAR(); GAPA(C0=__builtin_amdgcn_mfma_f32_32x32x16_bf16(kf[6],qr[3],C0,0,0,0),   P1[10],P1[11],P1[12],P1[13], pw3[0]=PKW(P1,8), pw3[1]=PKW(P1,10), pw3); \
    VRD(7); SBAR(); GAPA(C1=__builtin_amdgcn_mfma_f32_32x32x16_bf16(kf[7],qr[3],C1,0,0,0),   P1[14],P1[15],0.f,0.f,       pw3[2]=PKW(P1,12),pw3[3]=PKW(P1,14), pw3); \
    l_reg+=sacc; \
    if(GK){DMA_K((t)+3,sl_cur);} if(GV){DMA_V((t)+1,sl_next);} \
    CMASK(C0,C1,t); \
    if constexpr(!FAST){ float a=MX3(C0[0],C0[1],C1[0]),b=MX3(C0[2],C0[3],C1[1]); a=MX3(a,C1[2],C1[3]); \
      _Pragma("unroll") for(int r=4;r<16;r+=4){a=MX3(a,C0[r],C0[r+1]);b=MX3(b,C0[r+2],C0[r+3]);a=MX3(a,C1[r],C1[r+1]);b=MX3(b,C1[r+2],C1[r+3]);} \
      float rm=__builtin_fmaxf(a,b); { auto rr=__builtin_amdgcn_permlane32_swap(__float_as_uint(rm),__float_as_uint(rm),false,false); rm=__builtin_fmaxf(__uint_as_float(rr[0]),__uint_as_float(rr[1])); } \
      resc=false; \
      if(__builtin_expect(__any(rm-mhat>(float)THRL),0)){ const float dl=__builtin_fmaxf(rm-mhat,0.f); mhat+=dl; \
        const float f=__builtin_amdgcn_exp2f(-dl); l_reg*=f; if(hi==0)wsf[r32]=f; resc=true; } } \
    SBAR(); \
    GAPB2(o[0]=__builtin_amdgcn_mfma_f32_32x32x16_bf16(PAF(0),VFR(0),o[0],0,0,0), C0,0); \
    GAPB2(o[1]=__builtin_amdgcn_mfma_f32_32x32x16_bf16(PAF(0),VFR(4),o[1],0,0,0), C0,2); \
    KRD(GL,0); GAPB2(o[0]=__builtin_amdgcn_mfma_f32_32x32x16_bf16(PAF(1),VFR(1),o[0],0,0,0), C0,4); VRD2(0); \
    KRD(GL,1); GAPB2(o[1]=__builtin_amdgcn_mfma_f32_32x32x16_bf16(PAF(1),VFR(5),o[1],0,0,0), C0,6); VRD2(4); \
    KRD(GL,2); GAPB2(o[0]=__builtin_amdgcn_mfma_f32_32x32x16_bf16(PAF(2),VFR(2),o[0],0,0,0), C0,8); VRD2(1); \
    KRD(GL,3); GAPB2(o[1]=__builtin_amdgcn_mfma_f32_32x32x16_bf16(PAF(2),VFR(6),o[1],0,0,0), C0,10); VRD2(5); \
    GAPB2(o[0]=__builtin_amdgcn_mfma_f32_32x32x16_bf16(PAF(3),VFR(3),o[0],0,0,0), C0,12); VRD2(2); \
    GAPB2(o[1]=__builtin_amdgcn_mfma_f32_32x32x16_bf16(PAF(3),VFR(7),o[1],0,0,0), C0,14); VRD2(6); \
    GAPB2(o[2]=__builtin_amdgcn_mfma_f32_32x32x16_bf16(PAF(0),VFR(0),o[2],0,0,0), C1,0); VRD2(3); \
    GAPB2(o[3]=__builtin_amdgcn_mfma_f32_32x32x16_bf16(PAF(0),VFR(4),o[3],0,0,0), C1,2); VRD2(7); \
    GAPB2(o[2]=__builtin_amdgcn_mfma_f32_32x32x16_bf16(PAF(1),VFR(1),o[2],0,0,0), C1,4); \
    GAPB2(o[3]=__builtin_amdgcn_mfma_f32_32x32x16_bf16(PAF(1),VFR(5),o[3],0,0,0), C1,6); \
    GAPB2(o[2]=__builtin_amdgcn_mfma_f32_32x32x16_bf16(PAF(2),VFR(2),o[2],0,0,0), C1,8); \
    GAPB2(o[3]=__builtin_amdgcn_mfma_f32_32x32x16_bf16(PAF(2),VFR(6),o[3],0,0,0), C1,10); \
    GAPB2(o[2]=__builtin_amdgcn_mfma_f32_32x32x16_bf16(PAF(3),VFR(3),o[2],0,0,0), C1,12); \
    GAPB2(o[3]=__builtin_amdgcn_mfma_f32_32x32x16_bf16(PAF(3),VFR(7),o[3],0,0,0), C1,14); \
    }while(0)
  int t=1;
  #undef CMASK
  #define CMASK(P0,P1,t) do{}while(0)
  for(;t+5<NT;t+=2){
    STEP(pB0,pB1,pA0,pA1,t,true,true,true);     WAIT_BAR(3); RESC(); ROT();
    STEP(pA0,pA1,pB0,pB1,t+1,true,true,true);   WAIT_BAR(3); RESC(); ROT();
  }
  #undef CMASK
  #define CMASK(P0,P1,t) do{}while(0)
  #define ENDW(tt) do{ if((tt)+3<NT){WAIT_BAR(3);} else if((tt)+2<NT){WAIT_BAR(2);} else {WAIT_BAR(0);} }while(0)
  for(;t+1<NT;t+=2){
    STEP(pB0,pB1,pA0,pA1,t,(t+3<NT),(t+1<NT),(t+1<NT));       ENDW(t);   RESC(); ROT();
    STEP(pA0,pA1,pB0,pB1,t+1,(t+4<NT),(t+2<NT),(t+2<NT));     ENDW(t+1); RESC(); ROT();
  }
  STEP(pB0,pB1,pA0,pA1,NT-1,false,false,false); RESC();
  { float sacc=pB0[0]+pB0[1]; _Pragma("unroll") for(int r=2;r<16;++r)sacc+=pB0[r]; _Pragma("unroll") for(int r=0;r<16;++r)sacc+=pB1[r]; l_reg+=sacc;
    pw0=(u32x4){PKW(pB0,0),PKW(pB0,2),PKW(pB0,4),PKW(pB0,6)};pw1=(u32x4){PKW(pB0,8),PKW(pB0,10),PKW(pB0,12),PKW(pB0,14)};pw2=(u32x4){PKW(pB1,0),PKW(pB1,2),PKW(pB1,4),PKW(pB1,6)};pw3=(u32x4){PKW(pB1,8),PKW(pB1,10),PKW(pB1,12),PKW(pB1,14)};
    SBAR(); pv(o,vb0+2*sl_cur,PAF(0),PAF(1),PAF(2),PAF(3)); }
  #undef PKW
  #undef PAF
  #undef VFR
  #undef PIN
  #undef MX3
  #undef GAPA
  #undef GAPB
  #undef EX
  #undef VRD
  #undef KRD
  #undef GAPB2
  #undef VRD2
  #undef STEP
  #undef ENDW
  {auto rr=__builtin_amdgcn_permlane32_swap(__float_as_uint(l_reg),__float_as_uint(l_reg),false,false);l_reg=__uint_as_float(rr[0])+__uint_as_float(rr[1]);}
  if constexpr(FAST){
    #ifdef ATTN_FORCE_RERUN
    const bool bad_=true;
    #else
    const bool bad_=!(l_reg>1e-30f&&l_reg<1e30f);
    #endif
    int*flg=(int*)(shm+LDS_OST); const int bw=__any(bad_)?1:0; if(lane==0)flg[wid*1024]=bw;
    asm volatile("s_waitcnt lgkmcnt(0)\n\ts_barrier":::"memory");
    const int anyb=__any(flg[(lane&7)*1024]!=0);
    asm volatile("s_waitcnt lgkmcnt(0)\n\ts_barrier":::"memory");
    if(anyb)return true;
  }
  if(hi==0)wsf[32+r32]=l_reg;asm volatile("s_waitcnt lgkmcnt(0)":::"memory");
  float rli[16];
  #pragma unroll
  for(int r=0;r<16;++r)rli[r]=__builtin_amdgcn_rcpf(wsf[32+crow(r,hi)]);
  bf16*Ow=O+(qrow0+wid*QBLK)*DM+vcol;
  if(fuse){ bf16*stg=(bf16*)(shm+LDS_OST)+wid*2048; unsigned char*Mw=MIXp+(qrow0+wid*QBLK)*DM+vcol;
    const int ch=lane&7; float dd[2][4][8]; float qs[4]={0.f,0.f,0.f,0.f};
    #pragma unroll
    for(int pss=0;pss<2;++pss){
      #pragma unroll
      for(int r=0;r<16;++r){const int orow=crow(r,hi);
        #pragma unroll
        for(int d0=0;d0<2;++d0)stg[orow*64+d0*32+r32]=__float2bfloat16(o[2*pss+d0][r]*rli[r]);}
      asm volatile("s_waitcnt lgkmcnt(0)":::"memory");
      #pragma unroll
      for(int i=0;i<4;++i){const int row=i*8+(lane>>3); const u32x4 vb_=*(const u32x4*)(stg+row*64+ch*8); const u32x4 va_=*(const u32x4*)(Ow+(long)row*DM+pss*64+ch*8);
        #pragma unroll
        for(int t=0;t<4;++t){ const float a0=__uint_as_float(va_[t]<<16),a1=__uint_as_float(va_[t]&0xffff0000u),b0=__uint_as_float(vb_[t]<<16),b1=__uint_as_float(vb_[t]&0xffff0000u);
          const float e0=a0-lam*b0,e1=a1-lam*b1; dd[pss][i][2*t]=e0; dd[pss][i][2*t+1]=e1; qs[i]+=e0*e0+e1*e1; } }
      asm volatile("s_waitcnt lgkmcnt(0)":::"memory"); }
    #pragma unroll
    for(int i=0;i<4;++i){ float q=qs[i];
      q+=__builtin_bit_cast(float,__builtin_amdgcn_update_dpp(0,__builtin_bit_cast(int,q),0xB1,0xF,0xF,true)); q+=__builtin_bit_cast(float,__builtin_amdgcn_update_dpp(0,__builtin_bit_cast(int,q),0x4E,0xF,0xF,true)); q+=__builtin_bit_cast(float,__builtin_amdgcn_update_dpp(0,__builtin_bit_cast(int,q),0x141,0xF,0xF,true));
      qs[i]=1.f/sqrtf(q*(1.f/128.f)+1e-5f); }
    #pragma unroll
    for(int pss=0;pss<2;++pss){ float gv[8];
      #pragma unroll
      for(int t=0;t<8;++t)gv[t]=sgp[pss*64+ch*8+t]*gfac;
      #pragma unroll
      for(int i=0;i<4;++i){const int row=i*8+(lane>>3); unsigned b_[8];
        #pragma unroll
        for(int t=0;t<8;++t)b_[t]=__float_as_uint(__builtin_amdgcn_fmed3f(dd[pss][i][t]*qs[i]*gv[t],-127.0f,127.0f)+12582912.0f);
        typedef unsigned u32x2_ __attribute__((ext_vector_type(2))); u32x2_ w;
        w.x=__builtin_amdgcn_perm(b_[1],b_[0],0x0c0c0400u)|(__builtin_amdgcn_perm(b_[3],b_[2],0x0c0c0400u)<<16);
        w.y=__builtin_amdgcn_perm(b_[5],b_[4],0x0c0c0400u)|(__builtin_amdgcn_perm(b_[7],b_[6],0x0c0c0400u)<<16);
        *(u32x2_*)(Mw+(long)row*DM+pss*64+ch*8)=w;} }
  } else
  { bf16*stg=(bf16*)(shm+LDS_OST)+wid*2048;
    #pragma unroll
    for(int pss=0;pss<2;++pss){
      #pragma unroll
      for(int r=0;r<16;++r){const int orow=crow(r,hi);
        #pragma unroll
        for(int d0=0;d0<2;++d0)stg[orow*64+d0*32+r32]=__float2bfloat16(o[2*pss+d0][r]*rli[r]);}
      asm volatile("s_waitcnt lgkmcnt(0)":::"memory");
      #pragma unroll
      for(int i=0;i<4;++i){const int row=i*8+(lane>>3),ch=lane&7; const u32x4 v=*(const u32x4*)(stg+row*64+ch*8); ATTN_STORE16(Ow+(long)row*DM+pss*64+ch*8,v);}
      asm volatile("s_waitcnt lgkmcnt(0)":::"memory"); } }
  asm volatile("s_waitcnt lgkmcnt(0)\n\ts_barrier":::"memory");
  return false;
  #undef DMA_K
  #undef DMA_V
  #undef CMASK
  #undef START
  #undef RESC
  #undef ROT
}
constexpr int ATTN_LDS_BYTES=LDS_BYTES;
#undef SBAR
#undef WAIT_BAR
}

#define GAS __attribute__((address_space(1)))
#define LAS __attribute__((address_space(3)))
typedef unsigned short bf16;
typedef unsigned v4u __attribute__((ext_vector_type(4)));
typedef float f32x4 __attribute__((ext_vector_type(4)));
typedef short bf16x8 __attribute__((ext_vector_type(8)));
typedef GAS unsigned gu32;
typedef GAS unsigned long long gu64;
#define RLX_AGENT __ATOMIC_RELAXED, __HIP_MEMORY_SCOPE_AGENT
#define LDS_WAIT() asm volatile("s_waitcnt lgkmcnt(0)" ::: "memory")
#define VM_WAIT() asm volatile("s_waitcnt vmcnt(0)" ::: "memory")
__device__ __forceinline__ unsigned long long rt() { return __builtin_amdgcn_s_memrealtime(); }
__device__ __forceinline__ unsigned f2bf(float f) { unsigned u = __builtin_bit_cast(unsigned, f); return (u + 0x7fffu + ((u >> 16) & 1u)) >> 16; }
__device__ __forceinline__ unsigned pk2(float lo, float hi) { return f2bf(lo) | (f2bf(hi) << 16); }

#define XB_TMO      128
#define XB_XCNT(j)  (256  + 64 * (j))
#define XB_XSUB(j)  (1280 + 64 * (j))
#define XB_XGEN(j)  (2304 + 64 * (j))
#define XB_TOP      3328
#define XB_TOPGEN   3392
#define XCD_BAR_WORDS 3456
#define XB_SPIN_CAP (1u << 24)

__device__ __forceinline__ unsigned xb_ld(unsigned* p)              { return __hip_atomic_load(p, __ATOMIC_RELAXED, __HIP_MEMORY_SCOPE_AGENT); }
__device__ __forceinline__ unsigned xb_add(unsigned* p, unsigned v) { return __hip_atomic_fetch_add(p, v, __ATOMIC_RELAXED, __HIP_MEMORY_SCOPE_AGENT); }
__device__ __forceinline__ unsigned xb_xcc_id() { return (unsigned)__builtin_amdgcn_s_getreg((3 << 11) | 20) & 0xFu; }
#define XB_SPIN(cond, bar) do { unsigned _sp = 0; while (cond) { __builtin_amdgcn_s_sleep(1); \
    if ((++_sp & 255u) == 0u) { if (xb_ld(&(bar)[XB_TMO])) break; if (_sp > XB_SPIN_CAP) { atomicAdd(&(bar)[XB_TMO], 1u); break; } } } } while (0)

struct XcdBarrier {
    unsigned* bar; unsigned x;
    volatile LAS unsigned* st;
};

__device__ __forceinline__ XcdBarrier xcd_barrier_post(unsigned* bar, volatile LAS unsigned* st) {
    XcdBarrier b; b.bar = bar; b.x = xb_xcc_id(); b.st = st;
    if (threadIdx.x == 0) (void)xb_add(&bar[XB_XCNT(b.x)], 1u);
    return b;
}
__device__ __forceinline__ void xcd_barrier_complete(unsigned* bar, unsigned x, unsigned& nloc, unsigned& nx) {
    const unsigned G = gridDim.x * gridDim.y * gridDim.z;
    unsigned sum, cnt, mine, sp = 0u;
    for (;;) {
        sum = 0u; cnt = 0u; mine = 0u;
#pragma unroll
        for (unsigned j = 0; j < 16; ++j) { const unsigned c = xb_ld(&bar[XB_XCNT(j)]); sum += c; cnt += (c > 0u) ? 1u : 0u; mine = (j == x) ? c : mine; }
        if (sum == G) break;
        __builtin_amdgcn_s_sleep(1);
        if ((++sp & 255u) == 0u) { if (xb_ld(&bar[XB_TMO])) break; if (sp > XB_SPIN_CAP) { atomicAdd(&bar[XB_TMO], 1u); break; } }
    }
    nloc = mine > 0u ? mine : 1u; nx = cnt > 0u ? cnt : 1u;
}

__device__ __forceinline__ void xcd_barrier(const XcdBarrier& b) {
    asm volatile("s_waitcnt vmcnt(0)" ::: "memory");
    __syncthreads();
    if (threadIdx.x == 0) {
        unsigned* bar = b.bar;
        __builtin_amdgcn_s_waitcnt(0);
        unsigned nloc = b.st[0], nx = b.st[1];
        if (nloc == 0u) { xcd_barrier_complete(bar, b.x, nloc, nx); b.st[0] = nloc; b.st[1] = nx; }
        const unsigned old = xb_add(&bar[XB_XSUB(b.x)], 1u);
        const unsigned gen = old / nloc;
        if (old + 1u == (gen + 1u) * nloc) {
            __builtin_amdgcn_fence(__ATOMIC_RELEASE, "agent");
            asm volatile("s_waitcnt vmcnt(0)" ::: "memory");
            const unsigned og = xb_add(&bar[XB_TOP], 1u);
            const unsigned tg = og / nx;
            if (og + 1u == (tg + 1u) * nx) xb_add(&bar[XB_TOPGEN], 1u);
            else XB_SPIN(xb_ld(&bar[XB_TOPGEN]) == tg, bar);
            __builtin_amdgcn_fence(__ATOMIC_ACQUIRE, "agent");
            xb_add(&bar[XB_XGEN(b.x)], 1u);
            asm volatile("s_waitcnt vmcnt(0)" ::: "memory");
        } else {
            XB_SPIN(xb_ld(&bar[XB_XGEN(b.x)]) == gen, bar);
            __builtin_amdgcn_fence(__ATOMIC_ACQUIRE, "agent");
            asm volatile("s_waitcnt vmcnt(0)" ::: "memory");
        }
    }
    __syncthreads();
}

constexpr int NWAVES = 8;
constexpr int BATCH = 2, SEQ = 8192, DM = 1024, CTXL = 256, DEPTH = 4;
constexpr int RL = BATCH * SEQ, RC = BATCH * CTXL, RT = RL + RC;
constexpr int KVB = SEQ + CTXL;
constexpr int NE = 32, TOPK = 4, CAPB = 296, CAP = CAPB * 256;
constexpr float LN_EPS = 1e-5f, RMS_EPS = 1e-5f;
constexpr float DN_ALPHA = 1.6817928305074290f;
constexpr float OSC = 64.f;
constexpr float WQ = 127.f / 0.25f, WQD = 127.f / 0.105f, ACTQ = 127.f / 16.f;
constexpr int MODK = 16;
#ifndef ONE_LAUNCH
#define ONE_LAUNCH 1
#endif
#ifndef DEBUG_CODES
#define DEBUG_CODES 0
#endif
#ifndef PROBE
#define PROBE 0
#endif
#ifndef DBG_ATTN
#define DBG_ATTN 0
#endif
#ifndef USE_DATTN
#define USE_DATTN DBG_ATTN
#endif

constexpr size_t MiB = 1u << 20;
constexpr size_t WS_CTL = 0, CTL_ZERO_BYTES = 1 * MiB;
constexpr size_t WS_MODP = 1 * MiB, WS_MOD = 6 * MiB, WS_TAB = 7 * MiB;
constexpr size_t WS_WQKV = 8 * MiB, WS_WO = 20 * MiB, WS_FNIN = 24 * MiB, WS_FNOUT = 28 * MiB, WS_WGU = 32 * MiB, WS_WD = 544 * MiB;
constexpr size_t WS_X = 800 * MiB, WS_A1 = 868 * MiB, WS_A2 = 902 * MiB, WS_Q = 936 * MiB, WS_K = 970 * MiB, WS_V = 1004 * MiB, WS_O0 = 1038 * MiB, WS_O1 = 1072 * MiB;
constexpr size_t WS_MIX = 1106 * MiB, WS_Y = 1140 * MiB, WS_U = 1174 * MiB, WS_U2 = 1208 * MiB, WS_Z1 = 1242 * MiB, WS_ZC = 1306 * MiB, WS_T = 1308 * MiB;
constexpr size_t WS_AMOE = 1372 * MiB, WS_DEST = 1817 * MiB, WS_ASGE = 1818 * MiB, WS_ASGS = 1819 * MiB, WS_ASGG = 1820 * MiB;
constexpr size_t WS_WGB = 1821 * MiB, WS_WRT = 1822 * MiB, WS_X2 = 1823 * MiB, WS_ASCR = 1891 * MiB, WS_A1S = 1893 * MiB;
constexpr float MIXCLIP = 6.f;
constexpr size_t WS_MIX8 = WS_O1;
constexpr int CAPE_B = RT / 256, CAPE = RT;
constexpr size_t WS_ACT = 1900 * MiB, WS_OUTM = WS_ACT + (size_t)NE * CAPE * 1024, WS_GATE = WS_OUTM + (size_t)NE * CAPE * 1024, WS_ASCD = WS_GATE + 3 * MiB, WS_TOKR = WS_ASCD + 3 * MiB, WS_END = WS_TOKR + 3 * MiB;
constexpr size_t TB_ROPEC = 0, TB_ROPES = 8192, TB_TWC = 16384, TB_TWS = 49152, TB_DFTC = 81920, TB_DFT1 = 147456, TB_DFT2 = 278528, TB_DFT256 = 344064;
constexpr int CW_DBG = 8, CW_BAR = 4096, CW_CNT = 16384;

constexpr int RING_OFF = 0, RING_BYTES = 131072;
constexpr int LDSCTL_OFF = RING_BYTES, MISC_OFF = LDSCTL_OFF + 320;
constexpr int TAB_OFF = LDSCTL_OFF + 1024;
constexpr int LDS_BYTES = 147456;

__device__ __forceinline__ float shx(float v, int o, int lane) { return __builtin_bit_cast(float, __builtin_amdgcn_ds_bpermute((lane ^ o) << 2, __builtin_bit_cast(int, v))); }
__device__ __forceinline__ int shxi(int v, int o, int lane) { return __builtin_amdgcn_ds_bpermute((lane ^ o) << 2, v); }
__device__ __forceinline__ int shli(int v, int src) { return __builtin_amdgcn_ds_bpermute(src << 2, v); }
template <int CTRL> __device__ __forceinline__ float dppf(float v) { return __builtin_bit_cast(float, __builtin_amdgcn_update_dpp(0, __builtin_bit_cast(int, v), CTRL, 0xF, 0xF, true)); }
__device__ __forceinline__ float row16_sum(float v) { v += dppf<0xB1>(v); v += dppf<0x4E>(v); v += dppf<0x141>(v); v += dppf<0x140>(v); return v; }
__device__ __forceinline__ float wsum(float v) { v = row16_sum(v);
    { auto rr = __builtin_amdgcn_permlane16_swap(__float_as_uint(v), __float_as_uint(v), false, false); v = __uint_as_float(rr[0]) + __uint_as_float(rr[1]); }
    { auto rr = __builtin_amdgcn_permlane32_swap(__float_as_uint(v), __float_as_uint(v), false, false); v = __uint_as_float(rr[0]) + __uint_as_float(rr[1]); }
    return v; }
__device__ __forceinline__ float wmaxf(float v) { v = fmaxf(v, dppf<0xB1>(v)); v = fmaxf(v, dppf<0x4E>(v)); v = fmaxf(v, dppf<0x141>(v)); v = fmaxf(v, dppf<0x140>(v));
    { auto rr = __builtin_amdgcn_permlane16_swap(__float_as_uint(v), __float_as_uint(v), false, false); v = fmaxf(__uint_as_float(rr[0]), __uint_as_float(rr[1])); }
    { auto rr = __builtin_amdgcn_permlane32_swap(__float_as_uint(v), __float_as_uint(v), false, false); v = fmaxf(__uint_as_float(rr[0]), __uint_as_float(rr[1])); }
    return v; }
__device__ __forceinline__ float wave_sum(float v, int lane) {
#pragma unroll
    for (int o = 1; o < 64; o <<= 1) v += shx(v, o, lane);
    return v;
}
__device__ __forceinline__ float wave_max(float v, int lane) {
#pragma unroll
    for (int o = 1; o < 64; o <<= 1) v = fmaxf(v, shx(v, o, lane));
    return v;
}
__device__ __forceinline__ int wave_min_i(int v, int lane) {
#pragma unroll
    for (int o = 1; o < 64; o <<= 1) { const int w = shxi(v, o, lane); v = w < v ? w : v; }
    return v;
}
__device__ __forceinline__ float bf2f(unsigned h) { return __builtin_bit_cast(float, h << 16); }

__device__ __forceinline__ void ld_f32(const float* p, int lane, float (&v)[16]) {
#pragma unroll
    for (int j = 0; j < 2; ++j) { const f32x4 a = *(const f32x4*)(p + 512 * j + 8 * lane), b = *(const f32x4*)(p + 512 * j + 8 * lane + 4);
        v[8 * j + 0] = a[0]; v[8 * j + 1] = a[1]; v[8 * j + 2] = a[2]; v[8 * j + 3] = a[3]; v[8 * j + 4] = b[0]; v[8 * j + 5] = b[1]; v[8 * j + 6] = b[2]; v[8 * j + 7] = b[3]; }
}
__device__ __forceinline__ void st_f32(float* p, int lane, const float (&v)[16]) {
#pragma unroll
    for (int j = 0; j < 2; ++j) { *(f32x4*)(p + 512 * j + 8 * lane) = (f32x4){v[8 * j], v[8 * j + 1], v[8 * j + 2], v[8 * j + 3]}; *(f32x4*)(p + 512 * j + 8 * lane + 4) = (f32x4){v[8 * j + 4], v[8 * j + 5], v[8 * j + 6], v[8 * j + 7]}; }
}
__device__ __forceinline__ void ld_bf16(const bf16* p, int lane, float (&v)[16]) {
#pragma unroll
    for (int j = 0; j < 2; ++j) { const v4u w = *(const v4u*)(p + 512 * j + 8 * lane);
        v[8 * j + 0] = bf2f(w.x & 0xffffu); v[8 * j + 1] = bf2f(w.x >> 16); v[8 * j + 2] = bf2f(w.y & 0xffffu); v[8 * j + 3] = bf2f(w.y >> 16);
        v[8 * j + 4] = bf2f(w.z & 0xffffu); v[8 * j + 5] = bf2f(w.z >> 16); v[8 * j + 6] = bf2f(w.w & 0xffffu); v[8 * j + 7] = bf2f(w.w >> 16); }
}
__device__ __forceinline__ void st_bf16(bf16* p, int lane, const float (&v)[16]) {
#pragma unroll
    for (int j = 0; j < 2; ++j) { v4u w; w.x = pk2(v[8 * j], v[8 * j + 1]); w.y = pk2(v[8 * j + 2], v[8 * j + 3]); w.z = pk2(v[8 * j + 4], v[8 * j + 5]); w.w = pk2(v[8 * j + 6], v[8 * j + 7]); *(v4u*)(p + 512 * j + 8 * lane) = w; }
}
__device__ __forceinline__ void ld_f16(const unsigned short* p, int lane, float (&v)[16]) {
    typedef _Float16 h8 __attribute__((ext_vector_type(8)));
#pragma unroll
    for (int j = 0; j < 2; ++j) { const h8 w = *(const h8*)(p + 512 * j + 8 * lane);
#pragma unroll
        for (int t = 0; t < 8; ++t) v[8 * j + t] = (float)w[t]; }
}
__device__ __forceinline__ void st_f16(unsigned short* p, int lane, const float (&v)[16]) {
    typedef _Float16 h8 __attribute__((ext_vector_type(8)));
#pragma unroll
    for (int j = 0; j < 2; ++j) { h8 w;
#pragma unroll
        for (int t = 0; t < 8; ++t) w[t] = (_Float16)v[8 * j + t];
        *(h8*)(p + 512 * j + 8 * lane) = w; }
}
__device__ __forceinline__ void ld_f32(const LAS float* p, int lane, float (&v)[16]) {
#pragma unroll
    for (int j = 0; j < 2; ++j) { const f32x4 a = *(const LAS f32x4*)(p + 512 * j + 8 * lane), b = *(const LAS f32x4*)(p + 512 * j + 8 * lane + 4);
        v[8 * j + 0] = a[0]; v[8 * j + 1] = a[1]; v[8 * j + 2] = a[2]; v[8 * j + 3] = a[3]; v[8 * j + 4] = b[0]; v[8 * j + 5] = b[1]; v[8 * j + 6] = b[2]; v[8 * j + 7] = b[3]; }
}
template <class P> __device__ __forceinline__ void ln_row(float (&v)[16], P g, P b, int lane) {
    float s = 0.f;
#pragma unroll
    for (int t = 0; t < 16; ++t) s += v[t];
    const float mean = wsum(s) * (1.f / 1024.f); float q = 0.f;
#pragma unroll
    for (int t = 0; t < 16; ++t) { v[t] -= mean; q += v[t] * v[t]; }
    const float rstd = 1.f / sqrtf(wsum(q) * (1.f / 1024.f) + LN_EPS);
    float gg[16], bb[16]; ld_f32(g, lane, gg); ld_f32(b, lane, bb);
#pragma unroll
    for (int t = 0; t < 16; ++t) v[t] = v[t] * rstd * gg[t] + bb[t];
}

__device__ __forceinline__ void transpose_item(const float* W, int K, int N, bf16* WT, LAS float* scr, int k0, int n0, int lane) {
    float ld_[32];
#pragma unroll
    for (int i = 0; i < 32; ++i) ld_[i] = W[(size_t)(k0 + 2 * i + (lane >> 5)) * N + n0 + (lane & 31)];
#pragma unroll
    for (int i = 0; i < 32; ++i) scr[(2 * i + (lane >> 5)) * 33 + (lane & 31)] = ld_[i];
    LDS_WAIT(); asm volatile("" ::: "memory");
    const int c = lane & 7;
#pragma unroll
    for (int j = 0; j < 4; ++j) { const int n = (lane >> 3) + 8 * j; const LAS float* s = scr + (8 * c) * 33 + n;
        v4u o; o.x = pk2(s[0 * 33], s[1 * 33]); o.y = pk2(s[2 * 33], s[3 * 33]); o.z = pk2(s[4 * 33], s[5 * 33]); o.w = pk2(s[6 * 33], s[7 * 33]);
        *(GAS v4u*)(WT + (size_t)n * K + k0 + 8 * c) = o; }
    LDS_WAIT(); asm volatile("" ::: "memory");
}
__device__ __forceinline__ void ti8_load(const float* W, int N, int k0, int n0, int lane, float (&ld_)[32]) {
#pragma unroll
    for (int i = 0; i < 32; ++i) ld_[i] = __builtin_nontemporal_load(W + (size_t)(k0 + 2 * i + (lane >> 5)) * N + n0 + (lane & 31));
}
__device__ __forceinline__ void ti8_finish(const float (&ld_)[32], unsigned char* WT, int Kb, LAS float* scr, int k0, int lane, float scale) {
#pragma unroll
    for (int i = 0; i < 32; ++i) scr[(2 * i + (lane >> 5)) * 33 + (lane & 31)] = ld_[i];
    LDS_WAIT(); asm volatile("" ::: "memory");
    const int n = lane >> 1, kh = lane & 1; const LAS float* s = scr + (32 * kh) * 33 + n;
    unsigned w[8];
#pragma unroll
    for (int q = 0; q < 8; ++q) w[q] = pg8::pk4_i8(s[(4 * q) * 33] * scale, s[(4 * q + 1) * 33] * scale, s[(4 * q + 2) * 33] * scale, s[(4 * q + 3) * 33] * scale);
    GAS v4u* o = (GAS v4u*)(WT + (size_t)n * Kb + k0 + 32 * kh);
    o[0] = (v4u){w[0], w[1], w[2], w[3]}; o[1] = (v4u){w[4], w[5], w[6], w[7]};
    LDS_WAIT(); asm volatile("" ::: "memory");
}
__device__ __forceinline__ void transpose_item_i8(const float* W, int N, unsigned char* WT, int Kb, LAS float* scr, int k0, int n0, int lane, float scale) {
    float ld_[32]; ti8_load(W, N, k0, n0, lane, ld_); ti8_finish(ld_, WT, Kb, scr, k0, lane, scale);
}
__device__ __forceinline__ void ti8_half(const float (&ld_)[32], LAS float* scr, int lane, float scale, unsigned (&w)[8]) {
#pragma unroll
    for (int i = 0; i < 32; ++i) scr[(2 * i + (lane >> 5)) * 33 + (lane & 31)] = ld_[i];
    LDS_WAIT(); asm volatile("" ::: "memory");
    const LAS float* s = scr + (32 * (lane >> 5)) * 33 + (lane & 31);
#pragma unroll
    for (int q = 0; q < 8; ++q) w[q] = pg8::pk4_i8(s[(4 * q) * 33] * scale, s[(4 * q + 1) * 33] * scale, s[(4 * q + 2) * 33] * scale, s[(4 * q + 3) * 33] * scale);
    LDS_WAIT(); asm volatile("" ::: "memory");
}
__device__ __forceinline__ void transpose_item2_i8(const float* W, int N, unsigned char* WT, int Kb, LAS float* scr, int k0, int n0, int lane, float scale, bool nostore = false) {
    float la[32], lb[32]; ti8_load(W, N, k0, n0, lane, la); ti8_load(W, N, k0 + 64, n0, lane, lb);
    unsigned wa[8], wb[8]; ti8_half(la, scr, lane, scale, wa); ti8_half(lb, scr, lane, scale, wb);
    if (nostore) { asm volatile("" :: "v"(wa[0]), "v"(wa[7]), "v"(wb[0]), "v"(wb[7])); return; }
    LAS unsigned char* ob = (LAS unsigned char*)scr;
    { const int n = lane & 31, q = lane >> 5; LAS v4u* d0 = (LAS v4u*)(ob + n * 144 + 32 * q); LAS v4u* d1 = (LAS v4u*)(ob + n * 144 + 64 + 32 * q);
      d0[0] = (v4u){wa[0], wa[1], wa[2], wa[3]}; d0[1] = (v4u){wa[4], wa[5], wa[6], wa[7]}; d1[0] = (v4u){wb[0], wb[1], wb[2], wb[3]}; d1[1] = (v4u){wb[4], wb[5], wb[6], wb[7]}; }
    LDS_WAIT(); asm volatile("" ::: "memory");
#pragma unroll
    for (int i = 0; i < 4; ++i) { const int row = (lane >> 3) + 8 * i, ch = lane & 7; const v4u v = *(const LAS v4u*)(ob + row * 144 + ch * 16);
        *(GAS v4u*)(WT + (size_t)row * Kb + k0 + ch * 16) = v; }
    LDS_WAIT(); asm volatile("" ::: "memory");
}
#ifndef MC_VIA_REGS
#define MC_VIA_REGS 1
#endif
__device__ __forceinline__ void mc_dma(const float* p, int N, unsigned loff, LAS unsigned char* reg) {
#pragma unroll
    for (int i = 0; i < 16; ++i) __builtin_amdgcn_global_load_lds((const unsigned*)((const char*)(p + (size_t)i * N) + loff), (LAS unsigned*)(reg + i * 1024), 16, 0, 0);
}
__device__ __forceinline__ void mc_pack4(const f32x4 (&v)[16], float scale, v4u (&w)[4]) {
#pragma unroll
    for (int j = 0; j < 4; ++j) { unsigned o[4];
#pragma unroll
        for (int q = 0; q < 4; ++q) { unsigned b[4];
#pragma unroll
            for (int i = 0; i < 4; ++i) b[i] = __float_as_uint(__builtin_amdgcn_fmed3f(__builtin_fmaf(v[4 * q + i][j], scale, 12582912.0f), 12582912.0f - 127.0f, 12582912.0f + 127.0f));
            o[q] = __builtin_amdgcn_perm(b[1], b[0], 0x0c0c0400u) | (__builtin_amdgcn_perm(b[3], b[2], 0x0c0c0400u) << 16); }
        w[j] = (v4u){o[0], o[1], o[2], o[3]}; }
}
template <bool GU> __device__ __forceinline__ void moe_conv_stream(const float* W, unsigned char* WT, int i0, int i1, int wi, int nw, LAS unsigned char* reg, int lane, float scale) {
    constexpr int N = GU ? 2048 : 1024, SH = GU ? 9 : 8, KSH = GU ? 6 : 5;
    int it = i0 + wi; if (it >= i1) return;
#define MC_SRC(itx) (W + (size_t)((itx) >> SH) * 1024 * N + (size_t)((((itx) & ((1 << SH) - 1)) >> KSH) * 128) * N + ((itx) & ((1 << KSH) - 1)) * 32)
#define MC_DROW(n0) (GU ? ((n0) < 1024 ? (((n0) >> 7) * 256 + ((n0) & 127)) : (((((n0) - 1024) >> 7) * 256) + 128 + (((n0) - 1024) & 127))) : (n0))
    const unsigned loff = (unsigned)((16 * (lane >> 3)) * N + 4 * (lane & 7)) * 4u;
    const int ch = lane & 7, a = lane >> 3; const LAS unsigned char* rd = reg + (a + 8 * ch) * 16;
#if MC_VIA_REGS
    f32x4 ld_[16];
#define MC_LOAD(itx) do { const float* p_ = MC_SRC(itx); _Pragma("unroll") for (int i = 0; i < 16; ++i) ld_[i] = __builtin_nontemporal_load((const f32x4*)((const char*)(p_ + (size_t)i * N) + loff)); } while (0)
    MC_LOAD(it);
#pragma unroll 1
    for (; it < i1; it += nw) {
#pragma unroll
        for (int i = 0; i < 16; ++i) *(LAS f32x4*)(reg + i * 1024 + lane * 16) = ld_[i];
        __builtin_amdgcn_sched_barrier(0);
        if (it + nw < i1) MC_LOAD(it + nw);
        __builtin_amdgcn_sched_barrier(0);
        asm volatile("s_waitcnt lgkmcnt(0)" ::: "memory");
        f32x4 v[16];
#pragma unroll
        for (int i = 0; i < 16; ++i) v[i] = *(const LAS f32x4*)(rd + i * 1024);
        asm volatile("s_waitcnt lgkmcnt(0)" ::: "memory");
        v4u w[4]; mc_pack4(v, scale, w);
        const int r_ = it & ((1 << SH) - 1), n0 = (r_ & ((1 << KSH) - 1)) * 32;
        unsigned char* dst = WT + (size_t)(it >> SH) * N * 1024 + (size_t)(MC_DROW(n0) + 4 * a) * 1024 + (r_ >> KSH) * 128 + ch * 16;
#pragma unroll
        for (int j = 0; j < 4; ++j) *(GAS v4u*)(dst + (size_t)j * 1024) = w[j];
        asm volatile("" ::: "memory");
    }
#undef MC_LOAD
#else
    mc_dma(MC_SRC(it), N, loff, reg);
#pragma unroll 1
    for (; it < i1; it += nw) {
        asm volatile("s_waitcnt vmcnt(0)" ::: "memory");
        f32x4 v[16];
#pragma unroll
        for (int i = 0; i < 16; ++i) v[i] = *(const LAS f32x4*)(rd + i * 1024);
        asm volatile("s_waitcnt lgkmcnt(0)" ::: "memory");
        if (it + nw < i1) mc_dma(MC_SRC(it + nw), N, loff, reg);
        v4u w[4]; mc_pack4(v, scale, w);
        const int r_ = it & ((1 << SH) - 1), n0 = (r_ & ((1 << KSH) - 1)) * 32;
        unsigned char* dst = WT + (size_t)(it >> SH) * N * 1024 + (size_t)(MC_DROW(n0) + 4 * a) * 1024 + (r_ >> KSH) * 128 + ch * 16;
#pragma unroll
        for (int j = 0; j < 4; ++j) *(GAS v4u*)(dst + (size_t)j * 1024) = w[j];
    }
#endif
#undef MC_SRC
#undef MC_DROW
}
__device__ __forceinline__ void moe_conv_range(const float* Wgu, unsigned char* WTgu, const float* Wd, unsigned char* WTd, int gu0, int gu1, int d0, int d1, int wi, int nw, LAS float* scr, int lane) {
    moe_conv_stream<true>(Wgu, WTgu, gu0, gu1, wi, nw, (LAS unsigned char*)scr, lane, WQ);
    moe_conv_stream<false>(Wd, WTd, d0, d1, wi, nw, (LAS unsigned char*)scr, lane, WQD);
}
__device__ __forceinline__ void st_i8(unsigned char* p, int lane, const float (&v)[16], float scale) {
#pragma unroll
    for (int j = 0; j < 2; ++j) { typedef unsigned u32x2_t __attribute__((ext_vector_type(2))); u32x2_t w;
        w.x = pg8::pk4_i8(v[8 * j] * scale, v[8 * j + 1] * scale, v[8 * j + 2] * scale, v[8 * j + 3] * scale); w.y = pg8::pk4_i8(v[8 * j + 4] * scale, v[8 * j + 5] * scale, v[8 * j + 6] * scale, v[8 * j + 7] * scale);
        *(u32x2_t*)(p + 512 * j + 8 * lane) = w; }
}
__device__ __forceinline__ float st_i8_row(unsigned char* p, float* sc, int lane, const float (&v)[16]) {
    float am = 0.f;
#pragma unroll
    for (int t = 0; t < 16; ++t) am = fmaxf(am, fabsf(v[t]));
    am = fmaxf(wmaxf(am), 1e-20f); st_i8(p, lane, v, 127.f / am); if (lane == 0) *sc = am * (1.f / 127.f);
    return am * (1.f / 127.f);
}
__device__ __forceinline__ float silu_f(float x) { return x / (1.f + expf(-x)); }

struct Args { const float* in[21]; float* out; unsigned char* ws; int ph_lo, ph_hi; };

template <class P> __device__ __forceinline__ void pm1_comb(int lane, const v4u (&xw)[2], const v4u (&yw)[2], P g1p, float (&v)[16]) {
    float y[16], g1[16]; ld_f32(g1p, lane, g1);
#pragma unroll
    for (int j = 0; j < 2; ++j) { typedef _Float16 h8 __attribute__((ext_vector_type(8))); const h8 hx = __builtin_bit_cast(h8, xw[j]);
#pragma unroll
        for (int t = 0; t < 8; ++t) v[8 * j + t] = (float)hx[t];
        y[8 * j + 0] = bf2f(yw[j].x & 0xffffu); y[8 * j + 1] = bf2f(yw[j].x >> 16); y[8 * j + 2] = bf2f(yw[j].y & 0xffffu); y[8 * j + 3] = bf2f(yw[j].y >> 16);
        y[8 * j + 4] = bf2f(yw[j].z & 0xffffu); y[8 * j + 5] = bf2f(yw[j].z >> 16); y[8 * j + 6] = bf2f(yw[j].w & 0xffffu); y[8 * j + 7] = bf2f(yw[j].w >> 16); }
#pragma unroll
    for (int t = 0; t < 16; ++t) v[t] = DN_ALPHA * v[t] + g1[t] * y[t];
}
template <class P> __device__ __forceinline__ float pm1_pre2(int r, int lane, P scp, P shp, P lng, P lnb, unsigned short* X2, unsigned char* A2, float* asr, float (&v)[16]) {
    ln_row(v, lng, lnb, lane);
    st_f16(X2 + (size_t)r * 1024, lane, v);
    { float sc[16], sh[16]; ld_f32(scp, lane, sc); ld_f32(shp, lane, sh);
#pragma unroll
      for (int t = 0; t < 16; ++t) v[t] = v[t] * (1.f + sc[t]) + sh[t]; }
    return st_i8_row(A2 + (size_t)r * 1024, asr + r, lane, v);
}
__device__ __forceinline__ void pm1_post(int r, bool active, bool first, int lane, float (&p)[32], const float* brt, LAS float* LG, LAS int* TAB, int* asg_e, int* asg_s, float* asg_g) {
#define RSTEP(half, msk) { const bool up = (lane & (msk)) != 0; _Pragma("unroll") for (int t = 0; t < (half); ++t) { const float keep = up ? p[t + (half)] : p[t], send = up ? p[t] : p[t + (half)]; p[t] = keep + shx(send, (msk), lane); } }
    RSTEP(16, 32) RSTEP(8, 16) RSTEP(4, 8) RSTEP(2, 4) RSTEP(1, 2)
#undef RSTEP
    float lg = p[0] + shx(p[0], 1, lane);
    const int myE = (lane >> 1) & 31;
    lg += brt[myE];
    float val = (lane & 1) ? -INFINITY : lg; float mx = 0.f, esum = 0.f, myex = 0.f; int rank = 4;
#pragma unroll
    for (int kx = 0; kx < 4; ++kx) { const float m = wmaxf(val); const unsigned long long bal = __ballot(val == m); const int win = __builtin_ctzll(bal);
        if (kx == 0) mx = m;
        const float ex = expf(m - mx); esum += ex;
        if (lane == win) { rank = kx; myex = ex; val = -INFINITY; } }
    const bool sel = rank < 4; const float ex = myex, gs = esum;
    if (sel && active && first) { const int sl = __hip_atomic_fetch_add(TAB + myE, 1, __ATOMIC_RELAXED, __HIP_MEMORY_SCOPE_WORKGROUP);
        asg_e[r * 4 + rank] = myE; asg_s[r * 4 + rank] = sl; asg_g[r * 4 + rank] = ex / gs; }
}
__device__ __forceinline__ void pm1_top4(bool active, bool first, int lane, float lg, LAS int* TAB, LAS int* rec) {
    const int myE = lane & 31;
    float val = (lane < 32) ? lg : -INFINITY; float mx = 0.f, esum = 0.f, myex = 0.f; int rank = 4;
#pragma unroll
    for (int kx = 0; kx < 4; ++kx) { const float m = wmaxf(val); const unsigned long long bal = __ballot(val == m); const int win = __builtin_ctzll(bal);
        if (kx == 0) mx = m;
        const float ex = expf(m - mx); esum += ex;
        if (lane == win) { rank = kx; myex = ex; val = -INFINITY; } }
    if (rank < 4 && active && first) { const int sl = __hip_atomic_fetch_add(TAB + myE, 1, __ATOMIC_RELAXED, __HIP_MEMORY_SCOPE_WORKGROUP);
        rec[rank] = myE; rec[4 + rank] = sl; rec[8 + rank] = __builtin_bit_cast(int, myex / esum); }
}
typedef const float* cfptr_t;
typedef const cfptr_t __attribute__((address_space(4)))* kin_t;
#define PHASE_BASES unsigned long long wsi_ = (unsigned long long)args.ws; asm volatile("" : "+s"(wsi_)); GAS unsigned char* w_ = (GAS unsigned char*)wsi_; kin_t in_ = (kin_t)__builtin_amdgcn_kernarg_segment_ptr(); asm volatile("" : "+s"(in_)); \
    int tid_o_ = threadIdx.x; asm volatile("" : "+v"(tid_o_)); const int tid = tid_o_, lane = tid & 63; (void)tid; (void)lane; (void)in_;
#define WSP(T, off) ((T*)(GAS T*)(w_ + (off)))
#define INP(k) ((const float*)(const GAS float*)(unsigned long long)in_[k])
#define MODP(i, s, part) (WSP(float, WS_MOD) + (size_t)((((i) * 3 + (s)) * 6 + (part)) * 1024))

__global__ void __launch_bounds__(NWAVES * 64, 2) fwd_kernel(Args args) {
    extern __shared__ __attribute__((aligned(16))) unsigned char lds[];
    LAS unsigned char* const L = (LAS unsigned char*)lds;
    volatile LAS unsigned* const MISC = (volatile LAS unsigned*)(L + MISC_OFF);
    LAS int* const TAB = (LAS int*)(L + TAB_OFF);
    const int tid = threadIdx.x, lane = tid & 63, wave = __builtin_amdgcn_readfirstlane(tid >> 6);
    const int G = gridDim.x; const int bx = blockIdx.x; const int vcu = (G % 8 == 0) ? (bx % 8) * (G / 8) + bx / 8 : bx;
    const int gw = vcu * NWAVES + wave, NGW = G * NWAVES;

    for (int u = tid; u < (LDS_BYTES - LDSCTL_OFF) / 4; u += NWAVES * 64) ((LAS unsigned*)(L + LDSCTL_OFF))[u] = 0u;
    __syncthreads();
    XcdBarrier bar; bar.bar = (unsigned*)(args.ws + WS_CTL) + CW_BAR; bar.x = 0; bar.st = nullptr;
#if ONE_LAUNCH
    bar = xcd_barrier_post((unsigned*)(args.ws + WS_CTL) + CW_BAR, MISC + 8);
#define GRID_BAR() xcd_barrier(bar)
#else
#define GRID_BAR() do { } while (0)
#endif
    const int lo = args.ph_lo, hi = args.ph_hi;
#define IN(k) (lo <= (k) && (k) < hi)
#if PROBE
    int nstamp = 1; unsigned long long* const TSB = (unsigned long long*)(args.ws + WS_CTL) + 16384;
    if (bx == 0 && tid == 0) TSB[0] = __builtin_amdgcn_s_memrealtime();
#define SEAM(k) do { if (IN(k) && IN((k) + 1)) GRID_BAR(); if (bx == 0 && threadIdx.x == 0) TSB[nstamp] = __builtin_amdgcn_s_memrealtime(); ++nstamp; } while (0)
#else
#define SEAM(k) do { if (IN(k) && IN((k) + 1)) GRID_BAR(); } while (0)
#endif
#ifndef PHASE_MASK
#define PHASE_MASK 0xffffffffu
#endif
#ifndef PHASE_MASK0
#define PHASE_MASK0 7u
#endif
#define INL(t, bit) (((PHASE_MASK >> (bit)) & 1u) && IN(pb + (t)))
#define INL0(k) (((PHASE_MASK0 >> (k)) & 1u) && IN(k))
#ifndef REP_BIT
#define REP_BIT (-1)
#define REP_N 1
#endif
#define REP_ON(bit) (REP_BIT == (bit) || (REP_BIT == 99 && (bit) >= 16 && (bit) <= 20))
#ifndef REP_LY
#define REP_LY (-1)
#endif
#ifndef QKV_PROBE
#define QKV_PROBE 0
#endif
    int rep_ly_ = -1; (void)rep_ly_;
#define REP_HERE(bit) (REP_ON(bit) && (REP_LY < 0 || rep_ly_ == REP_LY))
#define REP_BEGIN(bit) for (int rep_ = 0; rep_ < (REP_HERE(bit) ? REP_N : 1); ++rep_) {
#define REP_END(bit) if (REP_HERE(bit) && rep_ + 1 < REP_N) GRID_BAR(); }

#if defined(P0_NOSTORE_ON_REP)
#define P0_NS (rep_ > 0)
#else
#define P0_NS false
#endif
    REP_BEGIN(30)
    if (INL0(0)) {
        PHASE_BASES
        LAS float* scr = (LAS float*)(L + RING_OFF + wave * 16384);
        {
            const float* W = INP(8); unsigned char* WT = WSP(unsigned char, WS_WQKV);
            for (int it = gw; it < 2 * 1536; it += NGW) { const int j = it / 1536, r = it % 1536, kb = r / 96, nb = r % 96;
                transpose_item_i8(W + (size_t)j * 1024 * 3072, 3072, WT + (size_t)j * 3072 * 1024 + (size_t)(nb * 32) * 1024, 1024, scr, kb * 64, nb * 32, lane, WQ); }
        }
        {
            for (int it = NGW - 1 - gw; it < 6 * 512; it += NGW) { const int mat = it / 512, r = it % 512, kb = r / 32, nb = r % 32;
                const float* W = (mat < 2 ? INP(11) : (mat < 4 ? INP(12) : INP(14))) + (size_t)(mat & 1) * 1024 * 1024;
                if (mat < 4) { unsigned char* WT8 = (unsigned char*)(GAS unsigned char*)(w_ + (mat < 2 ? WS_WO : WS_FNIN)) + (size_t)(mat & 1) * 1024 * 1024;
                    transpose_item_i8(W, 1024, WT8 + (size_t)(nb * 32) * 1024, 1024, scr, kb * 64, nb * 32, lane, WQ); }
                else { bf16* WT = (bf16*)(GAS bf16*)(w_ + WS_FNOUT) + (size_t)(mat & 1) * 1024 * 1024;
                    transpose_item(W, 1024, 1024, WT + (size_t)(nb * 32) * 1024, scr, kb * 64, nb * 32, lane); } }
        }
        {
            const float* wm = INP(4); const float* cv = INP(1); const float* cc = INP(3); float* MODPART = WSP(float, WS_MODP);
#define SILV(j) ((LAS float*)(L + RING_OFF + (j) * 16384 + 12288))
            for (int q_ = tid; q_ < 3072; q_ += NWAVES * 64) SILV(q_ >> 10)[q_ & 1023] = silu_f(q_ < 2048 ? cv[q_] : cc[q_ - 2048]);
            __syncthreads();
            for (int it = gw; it < 4 * 24 * MODK; it += NGW) { const int kc = it % MODK, rest = it / MODK, cb = rest % 24, i = rest / 24, n = cb * 256 + 4 * lane;
                f32x4 a0 = {0.f, 0.f, 0.f, 0.f}, a1 = a0, a2 = a0;
#pragma unroll 8
                for (int kk = 0; kk < 64; ++kk) { const int k = kc * 64 + kk; const f32x4 w = *(const f32x4*)(wm + ((size_t)i * 1024 + k) * 6144 + n);
                    const float s0 = SILV(0)[k], s1 = SILV(1)[k], s2 = SILV(2)[k]; a0 += w * s0; a1 += w * s1; a2 += w * s2; }
                float* o = MODPART + (size_t)((kc * 4 + i) * 3) * 6144 + n;
                *(f32x4*)(o) = a0; *(f32x4*)(o + 6144) = a1; *(f32x4*)(o + 2 * 6144) = a2; }
        }
        {
            float* ROPEC = WSP(float, WS_TAB + TB_ROPEC); float* ROPES = WSP(float, WS_TAB + TB_ROPES); float* TWC = WSP(float, WS_TAB + TB_TWC); float* TWS = WSP(float, WS_TAB + TB_TWS);
            bf16* DFTC = WSP(bf16, WS_TAB + TB_DFTC); bf16* DFT1 = WSP(bf16, WS_TAB + TB_DFT1); bf16* DFT2 = WSP(bf16, WS_TAB + TB_DFT2); bf16* DFT256 = WSP(bf16, WS_TAB + TB_DFT256);
            const int gt = gw * 64 + lane, NT_ = NGW * 64;
            for (int idx = gt; idx < 2048; idx += NT_) { const int pos = idx >> 4, f = idx & 15; const float inv = powf(10000.f, -(float)f / 16.f); const float ang = (float)pos * inv; ROPEC[idx] = cosf(ang); ROPES[idx] = sinf(ang); }
            for (int idx = gt; idx < 8192; idx += NT_) { const int kl = idx >> 6, nl = idx & 63; float s, c; sincospif(2.f * (float)(kl * nl) / 8192.f, &s, &c); TWC[idx] = c; TWS[idx] = s; }
            for (int idx = gt; idx < 256 * 128; idx += NT_) { const int row = idx >> 7, cc2 = idx & 127, reim = row >> 7, m = row & 127; float s, c; sincospif(2.f * (float)((m * cc2) & 127) / 128.f, &s, &c);
                DFTC[idx] = (bf16)f2bf((reim ? -s : c) * 0.08838834764831845f); }
            for (int idx = gt; idx < 256 * 256; idx += NT_) { const int row = idx >> 8, col = idx & 255, ro = row >> 7, kl = row & 127, ri = col >> 7, nh = col & 127; float s, c; sincospif(2.f * (float)((nh * kl) & 127) / 128.f, &s, &c);
                const float v = (ro == ri) ? c : (ro == 0 ? s : -s); DFT1[idx] = (bf16)f2bf(v * 0.08838834764831845f); }
            for (int idx = gt; idx < 256 * 128; idx += NT_) { const int row = idx >> 7, col = idx & 127, ri = col >> 6, nl = col & 63; float s, c; sincospif(2.f * (float)((nl * row) & 63) / 64.f, &s, &c);
                DFT2[idx] = (bf16)f2bf(row < 64 ? (ri ? s : c) * 0.125f : 0.f); }
            for (int idx = gt; idx < 256 * 512; idx += NT_) { const int row = idx >> 9, col = idx & 511, ri = col >> 8, j = col & 255; float s, c; sincospif(2.f * (float)((j * row) & 255) / 256.f, &s, &c);
                DFT256[idx] = (bf16)f2bf((ri ? s : c) * 0.0625f); }
        }
    }
    REP_END(30)
    SEAM(0);
    REP_BEGIN(31)
    if (INL0(1)) {
        PHASE_BASES
        const float* bm = INP(5); const float* MODPART = WSP(float, WS_MODP); float* MOD = WSP(float, WS_MOD);
        for (int idx = gw * 64 + lane; idx < 4 * 3 * 6144; idx += NGW * 64) { const int n = idx % 6144, is = idx / 6144, i = is / 3; float a = bm[i * 6144 + n];
#pragma unroll
            for (int kc = 0; kc < MODK; ++kc) a += MODPART[(size_t)kc * (4 * 3 * 6144) + idx];
            MOD[idx] = a; }
    }
    REP_END(31)
    SEAM(1);
    REP_BEGIN(32)
    if (INL0(2)) {
        PHASE_BASES
        const float* xin = INP(0); const float* cin = INP(2); unsigned short* X = WSP(unsigned short, WS_X); unsigned char* A1 = WSP(unsigned char, WS_A1); float* a1s = WSP(float, WS_A1S);
        float nv[16];
#define P2_SRC(rr) ((rr) < RL ? xin + (size_t)(rr) * 1024 : cin + (size_t)((rr) - RL) * 1024)
        if (gw < RT) ld_f32(P2_SRC(gw), lane, nv);
        for (int r = gw; r < RT; r += NGW) { const int s = r < RL ? (r >> 13) : 2;
            float v[16], sc[16], sh[16];
#pragma unroll
            for (int t = 0; t < 16; ++t) v[t] = nv[t];
            if (r + NGW < RT) ld_f32(P2_SRC(r + NGW), lane, nv);
            st_f16(X + (size_t)r * 1024, lane, v); ld_f32(MODP(0, s, 1), lane, sc); ld_f32(MODP(0, s, 0), lane, sh);
#pragma unroll
            for (int t = 0; t < 16; ++t) v[t] = v[t] * (1.f + sc[t]) + sh[t];
            st_i8_row(A1 + (size_t)r * 1024, a1s + r, lane, v); }
#undef P2_SRC
    }
    REP_END(32)
    SEAM(2);

#if defined(EXTRA_BARS)
    for (int eb = 0; eb < EXTRA_BARS; ++eb) GRID_BAR();
#endif
    for (int ly = 0; ly < DEPTH; ++ly) {
        const int pb = 3 + ly * 12;
        rep_ly_ = ly;
        const int jj = ly >> 1;
        const bool ctx_full = ly < 2;
        const int nrows = ctx_full ? RT : RL;
        const int nMt = (ly < 3) ? (RT / 256) : (RL / 256);
        if ((ly & 1) == 0) {
            REP_BEGIN(0)
            if (INL(0, 0)) {
                PHASE_BASES
                int kk_ = 512; asm volatile("" : "+s"(kk_));
                pg8::Gemm g{(const bf16*)WSP(unsigned char, WS_A1), (const bf16*)(WSP(unsigned char, WS_WQKV) + (size_t)jj * 3072 * 1024), nMt * 256, 3072, kk_}; pg8::StaticOrder S; S.init(nMt * 256, 3072, G, bx);
                pg8::EpiQKV E{WSP(bf16, WS_Q), (unsigned)((WS_K - WS_Q) / 2), WSP(float, WS_TAB + TB_ROPEC), WSP(float, WS_TAB + TB_ROPES), 0.125f * 1.4426950408889634f, WSP(float, WS_A1S), 1.f / WQ, (rep_ > 0) ? QKV_PROBE : 0};
                static_assert(WS_V - WS_K == WS_K - WS_Q, "Q | K | V equally spaced");
                pg8::gemm_phase<pg8::EpiQKV, pg8::StaticOrder, true, true, 1>(L + RING_OFF, g, S, E);
                const int remq = (nMt * 12) % G;
                if (remq != 0 && bx >= remq) { __syncthreads();
                    const int nwt = (G - remq) * NWAVES, tq = nwt * 2;
                    moe_conv_stream<false>(INP(19), WSP(unsigned char, WS_WD), ly * 32 * 256, ly * 32 * 256 + tq, (bx - remq) * NWAVES + wave, nwt, (LAS unsigned char*)(L + RING_OFF + wave * 16384), lane, WQD); }
            }
            REP_END(0)
            SEAM(pb + 0);
            REP_BEGIN(1)
            if (INL(1, 1)) {
                PHASE_BASES
                const int NU = 1024 + (ly == 0 ? 32 : 0);
                const int remq_ = (nMt * 12) % G, tq_ = remq_ ? (G - remq_) * NWAVES * 2 : 0;
                const int NGRP = (G % 32 == 0) ? 4 : 1, grp = (NGRP == 4) ? ((vcu & 31) >> 3) : 0;
#ifndef CONV_REP
#define CONV_REP 1
#endif
#define ATTN_CONV() do { PHASE_BASES const int cpg = G / NGRP, wig = ((NGRP == 4) ? ((vcu >> 5) * 8 + (vcu & 7)) : vcu) * NWAVES + wave, nwv = cpg * NWAVES; \
                         for (int cr_ = 0; cr_ < CONV_REP; ++cr_) moe_conv_range(INP(17), WSP(unsigned char, WS_WGU), INP(19), WSP(unsigned char, WS_WD), ly * 32 * 512 + grp * (64 * 512 / NGRP), ly * 32 * 512 + (grp + 1) * (64 * 512 / NGRP), \
                                       ly * 32 * 256 + tq_ + (64 * 256 - tq_) * grp / NGRP, ly * 32 * 256 + tq_ + (64 * 256 - tq_) * (grp + 1) / NGRP, wig, nwv, (LAS float*)(L + RING_OFF + wave * 16384), lane); __syncthreads(); } while (0)
                const float* lamp = INP(9) + jj * 256; const float* sg = INP(10) + jj * 128;
                const float linit = 0.8f - 0.6f * expf(-0.3f * (float)ly);
                const float d1 = wave_sum(lamp[lane] * lamp[64 + lane], lane), d2 = wave_sum(lamp[128 + lane] * lamp[192 + lane], lane);
                const float lam = __builtin_bit_cast(float, __builtin_amdgcn_readfirstlane(__builtin_bit_cast(int, expf(d1) - expf(d2) + linit)));
                float mg_ = fmaxf(fabsf(sg[lane]), fabsf(sg[64 + lane])) * fabsf(1.f - linit);
                mg_ = fmaxf(wave_max(mg_, lane), 1e-20f);
                const float mixq = __builtin_bit_cast(float, __builtin_amdgcn_readfirstlane(__builtin_bit_cast(int, 127.f / (MIXCLIP * mg_))));
                int un_ = 0, P_ = vcu, c_ = 0; bool failed_ = false, convd_ = false;
#define ATTN_LOOP(FASTF) \
                for (;; P_ += G, c_ = 0) { const bool havep = P_ < 512; \
                    const int qb = P_ & 31, xg = (P_ >> 5) & 7, it2 = P_ >> 8, grp2 = xg * 2 + it2, b = grp2 >> 3, h = grp2 & 7; \
                    _Pragma("unroll 1") for (; c_ < 2; ++c_, ++un_) { \
                        if (un_ == grp && rep_ == 0 && !convd_) { ATTN_CONV(); convd_ = true; } \
                        if (!havep) break; \
                        const long qrow0 = (long)b * SEQ + qb * 256, krow0 = (long)b * KVB; const int hq = 2 * h + c_; \
                        if (hattn::attn_unit<8, FASTF>(qrow0, krow0, KVB / 64, hq, h * 128, WSP(const hattn::bf16, WS_Q), WSP(const hattn::bf16, WS_K), WSP(const hattn::bf16, WS_V), \
                                            WSP(hattn::bf16, WS_O0), (char*)lds + RING_OFF, c_, lam, sg, (1.f - linit) * mixq, WSP(unsigned char, WS_MIX8))) { failed_ = true; break; } \
                    } \
                    if (failed_ || !havep) break; }
                ATTN_LOOP(true)
                if (failed_) { failed_ = false; ATTN_LOOP(false) }
#undef ATTN_LOOP
                if (ly == 0 && vcu < 16) {
                    const int b = vcu >> 3, h = vcu & 7; const long qrow0 = RL + (long)b * CTXL, krow0 = (long)b * KVB + SEQ;
#pragma unroll 1
                    for (int c = 0; c < 2; ++c)
                        hattn::attn_unit<8>(qrow0, krow0, CTXL / 64, 2 * h + c, h * 128, WSP(const hattn::bf16, WS_Q), WSP(const hattn::bf16, WS_K), WSP(const hattn::bf16, WS_V),
                                            WSP(hattn::bf16, WS_O0), (char*)lds + RING_OFF, c, lam, sg, (1.f - linit) * mixq, WSP(unsigned char, WS_MIX8));
                }
                if (grp > un_ && rep_ == 0 && !convd_) ATTN_CONV();
#undef ATTN_CONV
            }
            REP_END(1)
#if DBG_ATTN
            if (ly == 0) {
                GRID_BAR();
                { PHASE_BASES
                  const int NU = 1024 + 32;
                  for (int U = vcu; U < NU; U += G) {
                    long qrow0, krow0; int seq, hq;
                    if (U < 1024) { const int qb = U & 31, xg = (U >> 5) & 7, it = U >> 8, grp = xg * 4 + it, b = grp >> 4; hq = grp & 15; qrow0 = (long)b * SEQ + qb * 256; krow0 = (long)b * KVB; seq = KVB; }
                    else { const int w = U - 1024, b = w >> 4; hq = w & 15; qrow0 = RL + (long)b * CTXL; krow0 = (long)b * KVB + SEQ; seq = CTXL; }
                    const int h = hq >> 1, c = hq & 1;
                    hattn::attn_unit<8>(qrow0, krow0, seq / 64, hq, h * 128, WSP(const hattn::bf16, WS_Q), WSP(const hattn::bf16, WS_K), WSP(const hattn::bf16, WS_V),
                                        (hattn::bf16*)(GAS hattn::bf16*)(w_ + (c ? WS_U2 : WS_U)), (char*)lds + RING_OFF);
                  } }
                GRID_BAR();
                { PHASE_BASES
                  unsigned worst = 0;
                  for (int r = gw; r < RT; r += NGW) {
#pragma unroll
                    for (int c = 0; c < 2; ++c) { float a[16], b[16]; ld_bf16(WSP(bf16, c ? WS_O1 : WS_O0) + (size_t)r * 1024, lane, a); ld_bf16(WSP(bf16, c ? WS_U2 : WS_U) + (size_t)r * 1024, lane, b);
                      float e = 0.f; bool bad = false;
#pragma unroll
                      for (int t = 0; t < 16; ++t) { const float d = fabsf(a[t] - b[t]) / (fmaxf(fabsf(a[t]), fabsf(b[t])) + 0.01f); if (!(d == d)) bad = true; e = fmaxf(e, d); }
                      unsigned code = bad ? 7u : (e < 0.02f ? 0u : (e < 0.05f ? 2u : (e < 0.1f ? 3u : (e < 0.3f ? 4u : (e < 1.f ? 5u : 6u)))));
                      if (code) code += 10u * c + (r >= RL ? 20u : 0u);
                      worst = code > worst ? code : worst; } }
                  if (worst) atomicMax((unsigned*)(WSP(unsigned, WS_CTL) + CW_DBG), worst);
                }
                GRID_BAR();
            }
#endif
            SEAM(pb + 1);
        } else {
            REP_BEGIN(16)
            if (INL(0, 16)) {
                PHASE_BASES
                int kk_ = 512; asm volatile("" : "+s"(kk_));
                pg8::Gemm g{(const bf16*)WSP(unsigned char, WS_A1), (const bf16*)(WSP(unsigned char, WS_FNIN) + (size_t)jj * 1024 * 1024), nrows, 1024, kk_}; pg8::StaticOrder S; S.init(nrows, 1024, G, bx);
                pg8::EpiPF1 E{WSP(bf16, WS_U2), WSP(float, WS_A1S), 1.f / WQ, INP(13) + jj * 1024, (LAS float*)(TAB + 1536), RMS_EPS, RL};
                pg8::gemm_phase<pg8::EpiPF1, pg8::StaticOrder, true, true, 1>(L + RING_OFF, g, S, E);
            }
            REP_END(16)
            SEAM(pb + 0);
            REP_BEGIN(18)
            if (INL(2, 18)) {
                PHASE_BASES
                int kk_ = 128; asm volatile("" : "+s"(kk_)); pg8::Gemm g{WSP(bf16, WS_TAB + TB_DFTC), WSP(bf16, WS_U2), 256, 0, kk_}; pg8::LinearOrder S{ctx_full ? 528 : 512, G, vcu};
                pg8::EpiZ1 E{WSP(bf16, WS_Z1), WSP(bf16, WS_ZC)};
                pg8::gemm_phase<pg8::EpiZ1, pg8::LinearOrder, true, true>(L + RING_OFF, g, S, E);
            }
            REP_END(18)
            SEAM(pb + 2);
            REP_BEGIN(19)
            if (INL(3, 19)) {
                PHASE_BASES
                int kk_ = 256; asm volatile("" : "+s"(kk_)); pg8::Gemm g{WSP(bf16, WS_TAB + TB_DFT1), WSP(bf16, WS_Z1), 256, 0, kk_}; pg8::LinearOrder S{512, G, vcu};
                pg8::EpiFFT1 E{WSP(bf16, WS_T), WSP(float, WS_TAB + TB_TWC), WSP(float, WS_TAB + TB_TWS)};
                pg8::gemm_phase<pg8::EpiFFT1, pg8::LinearOrder, true, true>(L + RING_OFF, g, S, E);
            }
            REP_END(19)
            SEAM(pb + 3);
            REP_BEGIN(20)
            if (INL(4, 20)) {
                { PHASE_BASES
                  int kk_ = 128; asm volatile("" : "+s"(kk_)); pg8::Gemm g{WSP(bf16, WS_TAB + TB_DFT2), WSP(bf16, WS_T), 256, 0, kk_}; pg8::LinearOrder S{1024, G, vcu};
                  pg8::EpiFFT2 E{WSP(bf16, WS_MIX)};
                  pg8::gemm_phase<pg8::EpiFFT2, pg8::LinearOrder, true, true>(L + RING_OFF, g, S, E); }
                if (ctx_full) { __syncthreads();
                  PHASE_BASES
                  int kk_ = 512; asm volatile("" : "+s"(kk_)); pg8::Gemm g{WSP(bf16, WS_TAB + TB_DFT256), WSP(bf16, WS_ZC), 256, 0, kk_}; pg8::LinearOrder S{8, G, vcu};
                  pg8::EpiDFT256 E{WSP(bf16, WS_MIX)};
                  pg8::gemm_phase<pg8::EpiDFT256, pg8::LinearOrder, true, true>(L + RING_OFF, g, S, E); }
            }
            REP_END(20)
            SEAM(pb + 4);
        }
        REP_BEGIN(5)
        if (INL(5, 5)) {
            PHASE_BASES
            pg8::StaticOrder S; S.init(nrows, 1024, G, bx);
            if (ly & 1) {
                const bf16* Wt = (const bf16*)(const GAS bf16*)(w_ + WS_FNOUT) + (size_t)jj * 1024 * 1024;
                pg8::Gemm g{WSP(bf16, WS_MIX), Wt, nrows, 1024, 1024};
                pg8::EpiBf16<0> E{WSP(bf16, WS_Y), 1024, nullptr, 0, 0, 1.f};
                pg8::gemm_phase<pg8::EpiBf16<0>, pg8::StaticOrder, true, true>(L + RING_OFF, g, S, E);
            } else {
                const float* sg = INP(10) + jj * 128; const float linit = 0.8f - 0.6f * expf(-0.3f * (float)ly);
                float mg_ = fmaxf(fabsf(sg[lane]), fabsf(sg[64 + lane])) * fabsf(1.f - linit);
                mg_ = fmaxf(wave_max(mg_, lane), 1e-20f);
                const float deq = __builtin_bit_cast(float, __builtin_amdgcn_readfirstlane(__builtin_bit_cast(int, (MIXCLIP * mg_) * (1.f / 127.f))));
                int kk_ = 512; asm volatile("" : "+s"(kk_));
                pg8::Gemm g{(const bf16*)WSP(unsigned char, WS_MIX8), (const bf16*)(WSP(unsigned char, WS_WO) + (size_t)jj * 1024 * 1024), nrows, 1024, kk_};
                pg8::EpiI8Bf16 E{WSP(bf16, WS_Y), nullptr, 1.f / WQ, deq};
                pg8::gemm_phase<pg8::EpiI8Bf16, pg8::StaticOrder, true, true, 1>(L + RING_OFF, g, S, E);
            }
        }
        REP_END(5)
        SEAM(pb + 5);
        REP_BEGIN(6)
        if (INL(6, 6)) {
            PHASE_BASES
            constexpr int HP = 1028;
            LAS float* H = (LAS float*)(L + RING_OFF); LAS float* PART = H + 16 * HP;
            if (tid < 32 && rep_ == 0) TAB[tid] = 0;
            float wb0[32], wb1[32];
            { const float* wr = INP(15) + (size_t)ly * 32768 + (size_t)(128 * wave + 32 * (lane >> 4)) * 32 + (lane & 15);
#pragma unroll
              for (int s_ = 0; s_ < 32; ++s_) { wb0[s_] = wr[s_ * 32]; wb1[s_] = wr[s_ * 32 + 16]; } }
            __syncthreads();
            const unsigned short* X = WSP(unsigned short, WS_X); unsigned short* X2 = WSP(unsigned short, WS_X2); const bf16* Y = WSP(bf16, WS_Y); unsigned char* A2 = WSP(unsigned char, WS_A2); float* asr = WSP(float, WS_ASCR);
            const float* brt = INP(16) + ly * 32; const float* lng = INP(6) + (size_t)(ly * 2) * 1024; const float* lnb = INP(7) + (size_t)(ly * 2) * 1024;
            const int nit = (nrows - vcu * NWAVES + NGW - 1) / NGW;
            LAS float* const MV = PART + 8 * 16 * 32;
            LAS int* const REC = (LAS int*)(MV + 5 * 1024);
            for (int q_ = tid; q_ < 512; q_ += NWAVES * 64) { const int vec = q_ >> 8, off = (q_ & 255) * 4; *(LAS f32x4*)(MV + 3072 + vec * 1024 + off) = *(const f32x4*)((vec ? lnb : lng) + off); }
            int cur_s = -1;
#pragma unroll 1
            for (int i0 = 0; i0 < nit; i0 += 2) {
                { const int r0 = vcu * NWAVES + i0 * NGW, s_ = r0 < RL ? (r0 >> 13) : 2;
                  if (s_ != cur_s) { const float* src = MODP(ly, s_, 2);
                      for (int q_ = tid; q_ < 768; q_ += NWAVES * 64) *(LAS f32x4*)(MV + q_ * 4) = *(const f32x4*)(src + q_ * 4);
                      cur_s = s_; __syncthreads(); } }
#pragma unroll 1
                for (int q = 0; q < 2; ++q) { const int r = gw + (i0 + q) * NGW;
                    if (r < nrows) {
                        float v[16];
                        { v4u xw[2], yw[2];
#pragma unroll
                          for (int j_ = 0; j_ < 2; ++j_) { xw[j_] = *(const v4u*)(X + (size_t)r * 1024 + 512 * j_ + 8 * lane); yw[j_] = *(const v4u*)(Y + (size_t)r * 1024 + 512 * j_ + 8 * lane); }
                          pm1_comb(lane, xw, yw, (const LAS float*)MV, v); }
                        const float rsc_ = pm1_pre2(r, lane, (const LAS float*)(MV + 2048), (const LAS float*)(MV + 1024), (const LAS float*)(MV + 3072), (const LAS float*)(MV + 4096), X2, A2, asr, v);
                        if (lane == 0) REC[((i0 + q) * NWAVES + wave) * 16 + 12] = __builtin_bit_cast(int, rsc_);
                        LAS float* hr = H + (2 * wave + q) * HP + 8 * lane;
#pragma unroll
                        for (int j_ = 0; j_ < 2; ++j_) { *(LAS f32x4*)(hr + 512 * j_) = (f32x4){v[8 * j_], v[8 * j_ + 1], v[8 * j_ + 2], v[8 * j_ + 3]}; *(LAS f32x4*)(hr + 512 * j_ + 4) = (f32x4){v[8 * j_ + 4], v[8 * j_ + 5], v[8 * j_ + 6], v[8 * j_ + 7]}; }
                    }
                    asm volatile("" ::: "memory"); }
                __syncthreads();
                {
                    f32x4 c0 = {0.f, 0.f, 0.f, 0.f}, c1 = c0;
                    const LAS float* ha = H + (lane & 15) * HP + 128 * wave + 32 * (lane >> 4);
#pragma unroll
                    for (int s8 = 0; s8 < 8; ++s8) { const f32x4 a4 = *(const LAS f32x4*)(ha + 4 * s8);
#pragma unroll
                        for (int t = 0; t < 4; ++t) { c0 = __builtin_amdgcn_mfma_f32_16x16x4f32(a4[t], wb0[4 * s8 + t], c0, 0, 0, 0); c1 = __builtin_amdgcn_mfma_f32_16x16x4f32(a4[t], wb1[4 * s8 + t], c1, 0, 0, 0); } }
                    LAS float* pw = PART + (wave * 16 + 4 * (lane >> 4)) * 32 + (lane & 15);
#pragma unroll
                    for (int t = 0; t < 4; ++t) { pw[t * 32] = c0[t]; pw[t * 32 + 16] = c1[t]; }
                }
                __syncthreads();
#pragma unroll 1
                for (int q = 0; q < 2; ++q) { const int r = gw + (i0 + q) * NGW;
                    float lg = brt[lane & 31];
#pragma unroll
                    for (int w_ = 0; w_ < 8; ++w_) lg += PART[(w_ * 16 + 2 * wave + q) * 32 + (lane & 31)];
                    pm1_top4(r < nrows, rep_ == 0, lane, lg, TAB, REC + ((i0 + q) * NWAVES + wave) * 16); }
            }
            __syncthreads();
            if (tid < 32 && rep_ == 0) { int* counts = WSP(int, WS_CTL) + CW_CNT; const int h = TAB[tid]; const int base = h ? __hip_atomic_fetch_add(counts + ly * 32 + tid, h, __ATOMIC_RELAXED, __HIP_MEMORY_SCOPE_AGENT) : 0; TAB[32 + tid] = tid * CAPE + base; }
            __syncthreads();
            if (rep_ == 0) { float* const gate = WSP(float, WS_GATE); int* const dest = WSP(int, WS_DEST); float* const ascd = WSP(float, WS_ASCD); int* const tokr = WSP(int, WS_TOKR);
                for (int i_ = 0; i_ < nit; ++i_) { const int r = gw + i_ * NGW;
                    if (r < nrows && lane < 4) { const LAS int* rec = REC + (i_ * NWAVES + wave) * 16; const int e = rec[lane], d = TAB[32 + e] + rec[4 + lane];
                        gate[d] = __builtin_bit_cast(float, rec[8 + lane]); ascd[d] = __builtin_bit_cast(float, rec[12]); dest[r * 4 + lane] = d; tokr[d] = r; } } }
        }
        __syncthreads();
        REP_END(6)
        SEAM(pb + 6);
        if (INL(8, 8) || INL(9, 9)) {
            PHASE_BASES
            const int* counts = WSP(int, WS_CTL) + CW_CNT;
            __syncthreads();
            if (tid < CAPB + 8) { int acc = 0, ef = 31, jf = 0; for (int e = 0; e < 32; ++e) { const int nb = (counts[ly * 32 + e] + 255) >> 8; if (tid >= acc && tid < acc + nb) { ef = e; jf = tid - acc; } acc += nb; }
                TAB[128 + tid] = ef | ((ef * CAPE_B + jf) << 8); if (tid == 0) TAB[64] = acc; }
            __syncthreads();
        }
        REP_BEGIN(8)
        if (INL(8, 8)) {
            PHASE_BASES
            const int NB = TAB[64];
            int kk_ = 512; asm volatile("" : "+s"(kk_));
            pg8::Gemm g{(const bf16*)WSP(unsigned char, WS_A2), (const bf16*)(WSP(unsigned char, WS_WGU) + (size_t)ly * 32 * 2048 * 1024), 0, 0, kk_, WSP(int, WS_TOKR), TAB + 1024, (unsigned)(RT - 1)}; pg8::MoeOrder S{(const LAS int*)(TAB + 128), NB, 8, G, vcu};
            #if defined(MOE1_NOSTORE_ON_REP)
            const int ns_ = rep_ > 0 ? 2 : 0;
#else
            const int ns_ = 0;
#endif
            pg8::EpiSwiGLU E{WSP(unsigned char, WS_ACT), INP(18) + (size_t)ly * 32 * 2048, WSP(float, WS_ASCD), 1.f / WQ, ACTQ, ns_};
            pg8::gemm_phase<pg8::EpiSwiGLU, pg8::MoeOrder, true, true, 1, true>(L + RING_OFF, g, S, E);
        }
        REP_END(8)
        SEAM(pb + 8);
        REP_BEGIN(9)
        if (INL(9, 9)) {
            PHASE_BASES
            const int NB = TAB[64];
            int kk_ = 512; asm volatile("" : "+s"(kk_));
            pg8::Gemm g{(const bf16*)WSP(unsigned char, WS_ACT), (const bf16*)(WSP(unsigned char, WS_WD) + (size_t)ly * 32 * 1024 * 1024), 0, 0, kk_}; pg8::MoeOrder S{(const LAS int*)(TAB + 128), NB, 4, G, vcu};
            #if defined(MOE2_NOEPI_ON_REP)
            const int ns2_ = rep_ > 0 ? MOE2_NOEPI_ON_REP : 0;
#else
            const int ns2_ = 0;
#endif
            pg8::EpiMoE2 E{WSP(unsigned char, WS_OUTM), INP(20) + (size_t)ly * 32 * 1024, WSP(float, WS_GATE), 1.f / (ACTQ * WQD), OSC, ns2_};
            pg8::gemm_phase<pg8::EpiMoE2, pg8::MoeOrder, true, true, 1>(L + RING_OFF, g, S, E);
        }
        REP_END(9)
        SEAM(pb + 9);
        REP_BEGIN(10)
        if (INL(10, 10)) {
            PHASE_BASES
            const int* dest = WSP(int, WS_DEST); const unsigned char* OM = WSP(unsigned char, WS_OUTM); unsigned short* X = WSP(unsigned short, WS_X); const unsigned short* X2 = WSP(unsigned short, WS_X2); unsigned char* A1 = WSP(unsigned char, WS_A1); float* a1s = WSP(float, WS_A1S);
            const float* lng = INP(6) + (size_t)(ly * 2 + 1) * 1024; const float* lnb = INP(7) + (size_t)(ly * 2 + 1) * 1024;
            LAS float* const MV5 = (LAS float*)(L + RING_OFF);
            for (int q_ = tid; q_ < 11 * 256; q_ += NWAVES * 64) { const int vec = q_ >> 8, off = (q_ & 255) * 4; const float* src;
                if (vec < 9) { const int s_ = vec / 3, k_ = vec % 3; src = (k_ == 0 || ly + 1 >= DEPTH) ? MODP(ly, s_, 5) : MODP(ly + 1, s_, k_ == 1 ? 0 : 1); } else src = (vec == 9) ? lng : lnb;
                *(LAS f32x4*)(MV5 + vec * 1024 + off) = *(const f32x4*)(src + off); }
            __syncthreads();
            int nd0 = 0, nd1 = 0, nd2 = 0, nd3 = 0;
            if (gw < nrows) { nd0 = dest[gw * 4 + 0]; nd1 = dest[gw * 4 + 1]; nd2 = dest[gw * 4 + 2]; nd3 = dest[gw * 4 + 3]; }
            for (int r = gw; r < nrows; r += NGW) { const int s = r < RL ? (r >> 13) : 2;
                float v[16], acc[16];
                { const int d0 = nd0, d1 = nd1, d2 = nd2, d3 = nd3;
                  if (r + NGW < nrows) { nd0 = dest[(r + NGW) * 4 + 0]; nd1 = dest[(r + NGW) * 4 + 1]; nd2 = dest[(r + NGW) * 4 + 2]; nd3 = dest[(r + NGW) * 4 + 3]; }
                  typedef unsigned u32x2_t __attribute__((ext_vector_type(2)));
#pragma unroll
                  for (int j = 0; j < 2; ++j) {
                      const u32x2_t w0 = *(const u32x2_t*)(OM + (size_t)d0 * 1024 + 512 * j + 8 * lane), w1 = *(const u32x2_t*)(OM + (size_t)d1 * 1024 + 512 * j + 8 * lane);
                      const u32x2_t w2 = *(const u32x2_t*)(OM + (size_t)d2 * 1024 + 512 * j + 8 * lane), w3 = *(const u32x2_t*)(OM + (size_t)d3 * 1024 + 512 * j + 8 * lane);
#define F8(w, b) __builtin_amdgcn_cvt_f32_fp8((int)(w), (b))
#define SUM4(c, b) ((((F8(w0.c, b) + F8(w1.c, b)) + F8(w2.c, b)) + F8(w3.c, b)) * (1.f / OSC))
                      acc[8 * j + 0] = SUM4(x, 0); acc[8 * j + 1] = SUM4(x, 1); acc[8 * j + 2] = SUM4(x, 2); acc[8 * j + 3] = SUM4(x, 3);
                      acc[8 * j + 4] = SUM4(y, 0); acc[8 * j + 5] = SUM4(y, 1); acc[8 * j + 6] = SUM4(y, 2); acc[8 * j + 7] = SUM4(y, 3);
#undef SUM4
#undef F8
                  } }
                { float g2[16]; ld_f16(X2 + (size_t)r * 1024, lane, v); ld_f32((const LAS float*)(MV5 + (3 * s) * 1024), lane, g2);
#pragma unroll
                  for (int t = 0; t < 16; ++t) v[t] = DN_ALPHA * v[t] + g2[t] * acc[t]; }
                ln_row(v, (const LAS float*)(MV5 + 9 * 1024), (const LAS float*)(MV5 + 10 * 1024), lane);
                if (ly == DEPTH - 1) { st_f32((float*)(GAS float*)(unsigned long long)args.out + (size_t)r * 1024, lane, v); }
                else { st_f16(X + (size_t)r * 1024, lane, v);
                    if (r < RL || ly < 2) { float sc[16], sh[16]; ld_f32((const LAS float*)(MV5 + (3 * s + 2) * 1024), lane, sc); ld_f32((const LAS float*)(MV5 + (3 * s + 1) * 1024), lane, sh);
#pragma unroll
                        for (int t = 0; t < 16; ++t) v[t] = v[t] * (1.f + sc[t]) + sh[t];
                        st_i8_row(A1 + (size_t)r * 1024, a1s + r, lane, v); } }
            }
        }
        REP_END(10)
        SEAM(pb + 10);
    }
#if PROBE
    {
        GRID_BAR();
        const unsigned long long* T = (const unsigned long long*)(args.ws + WS_CTL) + 16384;
        const float t1 = (float)(__hip_atomic_load(T + PROBE_A1, RLX_AGENT) - __hip_atomic_load(T + PROBE_A0, RLX_AGENT)) * 0.01f, t2 = (float)(__hip_atomic_load(T + PROBE_B1, RLX_AGENT) - __hip_atomic_load(T + PROBE_B0, RLX_AGENT)) * 0.01f;
        const float cv = sqrtf(t1); float* o = (float*)(GAS float*)(unsigned long long)args.out;
        for (size_t idx = (size_t)gw * 64 + (tid & 63); idx < (size_t)RL * 1024; idx += (size_t)NGW * 64) o[idx] = idx == 0 ? 10.f * t2 : cv;
    }
#endif
#if DEBUG_CODES
    {
        gu32* ctl = (gu32*)(args.ws + WS_CTL);
        unsigned code = __hip_atomic_load(ctl + CW_DBG, RLX_AGENT); if (__hip_atomic_load(ctl + CW_BAR + XB_TMO, RLX_AGENT)) code = 90;
        if (code && IN(3 + (DEPTH - 1) * 12 + 10)) { __syncthreads(); const float cv = sqrtf((float)code); for (size_t idx = (size_t)gw * 64 + lane; idx < (size_t)RL * 1024; idx += (size_t)NGW * 64) args.out[idx] = cv; }
    }
#endif
#undef IN
#undef SEAM
}

constexpr int N_PHASES = 3 + DEPTH * 12 - 1;
extern "C" void kernel_launch(void* const* d_in, const int* in_sizes, int n_in, void* d_out, int out_size, void* d_ws, size_t ws_size, hipStream_t stream) {
    static int grid = 0;
    if (grid == 0) {
        if (n_in != 21 || out_size != RL * DM || ws_size < WS_END) { fprintf(stderr, "kernel_launch: unexpected problem (n_in %d, out %d, ws %zu)\n", n_in, out_size, ws_size); grid = -1; return; }
        int dev = 0, cus = 0, per_cu = 0;
        if (hipGetDevice(&dev) != hipSuccess || hipDeviceGetAttribute(&cus, hipDeviceAttributeMultiprocessorCount, dev) != hipSuccess) { grid = -1; return; }
        if (hipFuncSetAttribute((const void*)fwd_kernel, hipFuncAttributeMaxDynamicSharedMemorySize, LDS_BYTES) != hipSuccess) { fprintf(stderr, "kernel_launch: hipFuncSetAttribute failed\n"); grid = -1; return; }
        if (hipOccupancyMaxActiveBlocksPerMultiprocessor(&per_cu, (const void*)fwd_kernel, NWAVES * 64, LDS_BYTES) != hipSuccess || per_cu < 1) { fprintf(stderr, "kernel_launch: occupancy query reports %d workgroups per CU\n", per_cu); }
        (void)hipGetLastError();
        grid = cus;
    }
    if (grid < 0) return;
    (void)hipMemsetAsync((char*)d_ws + WS_CTL, 0, CTL_ZERO_BYTES, stream);
    Args a{};
    for (int i = 0; i < 21; ++i) a.in[i] = (const float*)d_in[i];
    a.out = (float*)d_out; a.ws = (unsigned char*)d_ws;
#if ONE_LAUNCH
    a.ph_lo = 0; a.ph_hi = N_PHASES;
    hipLaunchKernelGGL(fwd_kernel, dim3(grid), dim3(NWAVES * 64), LDS_BYTES, stream, a);
#else
    for (int p = 0; p < N_PHASES; ++p) {
        const int q = (p - 3) % 12, ly = (p - 3) / 12;
        if (p >= 3) { if (q == 11) continue; if ((ly & 1) == 0 && (q == 3 || q == 4)) continue; }
        a.ph_lo = p; a.ph_hi = p + 1;
        hipLaunchKernelGGL(fwd_kernel, dim3(grid), dim3(NWAVES * 64), LDS_BYTES, stream, a);
    }
#endif
}
```
